# Optimizing an MI355X kernel written in HIP

```python
import jax, jax.numpy as jnp
from jax import lax
import numpy as np

D_MODEL = 1024
BATCH = 8
SEQ = 4096
DEPTH = 4

HEAD_DIM = 64
PLE_DIM = 256
D_FF = 4 * D_MODEL
EPS = 1e-6

GDN_WIDTH = D_MODEL // 4
GDN_HEADS = GDN_WIDTH // HEAD_DIM
CONV_WIDTH = 4
GDN_CHUNK = 64

MLSTM_WIDTH = D_MODEL // 4
MLSTM_HEADS = MLSTM_WIDTH // HEAD_DIM
MLSTM_CHUNK = 64
GATE_SOFTCAP = 15.0

SWA_WIDTH = D_MODEL - GDN_WIDTH - MLSTM_WIDTH
SWA_Q_HEADS = SWA_WIDTH // HEAD_DIM
SWA_KV_HEADS = SWA_Q_HEADS // 4
SWA_GROUP = SWA_Q_HEADS // SWA_KV_HEADS
SWA_WINDOW = 128
SWA_BLOCK = 128
ROPE_THETA = 500000.0
ROPE_DIM = HEAD_DIM // 4

MIX_WIDTH = GDN_WIDTH + MLSTM_WIDTH + SWA_WIDTH
IN_SPLITS = (
    GDN_WIDTH, GDN_WIDTH, GDN_WIDTH, GDN_WIDTH, GDN_HEADS, GDN_HEADS,
    MLSTM_WIDTH, MLSTM_WIDTH, MLSTM_WIDTH, MLSTM_WIDTH, MLSTM_HEADS, MLSTM_HEADS,
    SWA_WIDTH, SWA_KV_HEADS * HEAD_DIM, SWA_KV_HEADS * HEAD_DIM,
)
IN_COLS = sum(IN_SPLITS)

kernel_name = 'hybrid_gdn_mlstm_swa_trunk'


def rms_norm(x, g):
    xf = x.astype(jnp.float32)
    y = xf * lax.rsqrt(jnp.mean(xf * xf, axis=-1, keepdims=True) + EPS)
    return (y * g.astype(jnp.float32)).astype(x.dtype)


def split_cols(t, sizes):
    offs = np.cumsum(np.array(sizes))[:-1].tolist()
    return jnp.split(t, offs, axis=-1)


def l2_normalize(x):
    return x * lax.rsqrt(jnp.sum(x * x, axis=-1, keepdims=True) + EPS)


def softcap(x, cap):
    return cap * jnp.tanh(x / cap)


def causal_depthwise_conv(x, w):
    K = w.shape[0]
    seq = x.shape[1]
    xp = jnp.pad(x, ((0, 0), (K - 1, 0), (0, 0)))
    out = xp[:, 0:seq] * w[0]
    for j in range(1, K):
        out = out + xp[:, j:j + seq] * w[j]
    return out


def to_chunked_heads(t, n_heads, chunk):
    bsz, seq, _ = t.shape
    return t.reshape(bsz, seq // chunk, chunk, n_heads, -1).transpose(0, 3, 1, 2, 4)


def to_chunked_gates(t, chunk):
    bsz, seq, n_heads = t.shape
    return t.reshape(bsz, seq // chunk, chunk, n_heads).transpose(0, 3, 1, 2)


def from_scan_heads(o):
    n, bsz, h, c, d = o.shape
    return o.transpose(1, 0, 3, 2, 4).reshape(bsz, n * c, h, d)


def rope_tables(positions):
    inv_freq = ROPE_THETA ** (-jnp.arange(0, ROPE_DIM, 2, dtype=jnp.float32) / ROPE_DIM)
    ang = positions.astype(jnp.float32)[..., None] * inv_freq
    return jnp.cos(ang), jnp.sin(ang)


def apply_partial_rope(x, cos, sin):
    half = ROPE_DIM // 2
    cos = cos.astype(x.dtype)
    sin = sin.astype(x.dtype)
    x1 = x[..., :half]
    x2 = x[..., half:ROPE_DIM]
    return jnp.concatenate([x1 * cos - x2 * sin, x2 * cos + x1 * sin, x[..., ROPE_DIM:]], axis=-1)


def gated_delta_net(q, k, v, z, beta_pre, a_pre, conv_w, a_log, dt_bias, norm_w):
    bsz, seq, _ = q.shape
    H, D, C = GDN_HEADS, HEAD_DIM, GDN_CHUNK
    f32 = jnp.float32
    qkv = jax.nn.silu(causal_depthwise_conv(jnp.concatenate([q, k, v], axis=-1), conv_w).astype(f32))
    q, k, v = (to_chunked_heads(t, H, C) for t in jnp.split(qkv, 3, axis=-1))
    q = l2_normalize(q) * (D ** -0.5)
    k = l2_normalize(k)
    beta = to_chunked_gates(jax.nn.sigmoid(beta_pre.astype(f32)), C)
    g = -jnp.exp(a_log.astype(f32)) * jax.nn.softplus(a_pre.astype(f32) + dt_bias.astype(f32))
    gc = jnp.cumsum(to_chunked_gates(g, C), axis=-1)
    causal = jnp.tril(jnp.ones((C, C), dtype=bool))
    strict = jnp.tril(jnp.ones((C, C), dtype=bool), -1)
    decay = jnp.exp(jnp.where(causal, gc[..., :, None] - gc[..., None, :], -jnp.inf))
    k_beta = k * beta[..., None]
    kk = jnp.einsum('bhncd,bhnsd->bhncs', k_beta, k) * decay
    lhs = jnp.eye(C, dtype=f32) + jnp.where(strict, kk, 0.0)
    rhs = jnp.concatenate([v * beta[..., None], k_beta * jnp.exp(gc)[..., None]], axis=-1)
    u, w = jnp.split(lax.linalg.triangular_solve(lhs, rhs, left_side=True, lower=True), 2, axis=-1)
    qk = jnp.einsum('bhncd,bhnsd->bhncs', q, k) * decay
    q_dec = q * jnp.exp(gc)[..., None]
    g_last = gc[..., -1]
    k_dec = k * jnp.exp(g_last[..., None] - gc)[..., None]

    def step(state, xs):
        u_c, w_c, qk_c, qd_c, kd_c, gl_c = xs
        v_new = u_c - jnp.einsum('bhcd,bhde->bhce', w_c, state)
        o = jnp.einsum('bhcd,bhde->bhce', qd_c, state) + jnp.einsum('bhcs,bhse->bhce', qk_c, v_new)
        state = state * jnp.exp(gl_c)[..., None, None] + jnp.einsum('bhcd,bhce->bhde', kd_c, v_new)
        return state, o

    xs = tuple(jnp.moveaxis(t, 2, 0) for t in (u, w, qk, q_dec, k_dec, g_last))
    _, o = lax.scan(step, jnp.zeros((bsz, H, D, D), f32), xs)
    o = from_scan_heads(o)
    o = rms_norm(o, norm_w) * jax.nn.silu(z.astype(f32).reshape(bsz, seq, H, D))
    return o.reshape(bsz, seq, H * D)


def mlstm(q, k, v, o_pre, i_pre, f_pre, i_bias, f_bias, norm_w):
    bsz, seq, _ = q.shape
    H, D, L = MLSTM_HEADS, HEAD_DIM, MLSTM_CHUNK
    f32 = jnp.float32
    q = to_chunked_heads(q.astype(f32), H, L)
    k = to_chunked_heads(k.astype(f32), H, L) * (D ** -0.5)
    v = to_chunked_heads(v.astype(f32), H, L)
    ig = to_chunked_gates(softcap(i_pre.astype(f32) + i_bias.astype(f32), GATE_SOFTCAP), L)
    lf = to_chunked_gates(jax.nn.log_sigmoid(softcap(f_pre.astype(f32) + f_bias.astype(f32), GATE_SOFTCAP)), L)
    b = jnp.cumsum(lf, axis=-1)
    causal = jnp.tril(jnp.ones((L, L), dtype=bool))
    dmat = jnp.where(causal, b[..., :, None] - b[..., None, :] + ig[..., None, :], -jnp.inf)
    m_intra = jnp.max(dmat, axis=-1)
    qk = jnp.einsum('bhnld,bhnsd->bhnls', q, k) * jnp.exp(dmat - m_intra[..., None])
    num_intra = jnp.einsum('bhnls,bhnse->bhnle', qk, v)
    den_intra = jnp.sum(qk, axis=-1)
    w_end = b[..., -1:] - b + ig
    m_chunk = jnp.max(w_end, axis=-1)
    e_end = jnp.exp(w_end - m_chunk[..., None])
    c_chunk = jnp.einsum('bhnl,bhnld,bhnle->bhnde', e_end, k, v)
    n_chunk = jnp.einsum('bhnl,bhnld->bhnd', e_end, k)
    b_last = b[..., -1]

    def step(carry, xs):
        c, n, m = carry
        q_c, b_c, mi_c, num_c, den_c, bl_c, mc_c, cc_c, nc_c = xs
        a = b_c + m[..., None]
        m_t = jnp.maximum(a, mi_c)
        s_inter = jnp.exp(a - m_t)
        s_intra = jnp.exp(mi_c - m_t)
        num = s_inter[..., None] * jnp.einsum('bhld,bhde->bhle', q_c, c) + s_intra[..., None] * num_c
        den = s_inter * jnp.einsum('bhld,bhd->bhl', q_c, n) + s_intra * den_c
        h = num / jnp.maximum(jnp.abs(den), jnp.exp(-m_t))[..., None]
        m_new = jnp.maximum(bl_c + m, mc_c)
        s_old = jnp.exp(bl_c + m - m_new)
        s_new = jnp.exp(mc_c - m_new)
        c = s_old[..., None, None] * c + s_new[..., None, None] * cc_c
        n = s_old[..., None] * n + s_new[..., None] * nc_c
        return (c, n, m_new), h

    xs = tuple(jnp.moveaxis(t, 2, 0) for t in (q, b, m_intra, num_intra, den_intra, b_last, m_chunk, c_chunk, n_chunk))
    init = (jnp.zeros((bsz, H, D, D), f32), jnp.zeros((bsz, H, D), f32), jnp.zeros((bsz, H), f32))
    _, h = lax.scan(step, init, xs)
    h = rms_norm(from_scan_heads(h), norm_w.reshape(H, D))
    h = h * jax.nn.sigmoid(o_pre.astype(f32).reshape(bsz, seq, H, D))
    return h.reshape(bsz, seq, H * D)


def sliding_window_attention(q, k, v, sinks, cos, sin):
    bsz, seq, _ = q.shape
    Hkv, G, D, T = SWA_KV_HEADS, SWA_GROUP, HEAD_DIM, SWA_BLOCK
    NB = seq // T
    q = apply_partial_rope(q.reshape(bsz, seq, Hkv, G, D), cos[:, :, None, None, :], sin[:, :, None, None, :])
    k = apply_partial_rope(k.reshape(bsz, seq, Hkv, D), cos[:, :, None, :], sin[:, :, None, :])
    v = v.reshape(bsz, seq, Hkv, D)
    qb = q.reshape(bsz, NB, T, Hkv, G, D)

    def band(t):
        tb = t.reshape(bsz, NB, T, Hkv, D)
        prev = jnp.pad(tb, ((0, 0), (1, 0), (0, 0), (0, 0), (0, 0)))[:, :-1]
        return jnp.concatenate([prev, tb], axis=2)

    kw, vw = band(k), band(v)
    s = jnp.einsum('bnqhgd,bnkhd->bnhgqk', qb, kw).astype(jnp.float32) * (D ** -0.5)
    qi = jnp.arange(T)[:, None] + T
    ki = jnp.arange(2 * T)[None, :]
    in_window = (ki <= qi) & (ki > qi - SWA_WINDOW)
    has_prev = (jnp.arange(NB) > 0)[:, None, None] | (ki >= T)[None]
    mask = in_window[None] & has_prev
    s = jnp.where(mask[None, :, None, None], s, -jnp.inf)
    sink = jnp.broadcast_to(sinks.astype(jnp.float32).reshape(1, 1, Hkv, G, 1, 1), s.shape[:-1] + (1,))
    probs = jax.nn.softmax(jnp.concatenate([s, sink], axis=-1), axis=-1)[..., :-1]
    out = jnp.einsum('bnhgqk,bnkhd->bnqhgd', probs.astype(v.dtype), vw)
    return out.reshape(bsz, seq, Hkv * G * D)


def setup_inputs(seed: int = 0) -> dict:
    key = jax.random.key(seed)
    ks = jax.random.split(key, 24)
    f32 = jnp.float32

    def nrm(k_, shape, scale):
        return jax.random.normal(k_, shape, f32) * scale

    def gain(k_, shape):
        return 1.0 + 0.02 * jax.random.normal(k_, shape, f32)

    x = jax.random.normal(ks[0], (BATCH, SEQ, D_MODEL), f32)
    p = jax.random.normal(ks[1], (DEPTH, BATCH, SEQ, PLE_DIM), f32)
    offsets = jax.random.randint(ks[2], (BATCH, 1), 0, 1024, dtype=jnp.int32)
    positions = offsets + jnp.arange(SEQ, dtype=jnp.int32)[None, :]
    w_in = nrm(ks[3], (DEPTH, D_MODEL, IN_COLS), D_MODEL ** -0.5)
    conv_w = nrm(ks[4], (DEPTH, CONV_WIDTH, 3 * GDN_WIDTH), CONV_WIDTH ** -0.5)
    gdn_a_log = jnp.log(jax.random.uniform(ks[5], (DEPTH, GDN_HEADS), f32, 1.0, 16.0))
    dt = jnp.exp(jax.random.uniform(ks[6], (DEPTH, GDN_HEADS), f32, np.log(1e-3), np.log(1e-1)))
    gdn_dt_bias = dt + jnp.log(-jnp.expm1(-dt))
    gdn_norm = gain(ks[7], (DEPTH, HEAD_DIM))
    mlstm_i_bias = nrm(ks[8], (DEPTH, MLSTM_HEADS), 0.1)
    mlstm_f_bias = jax.random.uniform(ks[9], (DEPTH, MLSTM_HEADS), f32, 3.0, 6.0)
    mlstm_norm = gain(ks[10], (DEPTH, MLSTM_WIDTH))
    attn_sinks = nrm(ks[11], (DEPTH, SWA_Q_HEADS), 0.5)
    w_out = nrm(ks[12], (DEPTH, MIX_WIDTH, D_MODEL), MIX_WIDTH ** -0.5)
    norm_mix = gain(ks[13], (DEPTH, D_MODEL))
    norm_mlp = gain(ks[14], (DEPTH, D_MODEL))
    w_up = nrm(ks[15], (DEPTH, D_MODEL, D_FF), D_MODEL ** -0.5)
    w_down = nrm(ks[16], (DEPTH, D_FF, D_MODEL), D_FF ** -0.5)
    norm_ple = gain(ks[17], (DEPTH, D_MODEL))
    w_ple_gate = nrm(ks[18], (DEPTH, D_MODEL, D_MODEL), D_MODEL ** -0.5)
    w_ple_proj = nrm(ks[19], (DEPTH, PLE_DIM, D_MODEL), PLE_DIM ** -0.5)
    norm_final = gain(ks[20], (D_MODEL,))
    return {'x': x, 'p': p, 'positions': positions, 'w_in': w_in, 'conv_w': conv_w,
            'gdn_a_log': gdn_a_log, 'gdn_dt_bias': gdn_dt_bias, 'gdn_norm': gdn_norm,
            'mlstm_i_bias': mlstm_i_bias, 'mlstm_f_bias': mlstm_f_bias, 'mlstm_norm': mlstm_norm,
            'attn_sinks': attn_sinks, 'w_out': w_out, 'norm_mix': norm_mix, 'norm_mlp': norm_mlp,
            'w_up': w_up, 'w_down': w_down, 'norm_ple': norm_ple, 'w_ple_gate': w_ple_gate,
            'w_ple_proj': w_ple_proj, 'norm_final': norm_final}


def reference(x, p, positions, w_in, conv_w, gdn_a_log, gdn_dt_bias, gdn_norm,
              mlstm_i_bias, mlstm_f_bias, mlstm_norm, attn_sinks, w_out, norm_mix, norm_mlp,
              w_up, w_down, norm_ple, w_ple_gate, w_ple_proj, norm_final):
    cos, sin = rope_tables(positions)
    for i in range(DEPTH):
        h = rms_norm(x, norm_mix[i])
        proj = jnp.einsum('bsd,dc->bsc', h, w_in[i])
        (gq, gk, gv, gz, gb, ga, mq, mk, mv, mo, mi, mf, sq, sk, sv) = split_cols(proj, IN_SPLITS)
        y_a = gated_delta_net(gq, gk, gv, gz, gb, ga, conv_w[i], gdn_a_log[i], gdn_dt_bias[i], gdn_norm[i])
        y_b = mlstm(mq, mk, mv, mo, mi, mf, mlstm_i_bias[i], mlstm_f_bias[i], mlstm_norm[i])
        y_c = sliding_window_attention(sq, sk, sv, attn_sinks[i], cos, sin)
        y = jnp.concatenate([y_a.astype(x.dtype), y_b.astype(x.dtype), y_c.astype(x.dtype)], axis=-1)
        x = x + jnp.einsum('bsc,cd->bsd', y, w_out[i])
        u = jnp.einsum('bsd,df->bsf', rms_norm(x, norm_mlp[i]), w_up[i])
        x = x + jnp.einsum('bsf,fd->bsd', jnp.square(jax.nn.relu(u)), w_down[i])
        gate = jax.nn.sigmoid(jnp.einsum('bsd,de->bse', rms_norm(x, norm_ple[i]), w_ple_gate[i]))
        x = x + gate * jnp.einsum('bsk,kd->bsd', p[i], w_ple_proj[i])
    return rms_norm(x, norm_final)
```

```cpp
#include <hip/hip_runtime.h>
#include <hip/hip_cooperative_groups.h>
#include <cstdio>
#include <cstdint>
#include <cmath>
namespace pg8 {
#define PG8_LAS __attribute__((address_space(3)))
typedef unsigned short bf16_t;
typedef short bf16x8 __attribute__((ext_vector_type(8)));
typedef float f32x4 __attribute__((ext_vector_type(4)));
typedef unsigned u32x4 __attribute__((ext_vector_type(4)));
constexpr int BM = 256, BK = 64, HALF = 128, HTB = HALF * BK * 2  , STAGE_BYTES = 8 * HTB, NXCD = 8, WGM = 8;

__host__ __device__ __forceinline__ int lds_byte(int r, int c) { const int st = (r >> 4) * 2 + (c >> 5), rr = r & 15, cc = c & 31, ob = rr * 64 + cc * 2; return st * 1024 + (ob ^ (((ob >> 9) & 1) << 5)); }
__host__ __device__ __forceinline__ void stage_rc(int b, int& R, int& C) { const int st = b / 1024, sb = b % 1024, swz = sb ^ (((sb >> 9) & 1) << 5); R = (st >> 1) * 16 + swz / 64; C = (st & 1) * 32 + (swz % 64) / 2; }
__host__ __device__ __forceinline__ int perm32(int rho) { const int n = rho >> 4, i = rho & 15; return 8 * (i >> 2) + 4 * n + (i & 3); }

struct Unit { int pm, pn; };
struct Gemm { const bf16_t* A; const bf16_t* Bt; int M, N, K; };

struct StaticOrder {
    int nM, nN, nwg, G, c;
    __host__ __device__ void init(int M, int N, int G_, int c_) { nM = M / BM; nN = N / BM; nwg = nM * nN; G = G_; c = c_; }
    __host__ __device__ bool next(int i, Unit& u) const {
        const long L = (long)i * G + c; if (L >= nwg) return false;
        int wgid = (int)L; { const int q = nwg / NXCD, r = nwg % NXCD, xcd = wgid % NXCD, off = wgid / NXCD; wgid = (xcd < r ? xcd * (q + 1) : r * (q + 1) + (xcd - r) * q) + off; }
        const int nig = WGM * nN, gid = wgid / nig, fm = gid * WGM, gsz = (nM - fm) < WGM ? (nM - fm) : WGM;
        u.pm = fm + ((wgid % nig) % gsz); u.pn = (wgid % nig) / gsz; return true;
    }
    __device__ __forceinline__ void a_ready(const Unit&) const {}
    __device__ __forceinline__ void done(const Unit&) const {}
};


__device__ __forceinline__ unsigned cvt_pk_bf16(float lo, float hi) { unsigned r; asm volatile("v_cvt_pk_bf16_f32 %0, %1, %2" : "=v"(r) : "v"(lo), "v"(hi)); return r; }
typedef unsigned u32x2 __attribute__((ext_vector_type(2)));
constexpr float RMS_EPS = 1e-6f;
__device__ __forceinline__ float row_rstd(const float* ssq, int row) {
    const f32x4* p = (const f32x4*)(ssq + (size_t)row * 16);
    const f32x4 a = p[0], b = p[1], c = p[2], d = p[3];
    const float s = ((a[0] + a[1]) + (a[2] + a[3])) + ((b[0] + b[1]) + (b[2] + b[3])) + ((c[0] + c[1]) + (c[2] + c[3])) + ((d[0] + d[1]) + (d[2] + d[3]));
    return 1.0f / sqrtf(s * (1.0f / 1024.0f) + RMS_EPS);
}
struct EpiAny {
    static constexpr bool PERM = true, AFTER_DRAIN = false;
    int mode; const float* ssq_in; float* ssq_out; const float* base; float* xout; bf16_t* ob; const bf16_t* pp; float* gates;
    __device__ __forceinline__ void operator()(const f32x4 (&acc)[2][2][4][2], const Unit& u, int wr, int wc, int fr, int fq) const {
        const int row0 = u.pm * BM + wr * 64 + fr; const int col0 = u.pn * BM + wc * 32 + 8 * fq;
        if (mode <= 1) {
            const int ld = mode == 0 ? 2816 : 4096;
            if (mode == 1 || u.pn < 11) {
#pragma unroll
                for (int ai = 0; ai < 2; ++ai)
#pragma unroll
                    for (int m = 0; m < 4; ++m) { const int row = row0 + ai * HALF + m * 16; const float rs = row_rstd(ssq_in, row); bf16_t* rowp = ob + (size_t)row * ld + col0;
#pragma unroll
                        for (int bj = 0; bj < 2; ++bj) { f32x4 v0 = acc[ai][bj][m][0] * rs, v1 = acc[ai][bj][m][1] * rs;
                            if (mode == 1) {
#pragma unroll
                                for (int e = 0; e < 4; ++e) { const float a = fmaxf(v0[e], 0.f), b = fmaxf(v1[e], 0.f); v0[e] = a * a; v1[e] = b * b; } }
                            u32x4 w; w.x = cvt_pk_bf16(v0[0], v0[1]); w.y = cvt_pk_bf16(v0[2], v0[3]); w.z = cvt_pk_bf16(v1[0], v1[1]); w.w = cvt_pk_bf16(v1[2], v1[3]);
                            *(u32x4*)(rowp + bj * HALF) = w; }
                        asm volatile("" ::: "memory"); }
            } else if (wc == 0 && fq < 2) {
#pragma unroll
                for (int ai = 0; ai < 2; ++ai)
#pragma unroll
                    for (int m = 0; m < 4; ++m) { const int row = row0 + ai * HALF + m * 16; const float rs = row_rstd(ssq_in, row); float* gp = gates + (size_t)row * 16 + 8 * fq;
                        *(f32x4*)(gp) = acc[ai][0][m][0] * rs; *(f32x4*)(gp + 4) = acc[ai][0][m][1] * rs; asm volatile("" ::: "memory"); }
            }
        } else if (mode == 2) {
#pragma unroll
            for (int ai = 0; ai < 2; ++ai)
#pragma unroll
                for (int m = 0; m < 4; ++m) { bf16_t* rowp = ob + (size_t)(row0 + ai * HALF + m * 16) * 1024 + col0;
#pragma unroll
                    for (int bj = 0; bj < 2; ++bj) { const f32x4 v0 = acc[ai][bj][m][0], v1 = acc[ai][bj][m][1];
                        u32x4 w; w.x = cvt_pk_bf16(v0[0], v0[1]); w.y = cvt_pk_bf16(v0[2], v0[3]); w.z = cvt_pk_bf16(v1[0], v1[1]); w.w = cvt_pk_bf16(v1[2], v1[3]);
                        *(u32x4*)(rowp + bj * HALF) = w; }
                    asm volatile("" ::: "memory"); }
        } else {
#pragma unroll
            for (int ai = 0; ai < 2; ++ai)
#pragma unroll
                for (int m = 0; m < 4; ++m) { const int row = row0 + ai * HALF + m * 16; const size_t off = (size_t)row * 1024 + col0;
                    const float* bp = base + off; float* xp = xout + off; bf16_t* op = ob + off; const bf16_t* ppp = pp + off;
                    float rs = 1.f; if (mode == 4) rs = row_rstd(ssq_in, row);
                    float s = 0.f;
#pragma unroll
                    for (int bj = 0; bj < 2; ++bj) {
                        f32x4 a0 = acc[ai][bj][m][0], a1 = acc[ai][bj][m][1];
                        const f32x4 b0 = *(const f32x4*)(bp + bj * HALF), b1 = *(const f32x4*)(bp + bj * HALF + 4);
                        if (mode == 4) { const u32x4 pw = *(const u32x4*)(ppp + bj * HALF);
                            const f32x4 p0 = (f32x4){__uint_as_float(pw.x << 16), __uint_as_float(pw.x & 0xffff0000u), __uint_as_float(pw.y << 16), __uint_as_float(pw.y & 0xffff0000u)}, p1 = (f32x4){__uint_as_float(pw.z << 16), __uint_as_float(pw.z & 0xffff0000u), __uint_as_float(pw.w << 16), __uint_as_float(pw.w & 0xffff0000u)};
#pragma unroll
                            for (int e = 0; e < 4; ++e) { a0[e] = p0[e] / (1.0f + __expf(-a0[e] * rs)); a1[e] = p1[e] / (1.0f + __expf(-a1[e] * rs)); } }
                        const f32x4 o0 = b0 + a0, o1 = b1 + a1;
                        *(f32x4*)(xp + bj * HALF) = o0; *(f32x4*)(xp + bj * HALF + 4) = o1;
                        u32x4 w; w.x = cvt_pk_bf16(o0[0], o0[1]); w.y = cvt_pk_bf16(o0[2], o0[3]); w.z = cvt_pk_bf16(o1[0], o1[1]); w.w = cvt_pk_bf16(o1[2], o1[3]);
                        *(u32x4*)(op + bj * HALF) = w;
                        s += ((o0[0] * o0[0] + o0[1] * o0[1]) + (o0[2] * o0[2] + o0[3] * o0[3])) + ((o1[0] * o1[0] + o1[1] * o1[1]) + (o1[2] * o1[2] + o1[3] * o1[3])); }
                    s += __int_as_float(__builtin_amdgcn_ds_bpermute(((fq ^ 1) * 16 + fr) << 2, __float_as_int(s))); s += __int_as_float(__builtin_amdgcn_ds_bpermute(((fq ^ 2) * 16 + fr) << 2, __float_as_int(s)));
                    if (fq == 0) ssq_out[(size_t)row * 16 + u.pn * 4 + wc] = s;
                    asm volatile("" ::: "memory"); }
        }
    }
};

template <class Epi, class Sched, bool ALIGN_EPI = false, bool SP2 = false>
__device__ __forceinline__ void gemm_phase(PG8_LAS unsigned char* lds, const Gemm g, const Sched& S, const Epi& E, int wave_id) {
    int tid_; asm volatile("v_mbcnt_lo_u32_b32 %0, -1, 0\n\tv_mbcnt_hi_u32_b32 %0, -1, %0" : "=v"(tid_)); tid_ += wave_id * 64; const int tid = tid_, wid = __builtin_amdgcn_readfirstlane(tid >> 6), lane = tid & 63, wr = wid >> 2, wc = wid & 3, fr = lane & 15, fq = lane >> 4;
    const int K = g.K, nt = K / BK;
    unsigned voffA[2], voffB[2];
#pragma unroll
    for (int i = 0; i < 2; ++i) { int R, C; stage_rc(tid * 16 + i * 8192, R, C); const int Rb = Epi::PERM ? ((R & ~31) + perm32(R & 31)) : R;
        voffA[i] = (unsigned)(R * K + C) * 2u; voffB[i] = (unsigned)(Rb * K + C) * 2u; }
    const size_t kstep = (size_t)(BK * 2);
    const size_t hstep = (size_t)HALF * K * 2;
    const size_t tstep = 2 * hstep;
    const unsigned ldsw = (unsigned)wid * 1024u;
    const int aoff = lds_byte(wr * 64 + fr, fq * 8), boff = lds_byte(wc * 32 + fr, fq * 8);
#define PG8_SA(b, h) (((b) * 2 + (h)) * HTB)
#define PG8_SB(b, h) ((4 + (b) * 2 + (h)) * HTB)
#define PG8_STAGE(bufoff, gbase, voff) do { _Pragma("unroll") for (int _i = 0; _i < 2; ++_i) \
        __builtin_amdgcn_global_load_lds((const unsigned*)((const char*)(gbase) + (voff)[_i]), (PG8_LAS unsigned*)(lds + (bufoff) + ldsw + _i * 8192), 16, 0, 0); } while (0)
#define PG8_LDA(dst, b, h) do { _Pragma("unroll") for (int m = 0; m < 4; ++m) _Pragma("unroll") for (int k = 0; k < 2; ++k) dst[m][k] = *(const PG8_LAS bf16x8*)(lds + PG8_SA(b, h) + aoff + m * 2048 + k * 1024); } while (0)
#define PG8_LDB(dst, b, h) do { _Pragma("unroll") for (int n = 0; n < 2; ++n) _Pragma("unroll") for (int k = 0; k < 2; ++k) dst[n][k] = *(const PG8_LAS bf16x8*)(lds + PG8_SB(b, h) + boff + n * 2048 + k * 1024); } while (0)
#define PG8_MMA(ai, bj, At, Bt) do { __builtin_amdgcn_s_setprio(1); _Pragma("unroll") for (int m = 0; m < 4; ++m) _Pragma("unroll") for (int n = 0; n < 2; ++n) _Pragma("unroll") for (int k = 0; k < 2; ++k) \
        acc[ai][bj][m][n] = __builtin_amdgcn_mfma_f32_16x16x32_bf16(Bt[n][k], At[m][k], acc[ai][bj][m][n], 0, 0, 0); __builtin_amdgcn_s_setprio(0); } while (0)
#define PG8_WAIT_V(n) asm volatile("s_waitcnt vmcnt(" #n ")" ::: "memory")
#define PG8_WAIT_L(n) asm volatile("s_waitcnt lgkmcnt(" #n ")" ::: "memory")
#define PG8_BAR __builtin_amdgcn_s_barrier()
#define PG8_SCHED __builtin_amdgcn_sched_barrier(0)
    Unit cur, nxt; int ui = 0;
    if (!S.next(0, cur)) return;
    f32x4 acc[2][2][4][2];
#pragma unroll
    for (int a = 0; a < 2; ++a)
#pragma unroll
        for (int b = 0; b < 2; ++b)
#pragma unroll
            for (int m = 0; m < 4; ++m)
#pragma unroll
                for (int n = 0; n < 2; ++n) acc[a][b][m][n] = (f32x4){0.f, 0.f, 0.f, 0.f};
    bf16x8 At[4][2], B0[2][2], B1[2][2];
    const char* cA = (const char*)g.A + (size_t)cur.pm * tstep; const char* cB = (const char*)g.Bt + (size_t)cur.pn * tstep;
    S.a_ready(cur);
    if constexpr (SP2) {
        PG8_STAGE(PG8_SB(0, 0), cB, voffB); PG8_STAGE(PG8_SB(0, 1), cB + hstep, voffB); PG8_STAGE(PG8_SA(0, 0), cA, voffA); PG8_STAGE(PG8_SA(0, 1), cA + hstep, voffA);
        if (wr == 1) PG8_BAR;
        PG8_WAIT_V(2); PG8_BAR;
        PG8_STAGE(PG8_SB(1, 0), cB + kstep, voffB); PG8_STAGE(PG8_SA(1, 0), cA + kstep, voffA); PG8_STAGE(PG8_SB(1, 1), cB + hstep + kstep, voffB);
        PG8_WAIT_V(6); PG8_BAR;
    } else {
        PG8_STAGE(PG8_SB(0, 0), cB, voffB); PG8_STAGE(PG8_SA(0, 0), cA, voffA); PG8_STAGE(PG8_SB(0, 1), cB + hstep, voffB); PG8_STAGE(PG8_SA(0, 1), cA + hstep, voffA);
        if (wr == 1) PG8_BAR;
        PG8_WAIT_V(4); PG8_BAR;
        PG8_STAGE(PG8_SB(1, 0), cB + kstep, voffB); PG8_STAGE(PG8_SA(1, 0), cA + kstep, voffA); PG8_STAGE(PG8_SB(1, 1), cB + hstep + kstep, voffB);
        PG8_WAIT_V(6); PG8_BAR;
    }
    for (;;) {
        const bool has_next = S.next(ui + 1, nxt);
        const char* nA = has_next ? (const char*)g.A + (size_t)nxt.pm * tstep : cA; const char* nB = has_next ? (const char*)g.Bt + (size_t)nxt.pn * tstep : cB;
        for (int t = 0; t < nt; t += 2) {
            const bool last = (t == nt - 2);
            const char* a1 = cA + (size_t)(t + 1) * kstep;
            const char* a2 = last ? nA : cA + (size_t)(t + 2) * kstep; const char* b2 = last ? nB : cB + (size_t)(t + 2) * kstep;
            const char* a3 = a2 + kstep; const char* b3 = b2 + kstep;
            if (last && has_next) S.a_ready(nxt);
            if constexpr (SP2) {
            PG8_LDB(B0, 0, 0); PG8_LDB(B1, 0, 1); PG8_SCHED; PG8_LDA(At, 0, 0); PG8_STAGE(PG8_SA(1, 1), a1 + hstep, voffA);
            PG8_WAIT_V(8); PG8_WAIT_L(0); PG8_BAR; PG8_MMA(0, 0, At, B0); PG8_MMA(0, 1, At, B1); PG8_BAR; PG8_SCHED;
            PG8_LDA(At, 0, 1); PG8_STAGE(PG8_SB(0, 0), b2, voffB); PG8_STAGE(PG8_SB(0, 1), b2 + hstep, voffB); PG8_STAGE(PG8_SA(0, 0), a2, voffA);
            PG8_WAIT_V(8); PG8_WAIT_L(0); PG8_BAR; PG8_MMA(1, 0, At, B0); PG8_MMA(1, 1, At, B1); PG8_BAR; PG8_SCHED;
            PG8_LDB(B0, 1, 0); PG8_LDB(B1, 1, 1); PG8_SCHED; PG8_LDA(At, 1, 0); PG8_STAGE(PG8_SA(0, 1), a2 + hstep, voffA);
            PG8_WAIT_V(8); PG8_WAIT_L(0); PG8_BAR; PG8_MMA(0, 0, At, B0); PG8_MMA(0, 1, At, B1); PG8_BAR; PG8_SCHED;
            PG8_LDA(At, 1, 1); PG8_STAGE(PG8_SB(1, 0), b3, voffB); PG8_STAGE(PG8_SB(1, 1), b3 + hstep, voffB); PG8_STAGE(PG8_SA(1, 0), a3, voffA);
            PG8_WAIT_V(8); PG8_WAIT_L(0); PG8_BAR; PG8_MMA(1, 0, At, B0); PG8_MMA(1, 1, At, B1); PG8_BAR; PG8_SCHED;
            } else {
            PG8_LDB(B0, 0, 0); PG8_SCHED; PG8_LDA(At, 0, 0); PG8_STAGE(PG8_SA(1, 1), a1 + hstep, voffA);
            PG8_WAIT_L(8); PG8_BAR; PG8_WAIT_L(0); PG8_MMA(0, 0, At, B0); PG8_BAR; PG8_SCHED;
            PG8_LDB(B1, 0, 1); PG8_STAGE(PG8_SB(0, 0), b2, voffB);
            PG8_BAR; PG8_WAIT_L(0); PG8_MMA(0, 1, At, B1); PG8_BAR;
            PG8_LDA(At, 0, 1); PG8_STAGE(PG8_SA(0, 0), a2, voffA);
            PG8_BAR; PG8_WAIT_L(0); PG8_MMA(1, 0, At, B0); PG8_BAR; PG8_SCHED;
            PG8_STAGE(PG8_SB(0, 1), b2 + hstep, voffB);
            PG8_WAIT_V(6); PG8_BAR; PG8_MMA(1, 1, At, B1); PG8_BAR;
            PG8_LDB(B0, 1, 0); PG8_SCHED; PG8_LDA(At, 1, 0); PG8_STAGE(PG8_SA(0, 1), a2 + hstep, voffA);
            PG8_WAIT_L(8); PG8_BAR; PG8_WAIT_L(0); PG8_MMA(0, 0, At, B0); PG8_BAR; PG8_SCHED;
            PG8_LDB(B1, 1, 1); PG8_STAGE(PG8_SB(1, 0), b3, voffB);
            PG8_BAR; PG8_WAIT_L(0); PG8_MMA(0, 1, At, B1); PG8_BAR;
            PG8_LDA(At, 1, 1); PG8_STAGE(PG8_SA(1, 0), a3, voffA);
            PG8_BAR; PG8_WAIT_L(0); PG8_MMA(1, 0, At, B0); PG8_BAR; PG8_SCHED;
            PG8_STAGE(PG8_SB(1, 1), b3 + hstep, voffB);
            PG8_WAIT_V(6); PG8_BAR; PG8_MMA(1, 1, At, B1); PG8_BAR;
            }
        }
        if constexpr (ALIGN_EPI) { if (wr == 0) PG8_BAR; }
        if constexpr (!Epi::AFTER_DRAIN) { E(acc, cur, wr, wc, fr, fq); S.done(cur); }
        if (!has_next) break;
#pragma unroll
        for (int a = 0; a < 2; ++a)
#pragma unroll
            for (int b = 0; b < 2; ++b)
#pragma unroll
                for (int m = 0; m < 4; ++m)
#pragma unroll
                    for (int n = 0; n < 2; ++n) acc[a][b][m][n] = (f32x4){0.f, 0.f, 0.f, 0.f};
        cur = nxt; cA = nA; cB = nB; ++ui;
        if constexpr (ALIGN_EPI) { if (wr == 1) PG8_BAR; }
    }
    PG8_WAIT_V(0);
    if constexpr (!ALIGN_EPI) { if (wr == 0) PG8_BAR; }
    PG8_BAR;
    if constexpr (Epi::AFTER_DRAIN) { E.fused(acc, cur, wr, wc, fr, fq, lds, wid, lane); S.done(cur); }
#undef PG8_SA
#undef PG8_SB
#undef PG8_STAGE
#undef PG8_LDA
#undef PG8_LDB
#undef PG8_MMA
#undef PG8_WAIT_V
#undef PG8_WAIT_L
#undef PG8_BAR
#undef PG8_SCHED
}
}

namespace cg = cooperative_groups;
#define LAS __attribute__((address_space(3)))
typedef unsigned short bf16;
typedef float f32x4 __attribute__((ext_vector_type(4)));
typedef float f32x16 __attribute__((ext_vector_type(16)));
typedef short bf16x8 __attribute__((ext_vector_type(8)));
typedef short s16x4 __attribute__((ext_vector_type(4)));
typedef unsigned u32x4 __attribute__((ext_vector_type(4)));
typedef unsigned u32x2 __attribute__((ext_vector_type(2)));

constexpr int NWAVES = 8, NTHR = 512;
constexpr int BATCH = 8, SEQ = 4096, DM = 1024, M = BATCH * SEQ, NL = 4, FF = 4096, PLE = 256;
constexpr int NPROJ = 2816, NPAD = 3072, INC = 2832;
constexpr float EPS = 1e-6f;
constexpr int LDS_BYTES = 147456;
constexpr int REP_MIX = 1, REP_G = 1, REP_BAR = 1;

constexpr size_t MiB = 1u << 20;
constexpr size_t W_LAYER = 27 * MiB;
constexpr size_t WO_IN = 0, WO_OUT = 6 * MiB, WO_UP = 8 * MiB, WO_DOWN = 16 * MiB, WO_G = 24 * MiB, WO_P = 26 * MiB;
constexpr size_t WS_W = 0;
constexpr size_t WS_XB = 108 * MiB;
constexpr size_t WS_SSQ = 172 * MiB;
constexpr size_t WS_ROPE = 178 * MiB;
constexpr size_t WS_GATES = 180 * MiB;
constexpr size_t WS_PB = 182 * MiB;
constexpr size_t WS_QKVC = 198 * MiB;
constexpr size_t WS_BIG = 246 * MiB;
constexpr size_t WS_MISC = 502 * MiB;
constexpr size_t WS_END = 503 * MiB;
constexpr size_t WS_MLB = WS_XB;
constexpr int GU_W = 0, GU_QD = 4096, GU_KD = 8192, GU_U = 12288, GU_QK = 16384, GU_STRIDE = 19456;
constexpr int GDN_NA = 1724;
constexpr int WAVE_LDS = 18432;
constexpr int MU_QB = 0, MU_PT = 4096, MU_KW = 8192, MU_VB = 12288, MU_STRIDE = 16384;

struct Args { const void* in[21]; float* out; unsigned char* ws; };

struct Frame {
    LAS unsigned char* lds;
    int tid, lane, wave, G, gw, ngw;
};
typedef const __attribute__((address_space(4))) void* kptr_t;
__device__ __forceinline__ const void* karg(int i) {
    kptr_t kp = (kptr_t)__builtin_amdgcn_kernarg_segment_ptr();
    asm volatile("" : "+s"(kp));
    return ((const void* const __attribute__((address_space(4)))*)kp)[i];
}
__device__ __forceinline__ int lane_id_asm();
__device__ __forceinline__ Frame relaunder(const Frame& f) {
    Frame r = f;
    r.lane = lane_id_asm(); r.tid = r.wave * 64 + r.lane;
    asm volatile("" : "+v"(r.tid), "+v"(r.lane));
    asm volatile("" : "+s"(r.wave), "+s"(r.gw), "+s"(r.ngw), "+s"(r.G));
    return r;
}
#define IN_F(i) ((const float*)karg(i))
#define OUTP ((float*)karg(21))
#define WSP ((unsigned char*)karg(22))

__device__ __forceinline__ float bf2f(unsigned short b) { return __uint_as_float((unsigned)b << 16); }
__device__ __forceinline__ unsigned f2bf(float f) { unsigned u = __float_as_uint(f); return (u + 0x7fffu + ((u >> 16) & 1u)) >> 16; }
__device__ __forceinline__ unsigned pk2(float lo, float hi) { return f2bf(lo) | (f2bf(hi) << 16); }
__device__ __forceinline__ float lo_bf(unsigned w) { return __uint_as_float(w << 16); }
__device__ __forceinline__ float hi_bf(unsigned w) { return __uint_as_float(w & 0xffff0000u); }
__device__ __forceinline__ int lane_id_asm() { int l; asm volatile("v_mbcnt_lo_u32_b32 %0, -1, 0\n\tv_mbcnt_hi_u32_b32 %0, -1, %0" : "=v"(l)); return l; }
__device__ __forceinline__ float xshfl(float v, int src_lane) { return __int_as_float(__builtin_amdgcn_ds_bpermute(src_lane << 2, __float_as_int(v))); }
__device__ __forceinline__ unsigned xshflu(unsigned v, int src_lane) { return (unsigned)__builtin_amdgcn_ds_bpermute(src_lane << 2, (int)v); }
__device__ __forceinline__ float wave_sum(float v, int lane) {
#pragma unroll
    for (int o = 1; o < 64; o <<= 1) v += xshfl(v, lane ^ o);
    return v;
}
#define LDS_WAIT() asm volatile("s_waitcnt lgkmcnt(0)" ::: "memory")
__device__ __forceinline__ float sigmoidf_(float x) { return 1.0f / (1.0f + __expf(-x)); }
__device__ __forceinline__ float softplusf_(float x) { return fmaxf(x, 0.f) + log1pf(__expf(-fabsf(x))); }
__device__ __forceinline__ float sum8(float v) {
    v += __int_as_float(__builtin_amdgcn_update_dpp(0, __float_as_int(v), 0xB1, 0xF, 0xF, true));
    v += __int_as_float(__builtin_amdgcn_update_dpp(0, __float_as_int(v), 0x4E, 0xF, 0xF, true));
    v += __int_as_float(__builtin_amdgcn_update_dpp(0, __float_as_int(v), 0x141, 0xF, 0xF, true));
    return v;
}

__device__ __forceinline__ int win_src_col(int n) {
    if (n < 1024) return n;
    if (n < 2048) return n + 8;
    if (n < 2816) return n + 16;
    if (n < 2824) return 1024 + (n - 2816);
    if (n < 2832) return 2056 + (n - 2824);
    return -1;
}
template <int MAP>
__device__ __forceinline__ void transpose_item(const float* W, int K, int N, bf16* WT, const float* gain, LAS float* scr, int kb, int nb, int lane) {
    const int k0 = 64 * kb, n0 = 32 * nb;
    const int nd = n0 + (lane & 31);
    const int ns = MAP ? win_src_col(nd) : nd;
#pragma unroll 8
    for (int i = 0; i < 32; ++i) { const int kk = 2 * i + (lane >> 5); float v = 0.f; if (ns >= 0) v = W[(size_t)(k0 + kk) * N + ns]; if (gain) v *= gain[k0 + kk]; scr[kk * 33 + (lane & 31)] = v; }
    LDS_WAIT(); asm volatile("" ::: "memory");
    const int c = lane & 7;
#pragma unroll
    for (int j = 0; j < 4; ++j) { const int n = (lane >> 3) + 8 * j; const LAS float* s = scr + (8 * c) * 33 + n;
        u32x4 o; o.x = pk2(s[0 * 33], s[1 * 33]); o.y = pk2(s[2 * 33], s[3 * 33]); o.z = pk2(s[4 * 33], s[5 * 33]); o.w = pk2(s[6 * 33], s[7 * 33]);
        *(u32x4*)(WT + (size_t)(n0 + n) * K + k0 + 8 * c) = o; }
    LDS_WAIT(); asm volatile("" ::: "memory");
}
__device__ __forceinline__ void convert_weights(const Frame& F_in, int l, int blk0) {
    const Frame F = relaunder(F_in);
    unsigned char* const L_ws = WSP; const float* const L_w_in = IN_F(3); const float* const L_w_out = IN_F(12); const float* const L_w_up = IN_F(15); const float* const L_w_down = IN_F(16); const float* const L_w_g = IN_F(18); const float* const L_w_p = IN_F(19);
    const float* const L_norm_mix = IN_F(13); const float* const L_norm_mlp = IN_F(14); const float* const L_norm_ple = IN_F(17);
    LAS float* scr = (LAS float*)(F.lds + F.wave * 16384);
    constexpr int I_IN = 16 * 96, I_OUT = 16 * 32, I_UP = 16 * 128, I_DOWN = 64 * 32, I_G = 16 * 32, I_P = 4 * 32;
    constexpr int I_LAYER = I_IN + I_OUT + I_UP + I_DOWN + I_G + I_P;
    unsigned char* wb = L_ws + WS_W + (size_t)l * W_LAYER;
    for (int it = F.gw - blk0 * NWAVES; it < I_LAYER; it += F.ngw - blk0 * NWAVES) {
        int r = it;
        if (r < I_IN) { transpose_item<1>(L_w_in + (size_t)l * DM * INC, DM, INC, (bf16*)(wb + WO_IN), L_norm_mix + l * DM, scr, r / 96, r % 96, F.lane); continue; } r -= I_IN;
        if (r < I_OUT) { transpose_item<0>(L_w_out + (size_t)l * DM * DM, DM, DM, (bf16*)(wb + WO_OUT), nullptr, scr, r / 32, r % 32, F.lane); continue; } r -= I_OUT;
        if (r < I_UP) { transpose_item<0>(L_w_up + (size_t)l * DM * FF, DM, FF, (bf16*)(wb + WO_UP), L_norm_mlp + l * DM, scr, r / 128, r % 128, F.lane); continue; } r -= I_UP;
        if (r < I_DOWN) { transpose_item<0>(L_w_down + (size_t)l * FF * DM, FF, DM, (bf16*)(wb + WO_DOWN), nullptr, scr, r / 32, r % 32, F.lane); continue; } r -= I_DOWN;
        if (r < I_G) { transpose_item<0>(L_w_g + (size_t)l * DM * DM, DM, DM, (bf16*)(wb + WO_G), L_norm_ple + l * DM, scr, r / 32, r % 32, F.lane); continue; } r -= I_G;
        transpose_item<0>(L_w_p + (size_t)l * PLE * DM, PLE, DM, (bf16*)(wb + WO_P), nullptr, scr, r / 32, r % 32, F.lane);
    }
}
__device__ __forceinline__ void p0_prologue(const Frame& F_in) {
    const Frame F = relaunder(F_in);
    unsigned char* const L_ws = WSP; const float* const L_in_x = IN_F(0); const int* const L_in_pos = (const int*)karg(2);
    bf16* const L_XB = (bf16*)(L_ws + WS_XB); float* const L_SSQ = (float*)(L_ws + WS_SSQ); float* const L_ROPE = (float*)(L_ws + WS_ROPE);
    for (int m = F.gw; m < M; m += F.ngw) {
        const f32x4* xr = (const f32x4*)(L_in_x + (size_t)m * DM) + F.lane; float s = 0.f;
        unsigned long long* o8 = (unsigned long long*)(L_XB + (size_t)m * DM) + F.lane;
#pragma unroll
        for (int j = 0; j < 4; ++j) { const f32x4 v = xr[64 * j]; s += (v[0] * v[0] + v[1] * v[1]) + (v[2] * v[2] + v[3] * v[3]);
            o8[64 * j] = (unsigned long long)pk2(v[0], v[1]) | ((unsigned long long)pk2(v[2], v[3]) << 32); }
        s = wave_sum(s, F.lane);
        if (F.lane < 16) L_SSQ[(size_t)m * 16 + F.lane] = (F.lane == 0) ? s : 0.f;
    }
    for (int i = F.gw * 64 + F.lane; i < M * 8; i += F.ngw * 64) {
        const int t = i >> 3, j = i & 7;
        const float inv = (float)exp(-(double)(2 * j) / 16.0 * 13.122363377404328);
        const float ang = (float)L_in_pos[t] * inv;
        const double a = (double)ang; const double rev = a * 0.15915494309189535; const double fr = rev - floor(rev + 0.5);
        const float rad = (float)(fr * 6.283185307179586);
        L_ROPE[i] = cosf(rad); L_ROPE[(size_t)M * 8 + i] = sinf(rad);
    }
}

#define MFMA16(a, b, c) __builtin_amdgcn_mfma_f32_16x16x32_bf16((a), (b), (c), 0, 0, 0)
__device__ __forceinline__ int kperm(int ks, int g, int j) { return 32 * ks + 16 * (j >> 2) + 4 * g + (j & 3); }
__device__ __forceinline__ bf16x8 pack_tiles(const f32x4& a, const f32x4& b) { u32x4 w; w.x = pk2(a[0], a[1]); w.y = pk2(a[2], a[3]); w.z = pk2(b[0], b[1]); w.w = pk2(b[2], b[3]); return __builtin_bit_cast(bf16x8, w); }

__device__ __forceinline__ bf16* gdn_ubuf(unsigned char* ws, int unit) {
    return unit < GDN_NA ? (bf16*)(ws + WS_PB) + (size_t)unit * GU_STRIDE : (bf16*)(ws + WS_BIG + 240 * MiB) + (size_t)(unit - GDN_NA) * GU_STRIDE;
}
__device__ __forceinline__ int qk_idx(int tt, int ks) { return tt < 2 ? tt : 2 + (tt - 2) * 2 + ks; }
__device__ __forceinline__ bf16x8 conv8(const bf16* PROJ, size_t tok, int sp, int ch0, const f32x4 (&w)[4][2]) {
    float a[8];
#pragma unroll
    for (int j = 0; j < 8; ++j) a[j] = 0.f;
#pragma unroll
    for (int tap = 0; tap < 4; ++tap) if (sp - 3 + tap >= 0) {
        const u32x4 raw = *(const u32x4*)(PROJ + (tok - 3 + tap) * NPROJ + ch0);
#pragma unroll
        for (int i = 0; i < 4; ++i) { a[2 * i] += w[tap][i >> 1][(2 * i) & 3] * lo_bf(raw[i]); a[2 * i + 1] += w[tap][i >> 1][(2 * i + 1) & 3] * hi_bf(raw[i]); }
    }
    u32x4 o;
#pragma unroll
    for (int i = 0; i < 4; ++i) o[i] = pk2(a[2 * i] * sigmoidf_(a[2 * i]), a[2 * i + 1] * sigmoidf_(a[2 * i + 1]));
    return __builtin_bit_cast(bf16x8, o);
}
__device__ __forceinline__ void solve64(float (&x)[64], const LAS float* Lm) {
#pragma unroll
    for (int c = 1; c < 64; ++c) {
        int one = 1; asm volatile("" : "+s"(one));
        if (one) {
            float a = x[c];
#pragma unroll
            for (int s4 = 0; s4 < (c + 3) / 4; ++s4) { const f32x4 lv = *(const LAS f32x4*)(Lm + c * 64 + 4 * s4);
#pragma unroll
                for (int i = 0; i < 4; ++i) if (4 * s4 + i < c) a -= lv[i] * x[4 * s4 + i]; }
            x[c] = a;
        }
    }
}
__device__ __forceinline__ void gdn_prep(const Frame& F_in, int l) {
    const Frame F = relaunder(F_in);
    unsigned char* const L_ws = WSP; const float* const cw = IN_F(4) + (size_t)l * 4 * 768; const float* const L_a_log = IN_F(5); const float* const L_dt_bias = IN_F(6);
    const bf16* const PROJ = (const bf16*)(L_ws + WS_BIG); const float* const GATES = (const float*)(L_ws + WS_GATES); float* const GL = (float*)(L_ws + WS_MISC) + 2048;
    LAS float* Lm = (LAS float*)(F.lds + F.wave * WAVE_LDS);
    LAS bf16* T = (LAS bf16*)Lm;
    LAS float* gcv = Lm + 4096; LAS float* bkv = gcv + 64; LAS float* rkv = gcv + 128; LAS float* qdf = gcv + 192; LAS float* wfv = gcv + 256; LAS float* kdf = gcv + 320; LAS float* btv = gcv + 384;
    int g, m, lane;
#define RELANE() do { int ln_ = F.lane; asm volatile("" : "+v"(ln_)); lane = ln_; g = ln_ >> 4; m = ln_ & 15; } while (0)
    for (int unit = F.gw; unit < 2048; unit += F.ngw) {
        RELANE();
        const int h = (unit >> 6) & 3, n = unit & 63; const size_t t0 = (size_t)(unit >> 8) * SEQ + (size_t)n * 64;
        bf16* const ub = gdn_ubuf(L_ws, unit);
        float gl, gc_own, beta_own;
        {
            const float* gr = GATES + (t0 + lane) * 16;
            beta_own = sigmoidf_(gr[h]);
            float gs = -__expf(L_a_log[l * 4 + h]) * softplusf_(gr[4 + h] + L_dt_bias[l * 4 + h]);
#pragma unroll
            for (int o = 1; o < 64; o <<= 1) { const float t = xshfl(gs, lane >= o ? lane - o : lane); if (lane >= o) gs += t; }
            gc_own = gs; gl = __int_as_float(__builtin_amdgcn_readlane(__float_as_int(gs), 63));
            gcv[lane] = gs; btv[lane] = beta_own;
        }
        RELANE();
        bf16x8 FQ[4][2], FK[4][2];
#pragma unroll
        for (int ks = 0; ks < 2; ++ks) {
            f32x4 wq[4][2], wk[4][2];
#pragma unroll
            for (int tap = 0; tap < 4; ++tap) { const float* wp = cw + tap * 768 + h * 64 + 32 * ks + 8 * g; wq[tap][0] = *(const f32x4*)wp; wq[tap][1] = *(const f32x4*)(wp + 4); wk[tap][0] = *(const f32x4*)(wp + 256); wk[tap][1] = *(const f32x4*)(wp + 260); }
#pragma unroll
            for (int mt = 0; mt < 4; ++mt) { int one_ = 1; asm volatile("" : "+s"(one_)); if (one_) {
                FQ[mt][ks] = conv8(PROJ, t0 + 16 * mt + m, 64 * n + 16 * mt + m, h * 64 + 32 * ks + 8 * g, wq);
                FK[mt][ks] = conv8(PROJ, t0 + 16 * mt + m, 64 * n + 16 * mt + m, 256 + h * 64 + 32 * ks + 8 * g, wk);
            } }
        }
        RELANE();
#pragma unroll
        for (int tt = 0; tt < 4; ++tt) {
            f32x4 ak = (f32x4){0.f, 0.f, 0.f, 0.f}, aq = ak;
            ak = MFMA16(FK[tt][0], FK[tt][0], ak); ak = MFMA16(FK[tt][1], FK[tt][1], ak);
            aq = MFMA16(FQ[tt][0], FQ[tt][0], aq); aq = MFMA16(FQ[tt][1], FQ[tt][1], aq);
            const int r = m & 3;
            const float dk_ = r == 0 ? ak[0] : r == 1 ? ak[1] : r == 2 ? ak[2] : ak[3];
            const float dq_ = r == 0 ? aq[0] : r == 1 ? aq[1] : r == 2 ? aq[2] : aq[3];
            if ((m >> 2) == g) { rkv[16 * tt + m] = 1.0f / sqrtf(dk_ + EPS); qdf[16 * tt + m] = 0.125f / sqrtf(dq_ + EPS); }
        }
        LDS_WAIT(); asm volatile("" ::: "memory");
        RELANE();
        {
            const float rk = rkv[lane], rq = qdf[lane];
            LDS_WAIT(); asm volatile("" ::: "memory");
            bkv[lane] = beta_own * rk; wfv[lane] = beta_own * rk * __expf(gc_own); kdf[lane] = rk * __expf(gl - gc_own); qdf[lane] = rq;
        }
        LDS_WAIT(); asm volatile("" ::: "memory");
        RELANE();
#pragma unroll
        for (int tt = 0; tt < 4; ++tt) { int one_ = 1; asm volatile("" : "+s"(one_)); if (one_) {
            const float gct = gcv[16 * tt + m], rqt = qdf[16 * tt + m];
#pragma unroll
            for (int ks = 0; ks < 2; ++ks) if (2 * ks <= tt) {
                u32x4 ow = (u32x4){0u, 0u, 0u, 0u};
#pragma unroll
                for (int hf = 0; hf < 2; ++hf) { const int st = 2 * ks + hf;
                    if (st <= tt) {
                        f32x4 acc = (f32x4){0.f, 0.f, 0.f, 0.f};
                        acc = MFMA16(FK[st][0], FQ[tt][0], acc); acc = MFMA16(FK[st][1], FQ[tt][1], acc);
                        const f32x4 gcs = *(const LAS f32x4*)(gcv + 16 * st + 4 * g), rks = *(const LAS f32x4*)(rkv + 16 * st + 4 * g);
                        float v[4];
#pragma unroll
                        for (int r = 0; r < 4; ++r) { const int sI = 16 * st + 4 * g + r, tI = 16 * tt + m; v[r] = (sI <= tI) ? acc[r] * rqt * rks[r] * __expf(gct - gcs[r]) : 0.f; }
                        ow[2 * hf] = pk2(v[0], v[1]); ow[2 * hf + 1] = pk2(v[2], v[3]);
                    } }
                *(u32x4*)(ub + GU_QK + (qk_idx(tt, ks) * 64 + lane) * 8) = ow;
            }
        } }
        RELANE();
#pragma unroll
        for (int mt = 0; mt < 4; ++mt)
#pragma unroll
            for (int ks = 0; ks < 2; ++ks) *(LAS bf16x8*)(T + (16 * mt + m) * 72 + 32 * ks + 8 * g) = FQ[mt][ks];
        LDS_WAIT(); asm volatile("" ::: "memory");
#pragma unroll
        for (int mt = 0; mt < 4; ++mt) {
            const float f = qdf[16 * mt + m] * __expf(gcv[16 * mt + m]);
#pragma unroll
            for (int ks = 0; ks < 2; ++ks) {
                const u32x2 lo = *(const LAS u32x2*)(T + (16 * mt + m) * 72 + 32 * ks + 4 * g), hi = *(const LAS u32x2*)(T + (16 * mt + m) * 72 + 32 * ks + 16 + 4 * g);
                u32x4 ow; ow.x = pk2(lo_bf(lo.x) * f, hi_bf(lo.x) * f); ow.y = pk2(lo_bf(lo.y) * f, hi_bf(lo.y) * f); ow.z = pk2(lo_bf(hi.x) * f, hi_bf(hi.x) * f); ow.w = pk2(lo_bf(hi.y) * f, hi_bf(hi.y) * f);
                *(u32x4*)(ub + GU_QD + ((mt * 2 + ks) * 64 + lane) * 8) = ow;
            }
        }
        LDS_WAIT(); asm volatile("" ::: "memory");
        RELANE();
        float xw[64];
        {
            const int chk = 256 + h * 64 + lane;
            const float k0 = cw[chk], k1 = cw[768 + chk], k2 = cw[1536 + chk], k3 = cw[2304 + chk];
            float ka = 0.f, kb = 0.f, kc = 0.f;
            if (n > 0) { ka = bf2f(PROJ[(t0 - 3) * NPROJ + chk]); kb = bf2f(PROJ[(t0 - 2) * NPROJ + chk]); kc = bf2f(PROJ[(t0 - 1) * NPROJ + chk]); }
            unsigned short kr[64];
#pragma unroll
            for (int c = 0; c < 64; ++c) kr[c] = PROJ[(t0 + c) * NPROJ + chk];
            asm volatile("" ::: "memory");
#pragma unroll
            for (int c4 = 0; c4 < 16; ++c4) {
                const f32x4 wf4 = *(const LAS f32x4*)(wfv + 4 * c4), kd4 = *(const LAS f32x4*)(kdf + 4 * c4);
                float kt[4];
#pragma unroll
                for (int i = 0; i < 4; ++i) { const int c = 4 * c4 + i; const float kd_ = bf2f(kr[c]);
                    float ak = k0 * ka + k1 * kb + k2 * kc + k3 * kd_; ak = ak * sigmoidf_(ak); ka = kb; kb = kc; kc = kd_;
                    xw[c] = ak * wf4[i]; kt[i] = ak * kd4[i]; }
                u32x2 w2; w2.x = pk2(kt[0], kt[1]); w2.y = pk2(kt[2], kt[3]);
                *(LAS u32x2*)(T + lane * 72 + 4 * c4) = w2;
            }
        }
        LDS_WAIT(); asm volatile("" ::: "memory");
        RELANE();
#pragma unroll
        for (int dt = 0; dt < 4; ++dt)
#pragma unroll
            for (int ks = 0; ks < 2; ++ks) {
                const u32x2 lo = *(const LAS u32x2*)(T + (16 * dt + m) * 72 + 32 * ks + 4 * g), hi = *(const LAS u32x2*)(T + (16 * dt + m) * 72 + 32 * ks + 16 + 4 * g);
                u32x4 ow; ow.x = lo.x; ow.y = lo.y; ow.z = hi.x; ow.w = hi.y;
                *(u32x4*)(ub + GU_KD + ((dt * 2 + ks) * 64 + lane) * 8) = ow;
            }
        LDS_WAIT(); asm volatile("" ::: "memory");
        RELANE();
#pragma unroll
        for (int ct = 0; ct < 4; ++ct) { int one_ = 1; asm volatile("" : "+s"(one_)); if (one_) {
            const f32x4 gcc = *(const LAS f32x4*)(gcv + 16 * ct + 4 * g), bkc = *(const LAS f32x4*)(bkv + 16 * ct + 4 * g);
#pragma unroll
            for (int st = 0; st <= ct; ++st) {
                f32x4 acc = (f32x4){0.f, 0.f, 0.f, 0.f};
                acc = MFMA16(FK[ct][0], FK[st][0], acc); acc = MFMA16(FK[ct][1], FK[st][1], acc);
                const float gcs = gcv[16 * st + m], rks = rkv[16 * st + m];
#pragma unroll
                for (int r = 0; r < 4; ++r) { const int cI = 16 * ct + 4 * g + r, sI = 16 * st + m; Lm[cI * 64 + sI] = (sI < cI) ? acc[r] * bkc[r] * rks * __expf(gcc[r] - gcs) : 0.f; }
            }
        } }
        LDS_WAIT(); asm volatile("" ::: "memory");
        __builtin_amdgcn_sched_barrier(0);
        solve64(xw, Lm);
        __builtin_amdgcn_sched_barrier(0);
        {
            RELANE();
            const int l5 = lane & 31, gp = (l5 >> 2) & 3, jj = ((l5 >> 4) << 2) | (l5 & 3);
            bf16* wp = ub + GU_W + (lane >> 5) * 512 + gp * 128 + jj;
#pragma unroll
            for (int c = 0; c < 64; ++c) wp[(c >> 4) * 1024 + (c & 15) * 8] = (bf16)f2bf(xw[c]);
        }
        __builtin_amdgcn_sched_barrier(0);
        RELANE();
        float xu[64];
        {
            const int chv = 512 + h * 64 + lane;
            const float v0 = cw[chv], v1 = cw[768 + chv], v2 = cw[1536 + chv], v3 = cw[2304 + chv];
            float va = 0.f, vb = 0.f, vc = 0.f;
            if (n > 0) { va = bf2f(PROJ[(t0 - 3) * NPROJ + chv]); vb = bf2f(PROJ[(t0 - 2) * NPROJ + chv]); vc = bf2f(PROJ[(t0 - 1) * NPROJ + chv]); }
            unsigned short vr[64];
#pragma unroll
            for (int c = 0; c < 64; ++c) vr[c] = PROJ[(t0 + c) * NPROJ + chv];
            asm volatile("" ::: "memory");
#pragma unroll
            for (int c4 = 0; c4 < 16; ++c4) {
                const f32x4 bt4 = *(const LAS f32x4*)(btv + 4 * c4);
#pragma unroll
                for (int i = 0; i < 4; ++i) { const int c = 4 * c4 + i; const float vd_ = bf2f(vr[c]);
                    float av = v0 * va + v1 * vb + v2 * vc + v3 * vd_; av = av * sigmoidf_(av); va = vb; vb = vc; vc = vd_;
                    xu[c] = av * bt4[i]; }
            }
        }
        __builtin_amdgcn_sched_barrier(0);
        solve64(xu, Lm);
        __builtin_amdgcn_sched_barrier(0);
        LDS_WAIT(); asm volatile("" ::: "memory");
        RELANE();
        {
            const int sl = lane >> 4, e = lane & 15;
#pragma unroll
            for (int mt = 0; mt < 4; ++mt)
#pragma unroll
                for (int gp = 0; gp < 4; ++gp) { const int c = 16 * mt + 4 * gp; u32x2 w2; w2.x = pk2(xu[c], xu[c + 1]); w2.y = pk2(xu[c + 2], xu[c + 3]);
                    *(u32x2*)(ub + GU_U + ((sl * 4 + mt) * 64 + gp * 16 + e) * 4) = w2; }
        }
        if (lane == 0) GL[unit] = __expf(gl);
        LDS_WAIT(); asm volatile("" ::: "memory");
    }
#undef RELANE
}
__device__ __forceinline__ void gdn_scan(const Frame& F_in, int task) {
    const Frame F = relaunder(F_in);
    unsigned char* const L_ws = WSP; bf16* const PROJ = (bf16*)(L_ws + WS_BIG); const float* const GL = (const float*)(L_ws + WS_MISC) + 2048;
    const int bh = task >> 2, sl = task & 3;
    const int b = bh >> 2, h = bh & 3, unit0 = b * 256 + h * 64;
    f32x4 St[4];
#pragma unroll
    for (int i = 0; i < 4; ++i) St[i] = (f32x4){0.f, 0.f, 0.f, 0.f};
    bf16x8 W[8], QD[8], KD[8], QK[6]; u32x2 U[4], UN[4]; float gl; int vz = 0; asm volatile("" : "+v"(vz));
    {
        const bf16* u0 = gdn_ubuf(L_ws, unit0) + F.lane * 8;
#pragma unroll
        for (int f = 0; f < 8; ++f) { W[f] = *(const bf16x8*)(u0 + GU_W + f * 512); QD[f] = *(const bf16x8*)(u0 + GU_QD + f * 512); KD[f] = *(const bf16x8*)(u0 + GU_KD + f * 512); }
#pragma unroll
        for (int f = 0; f < 6; ++f) QK[f] = *(const bf16x8*)(u0 + GU_QK + f * 512);
#pragma unroll
        for (int mt = 0; mt < 4; ++mt) U[mt] = *(const u32x2*)(u0 - F.lane * 8 + GU_U + ((sl * 4 + mt) * 64 + F.lane) * 4);
        gl = GL[unit0 + vz];
    }
#pragma unroll 1
    for (int n = 0; n < 64; ++n) {
        const int nn = n < 63 ? n + 1 : 63;
        int ln_ = F.lane; asm volatile("" : "+v"(ln_)); const int g = ln_ >> 4, e = ln_ & 15;
        const bf16* un = gdn_ubuf(L_ws, unit0 + nn) + ln_ * 8;
        const float cgl = gl; gl = GL[unit0 + nn + vz];
#pragma unroll
        for (int mt = 0; mt < 4; ++mt) UN[mt] = *(const u32x2*)(un - ln_ * 8 + GU_U + ((sl * 4 + mt) * 64 + ln_) * 4);
        const bf16x8 SB0 = pack_tiles(St[0], St[1]), SB1 = pack_tiles(St[2], St[3]);
        const size_t t0 = (size_t)b * SEQ + (size_t)n * 64;
        f32x4 vn[4];
#pragma unroll
        for (int tt = 0; tt < 4; ++tt) {
            f32x4 ws_ = (f32x4){0.f, 0.f, 0.f, 0.f};
            ws_ = MFMA16(W[tt * 2], SB0, ws_); ws_ = MFMA16(W[tt * 2 + 1], SB1, ws_);
            W[tt * 2] = *(const bf16x8*)(un + GU_W + (tt * 2) * 512); W[tt * 2 + 1] = *(const bf16x8*)(un + GU_W + (tt * 2 + 1) * 512);
            vn[tt] = (f32x4){lo_bf(U[tt].x), hi_bf(U[tt].x), lo_bf(U[tt].y), hi_bf(U[tt].y)} - ws_;
        }
        const bf16x8 VB0 = pack_tiles(vn[0], vn[1]), VB1 = pack_tiles(vn[2], vn[3]);
#pragma unroll
        for (int tt = 0; tt < 4; ++tt) {
            f32x4 o = (f32x4){0.f, 0.f, 0.f, 0.f};
            o = MFMA16(QD[tt * 2], SB0, o); o = MFMA16(QD[tt * 2 + 1], SB1, o);
            QD[tt * 2] = *(const bf16x8*)(un + GU_QD + (tt * 2) * 512); QD[tt * 2 + 1] = *(const bf16x8*)(un + GU_QD + (tt * 2 + 1) * 512);
            o = MFMA16(QK[qk_idx(tt, 0)], VB0, o); QK[qk_idx(tt, 0)] = *(const bf16x8*)(un + GU_QK + qk_idx(tt, 0) * 512);
            if (tt >= 2) { o = MFMA16(QK[qk_idx(tt, 1)], VB1, o); QK[qk_idx(tt, 1)] = *(const bf16x8*)(un + GU_QK + qk_idx(tt, 1) * 512); }
#pragma unroll
            for (int r = 0; r < 4; ++r) PROJ[(t0 + 16 * tt + 4 * g + r) * NPROJ + 512 + h * 64 + 16 * sl + e] = (bf16)f2bf(o[r]);
        }
#pragma unroll
        for (int dt = 0; dt < 4; ++dt) { f32x4 c = St[dt] * cgl; c = MFMA16(KD[dt * 2], VB0, c); c = MFMA16(KD[dt * 2 + 1], VB1, c); St[dt] = c;
            KD[dt * 2] = *(const bf16x8*)(un + GU_KD + (dt * 2) * 512); KD[dt * 2 + 1] = *(const bf16x8*)(un + GU_KD + (dt * 2 + 1) * 512); }
#pragma unroll
        for (int mt = 0; mt < 4; ++mt) U[mt] = UN[mt];
    }
}

__device__ __forceinline__ void mlstm_prep(const Frame& F_in, int l) {
    const Frame F = relaunder(F_in);
    unsigned char* const L_ws = WSP; const float* const L_i_bias = IN_F(8); const float* const L_f_bias = IN_F(9);
    const bf16* const PROJ = (const bf16*)(L_ws + WS_BIG); const float* const GATES = (const float*)(L_ws + WS_GATES); float* const FL = (float*)(L_ws + WS_MISC);
    LAS float* bvec = (LAS float*)(F.lds + F.wave * WAVE_LDS); LAS float* avec = bvec + 64;
    const int g = F.lane >> 4, m = F.lane & 15;
    for (int unit = F.gw; unit < 2048; unit += F.ngw) {
        const int h = (unit >> 6) & 3; const size_t t0 = (size_t)(unit >> 8) * SEQ + (size_t)(unit & 63) * 64;
        bf16* const ub = (bf16*)(L_ws + WS_MLB) + (size_t)unit * MU_STRIDE;
        float bl;
        {
            const float* gr = GATES + (t0 + F.lane) * 16;
            const float iv = 15.0f * tanhf((gr[8 + h] + L_i_bias[l * 4 + h]) * (1.0f / 15.0f));
            const float c = 15.0f * tanhf((gr[12 + h] + L_f_bias[l * 4 + h]) * (1.0f / 15.0f));
            float bs = -softplusf_(-c);
#pragma unroll
            for (int o = 1; o < 64; o <<= 1) { const float t = xshfl(bs, F.lane >= o ? F.lane - o : F.lane); if (F.lane >= o) bs += t; }
            bl = __int_as_float(__builtin_amdgcn_readlane(__float_as_int(bs), 63));
            bvec[F.lane] = bs; avec[F.lane] = iv - bs;
        }
        LDS_WAIT(); asm volatile("" ::: "memory");
        const bf16* qrow = PROJ + (t0 + m) * NPROJ + 1024 + h * 64;
        bf16x8 FQ[4][2], FK[4][2];
#pragma unroll
        for (int mt = 0; mt < 4; ++mt)
#pragma unroll
            for (int ks = 0; ks < 2; ++ks) { FQ[mt][ks] = *(const bf16x8*)(qrow + (size_t)(16 * mt) * NPROJ + 32 * ks + 8 * g); FK[mt][ks] = *(const bf16x8*)(qrow + (size_t)(16 * mt) * NPROJ + 256 + 32 * ks + 8 * g); }
#pragma unroll
        for (int tt = 0; tt < 4; ++tt) {
            const float bt = bvec[16 * tt + m];
#pragma unroll
            for (int ks = 0; ks < 2; ++ks) {
                u32x4 ow = (u32x4){0u, 0u, 0u, 0u};
#pragma unroll
                for (int hf = 0; hf < 2; ++hf) { const int st = 2 * ks + hf;
                    if (st <= tt) {
                        f32x4 acc = (f32x4){0.f, 0.f, 0.f, 0.f};
                        acc = MFMA16(FK[st][0], FQ[tt][0], acc); acc = MFMA16(FK[st][1], FQ[tt][1], acc);
                        const f32x4 av = *(const LAS f32x4*)(avec + 16 * st + 4 * g);
                        float v[4];
#pragma unroll
                        for (int r = 0; r < 4; ++r) { const int sI = 16 * st + 4 * g + r, tI = 16 * tt + m; v[r] = (sI <= tI) ? acc[r] * 0.125f * __expf(bt + av[r]) : 0.f; }
                        ow[2 * hf] = pk2(v[0], v[1]); ow[2 * hf + 1] = pk2(v[2], v[3]);
                    } }
                *(u32x4*)(ub + MU_PT + ((tt * 2 + ks) * 64 + F.lane) * 8) = ow;
            }
        }
#pragma unroll
        for (int mt = 0; mt < 4; ++mt) {
            const float f = __expf(bvec[16 * mt + m]);
#pragma unroll
            for (int ks = 0; ks < 2; ++ks) {
                const u32x2 lo = *(const u32x2*)(qrow + (size_t)(16 * mt) * NPROJ + 32 * ks + 4 * g), hi = *(const u32x2*)(qrow + (size_t)(16 * mt) * NPROJ + 32 * ks + 16 + 4 * g);
                u32x4 ow; ow.x = pk2(lo_bf(lo.x) * f, hi_bf(lo.x) * f); ow.y = pk2(lo_bf(lo.y) * f, hi_bf(lo.y) * f); ow.z = pk2(lo_bf(hi.x) * f, hi_bf(hi.x) * f); ow.w = pk2(lo_bf(hi.y) * f, hi_bf(hi.y) * f);
                *(u32x4*)(ub + MU_QB + ((mt * 2 + ks) * 64 + F.lane) * 8) = ow;
            }
        }
#pragma unroll
        for (int ks = 0; ks < 2; ++ks) {
            const f32x4 a0 = *(const LAS f32x4*)(avec + 32 * ks + 4 * g), a1 = *(const LAS f32x4*)(avec + 32 * ks + 16 + 4 * g);
            float fac[8];
#pragma unroll
            for (int j = 0; j < 4; ++j) { fac[j] = 0.125f * __expf(bl + a0[j]); fac[4 + j] = 0.125f * __expf(bl + a1[j]); }
            const bf16* kcol = PROJ + (t0 + 32 * ks + 4 * g) * NPROJ + 1280 + h * 64 + m;
#pragma unroll
            for (int dt = 0; dt < 4; ++dt) {
                float kv[8];
#pragma unroll
                for (int j = 0; j < 8; ++j) kv[j] = bf2f(kcol[(size_t)(16 * (j >> 2) + (j & 3)) * NPROJ + 16 * dt]) * fac[j];
                u32x4 ow; ow.x = pk2(kv[0], kv[1]); ow.y = pk2(kv[2], kv[3]); ow.z = pk2(kv[4], kv[5]); ow.w = pk2(kv[6], kv[7]);
                *(u32x4*)(ub + MU_KW + ((dt * 2 + ks) * 64 + F.lane) * 8) = ow;
            }
#pragma unroll
            for (int sl = 0; sl < 4; ++sl) {
                unsigned short vv[8];
#pragma unroll
                for (int j = 0; j < 8; ++j) vv[j] = kcol[(size_t)(16 * (j >> 2) + (j & 3)) * NPROJ + 256 + 16 * sl];
                u32x4 ow; ow.x = vv[0] | ((unsigned)vv[1] << 16); ow.y = vv[2] | ((unsigned)vv[3] << 16); ow.z = vv[4] | ((unsigned)vv[5] << 16); ow.w = vv[6] | ((unsigned)vv[7] << 16);
                *(u32x4*)(ub + MU_VB + ((sl * 2 + ks) * 64 + F.lane) * 8) = ow;
            }
        }
        if (F.lane == 0) FL[unit] = __expf(bl);
        LDS_WAIT(); asm volatile("" ::: "memory");
    }
}
__device__ __forceinline__ void mlstm_scan(const Frame& F_in, int task) {
    const Frame F = relaunder(F_in);
    unsigned char* const L_ws = WSP; bf16* const PROJ = (bf16*)(L_ws + WS_BIG); float* const GATES = (float*)(L_ws + WS_GATES); const float* const FL = (const float*)(L_ws + WS_MISC);
    const int bh = task / 5, sl = task % 5;
    const int b = bh >> 2, h = bh & 3;
    const bf16* ub0 = (const bf16*)(L_ws + WS_MLB) + (size_t)(b * 256 + h * 64) * MU_STRIDE; const bf16* ub = ub0 + F.lane * 8;
    const u32x4 ones = (u32x4){0x3f803f80u, 0x3f803f80u, 0x3f803f80u, 0x3f803f80u};
    f32x4 Ct[4];
#pragma unroll
    for (int i = 0; i < 4; ++i) Ct[i] = (f32x4){0.f, 0.f, 0.f, 0.f};
    bf16x8 QB[8], PT[8], KW[8], VB[2], VN[2]; float fl;
#define ML_VB(dst, n_) do { const bf16* u_ = ub + (size_t)(n_) * MU_STRIDE; if (sl < 4) { dst[0] = *(const bf16x8*)(u_ + MU_VB + (sl * 2) * 512); dst[1] = *(const bf16x8*)(u_ + MU_VB + (sl * 2 + 1) * 512); } else { dst[0] = __builtin_bit_cast(bf16x8, ones); dst[1] = dst[0]; } } while (0)
#pragma unroll
    for (int f = 0; f < 8; ++f) { QB[f] = *(const bf16x8*)(ub + MU_QB + f * 512); PT[f] = *(const bf16x8*)(ub + MU_PT + f * 512); KW[f] = *(const bf16x8*)(ub + MU_KW + f * 512); }
    int vz = 0; asm volatile("" : "+v"(vz)); ML_VB(VB, 0); fl = FL[b * 256 + h * 64 + vz];
#pragma unroll 1
    for (int n = 0; n < 64; ++n) {
        const int nn = n < 63 ? n + 1 : 63;
        int ln_ = F.lane; asm volatile("" : "+v"(ln_)); const int g = ln_ >> 4, e = ln_ & 15;
        const bf16* un = ub0 + ln_ * 8 + (size_t)nn * MU_STRIDE;
        const float cfl = fl; fl = FL[b * 256 + h * 64 + nn + vz];
        ML_VB(VN, nn);
        const bf16x8 CB0 = pack_tiles(Ct[0], Ct[1]), CB1 = pack_tiles(Ct[2], Ct[3]);
        const size_t t0 = (size_t)b * SEQ + (size_t)n * 64;
#pragma unroll
        for (int tt = 0; tt < 4; ++tt) {
            f32x4 o = (f32x4){0.f, 0.f, 0.f, 0.f};
            o = MFMA16(QB[tt * 2], CB0, o); o = MFMA16(QB[tt * 2 + 1], CB1, o); o = MFMA16(PT[tt * 2], VB[0], o); o = MFMA16(PT[tt * 2 + 1], VB[1], o);
            QB[tt * 2] = *(const bf16x8*)(un + MU_QB + (tt * 2) * 512); QB[tt * 2 + 1] = *(const bf16x8*)(un + MU_QB + (tt * 2 + 1) * 512);
            PT[tt * 2] = *(const bf16x8*)(un + MU_PT + (tt * 2) * 512); PT[tt * 2 + 1] = *(const bf16x8*)(un + MU_PT + (tt * 2 + 1) * 512);
            if (sl < 4) {
#pragma unroll
                for (int r = 0; r < 4; ++r) PROJ[(t0 + 16 * tt + 4 * g + r) * NPROJ + 1536 + h * 64 + 16 * sl + e] = (bf16)f2bf(o[r]);
            } else if (e == 0) {
#pragma unroll
                for (int r = 0; r < 4; ++r) GATES[(t0 + 16 * tt + 4 * g + r) * 16 + 8 + h] = o[r];
            }
        }
#pragma unroll
        for (int dt = 0; dt < 4; ++dt) { f32x4 c = Ct[dt] * cfl; c = MFMA16(KW[dt * 2], VB[0], c); c = MFMA16(KW[dt * 2 + 1], VB[1], c); Ct[dt] = c;
            KW[dt * 2] = *(const bf16x8*)(un + MU_KW + (dt * 2) * 512); KW[dt * 2 + 1] = *(const bf16x8*)(un + MU_KW + (dt * 2 + 1) * 512); }
        VB[0] = VN[0]; VB[1] = VN[1];
    }
#undef ML_VB
}

__device__ __forceinline__ float sum16(float v) {
    v += __int_as_float(__builtin_amdgcn_update_dpp(0, __float_as_int(v), 0xB1, 0xF, 0xF, true));
    v += __int_as_float(__builtin_amdgcn_update_dpp(0, __float_as_int(v), 0x4E, 0xF, 0xF, true));
    v += __int_as_float(__builtin_amdgcn_update_dpp(0, __float_as_int(v), 0x141, 0xF, 0xF, true));
    v += __int_as_float(__builtin_amdgcn_update_dpp(0, __float_as_int(v), 0x140, 0xF, 0xF, true));
    return v;
}
__device__ __forceinline__ void m2_post(const Frame& F_in, int l) {
    const Frame F = relaunder(F_in);
    unsigned char* const L_ws = WSP;
    {
        const f32x4* ps = (const f32x4*)(IN_F(1) + (size_t)l * M * PLE); u32x2* pb = (u32x2*)(L_ws + WS_PB);
        const int stride = F.ngw * 64;
        for (int i = F.gw * 64 + F.lane; i < M * PLE / 4; i += 4 * stride) {
            f32x4 v[4];
#pragma unroll
            for (int u = 0; u < 4; ++u) v[u] = ps[i + u * stride];
#pragma unroll
            for (int u = 0; u < 4; ++u) { u32x2 w; w.x = pk2(v[u][0], v[u][1]); w.y = pk2(v[u][2], v[u][3]); pb[i + u * stride] = w; }
        }
    }
    const bf16* const PROJ = (const bf16*)(L_ws + WS_BIG); bf16* const Y = (bf16*)(L_ws + WS_BIG + 176 * MiB); const float* const GATES = (const float*)(L_ws + WS_GATES);
    const f32x4 gn = *(const f32x4*)(IN_F(7) + l * 64 + ((4 * F.lane) & 63)), mn = *(const f32x4*)(IN_F(10) + l * 256 + 4 * F.lane);
    for (int t = F.gw * 4; t < M; t += F.ngw * 4) {
        u32x2 og[4], zg[4], om[4], pm[4]; float dn[4];
#pragma unroll
        for (int u = 0; u < 4; ++u) { const bf16* row = PROJ + (size_t)(t + u) * NPROJ + 4 * F.lane;
            og[u] = *(const u32x2*)(row + 512); zg[u] = *(const u32x2*)(row + 768); om[u] = *(const u32x2*)(row + 1536); pm[u] = *(const u32x2*)(row + 1792);
            dn[u] = GATES[(size_t)(t + u) * 16 + 8 + (F.lane >> 4)]; }
#pragma unroll
        for (int u = 0; u < 4; ++u) {
            float o[4] = {lo_bf(og[u].x), hi_bf(og[u].x), lo_bf(og[u].y), hi_bf(og[u].y)}, z[4] = {lo_bf(zg[u].x), hi_bf(zg[u].x), lo_bf(zg[u].y), hi_bf(zg[u].y)};
            float rs = 1.0f / sqrtf(sum16((o[0] * o[0] + o[1] * o[1]) + (o[2] * o[2] + o[3] * o[3])) * (1.0f / 64.0f) + EPS);
            float y[4];
#pragma unroll
            for (int i = 0; i < 4; ++i) y[i] = o[i] * rs * gn[i] * (z[i] * sigmoidf_(z[i]));
            u32x2 w; w.x = pk2(y[0], y[1]); w.y = pk2(y[2], y[3]);
            *(u32x2*)(Y + (size_t)(t + u) * DM + 4 * F.lane) = w;
            const float inv = 1.0f / fmaxf(fabsf(dn[u]), 1.0f);
            float hm[4] = {lo_bf(om[u].x) * inv, hi_bf(om[u].x) * inv, lo_bf(om[u].y) * inv, hi_bf(om[u].y) * inv}, p[4] = {lo_bf(pm[u].x), hi_bf(pm[u].x), lo_bf(pm[u].y), hi_bf(pm[u].y)};
            rs = 1.0f / sqrtf(sum16((hm[0] * hm[0] + hm[1] * hm[1]) + (hm[2] * hm[2] + hm[3] * hm[3])) * (1.0f / 64.0f) + EPS);
#pragma unroll
            for (int i = 0; i < 4; ++i) y[i] = hm[i] * rs * mn[i] * sigmoidf_(p[i]);
            w.x = pk2(y[0], y[1]); w.y = pk2(y[2], y[3]);
            *(u32x2*)(Y + (size_t)(t + u) * DM + 256 + 4 * F.lane) = w;
        }
    }
}

__device__ __forceinline__ int crow(int reg, int h) { return (reg & 3) + 8 * (reg >> 2) + 4 * h; }
__device__ __forceinline__ void swa_phase(const Frame& F_in, int l, int blk0) {
    const Frame F = relaunder(F_in);
    unsigned char* const L_ws = WSP; const float* const L_sinks = IN_F(11); const bf16* const L_PROJ = (const bf16*)(L_ws + WS_BIG); bf16* const L_Y = (bf16*)(L_ws + WS_BIG + 176 * MiB); const float* const L_ROPE = (const float*)(L_ws + WS_ROPE);
    LAS bf16* Ks = (LAS bf16*)F.lds;
    LAS bf16* Vt = (LAS bf16*)(F.lds + 36864);
    const float* COS = L_ROPE; const float* SIN = L_ROPE + (size_t)M * 8;
    const int r = F.lane & 31, h = F.lane >> 5;
    for (int unit = (int)blockIdx.x - blk0; unit < 512; unit += F.G - blk0) {
        const int b = unit >> 6, kvh = (unit >> 5) & 1, nb = unit & 31;
        const int tok0 = b * SEQ + nb * 128;
        __syncthreads();
        {
            const int key = F.tid >> 1, half = F.tid & 1; const int tok = tok0 - 128 + key; const bool valid = (nb > 0) || (key >= 128);
            u32x4 kq[4], vq[4];
#pragma unroll
            for (int i = 0; i < 4; ++i) { kq[i] = (u32x4){0u, 0u, 0u, 0u}; vq[i] = (u32x4){0u, 0u, 0u, 0u}; }
            if (valid) {
                const bf16* ksrc = L_PROJ + (size_t)tok * NPROJ + 2560 + kvh * 64 + half * 32;
                const bf16* vsrc = L_PROJ + (size_t)tok * NPROJ + 2688 + kvh * 64 + half * 32;
#pragma unroll
                for (int i = 0; i < 4; ++i) { kq[i] = *(const u32x4*)(ksrc + 8 * i); vq[i] = *(const u32x4*)(vsrc + 8 * i); }
                if (half == 0) {
                    const f32x4 c0 = *(const f32x4*)(COS + (size_t)tok * 8), c1 = *(const f32x4*)(COS + (size_t)tok * 8 + 4);
                    const f32x4 s0 = *(const f32x4*)(SIN + (size_t)tok * 8), s1 = *(const f32x4*)(SIN + (size_t)tok * 8 + 4);
                    float x1[8], x2[8], cs[8], sn[8];
#pragma unroll
                    for (int i = 0; i < 4; ++i) { x1[2 * i] = lo_bf(kq[0][i]); x1[2 * i + 1] = hi_bf(kq[0][i]); x2[2 * i] = lo_bf(kq[1][i]); x2[2 * i + 1] = hi_bf(kq[1][i]); cs[i] = c0[i]; cs[4 + i] = c1[i]; sn[i] = s0[i]; sn[4 + i] = s1[i]; }
#pragma unroll
                    for (int i = 0; i < 4; ++i) {
                        kq[0][i] = pk2(x1[2 * i] * cs[2 * i] - x2[2 * i] * sn[2 * i], x1[2 * i + 1] * cs[2 * i + 1] - x2[2 * i + 1] * sn[2 * i + 1]);
                        kq[1][i] = pk2(x2[2 * i] * cs[2 * i] + x1[2 * i] * sn[2 * i], x2[2 * i + 1] * cs[2 * i + 1] + x1[2 * i + 1] * sn[2 * i + 1]); }
                }
            }
#pragma unroll
            for (int i = 0; i < 4; ++i) *(LAS u32x4*)(Ks + key * 72 + half * 32 + 8 * i) = kq[i];
#pragma unroll
            for (int i = 0; i < 4; ++i)
#pragma unroll
                for (int e = 0; e < 4; ++e) { const int d = half * 32 + 8 * i + 2 * e; Vt[d * 264 + key] = (bf16)(vq[i][e] & 0xffffu); Vt[(d + 1) * 264 + key] = (bf16)(vq[i][e] >> 16); }
        }
        __syncthreads();
        const int g = F.wave >> 1, qhalf = F.wave & 1, qh = kvh * 4 + g;
        const float sink = L_sinks[l * 8 + qh];
#pragma unroll 1
        for (int sub = 0; sub < 2; ++sub) {
            const int q0 = qhalf * 64 + sub * 32;
            const int qtok = tok0 + q0 + r;
            bf16x8 qf[4];
            {
                const bf16* qsrc = L_PROJ + (size_t)qtok * NPROJ + 2048 + qh * 64 + 8 * h;
                u32x4 qw[4];
#pragma unroll
                for (int ks = 0; ks < 4; ++ks) qw[ks] = *(const u32x4*)(qsrc + 16 * ks);
                const f32x4 c0 = *(const f32x4*)(COS + (size_t)qtok * 8), c1 = *(const f32x4*)(COS + (size_t)qtok * 8 + 4);
                const f32x4 s0 = *(const f32x4*)(SIN + (size_t)qtok * 8), s1 = *(const f32x4*)(SIN + (size_t)qtok * 8 + 4);
                float cs[8], sn[8];
#pragma unroll
                for (int i = 0; i < 4; ++i) { cs[i] = c0[i]; cs[4 + i] = c1[i]; sn[i] = s0[i]; sn[4 + i] = s1[i]; }
                u32x4 ow;
#pragma unroll
                for (int i = 0; i < 4; ++i) ow[i] = xshflu(qw[0][i], F.lane ^ 32);
                const float sg = h ? 1.0f : -1.0f;
#pragma unroll
                for (int i = 0; i < 4; ++i) {
                    const float a0 = lo_bf(qw[0][i]), a1 = hi_bf(qw[0][i]), b0 = lo_bf(ow[i]), b1 = hi_bf(ow[i]);
                    qw[0][i] = pk2((a0 * cs[2 * i] + sg * b0 * sn[2 * i]) * 0.125f, (a1 * cs[2 * i + 1] + sg * b1 * sn[2 * i + 1]) * 0.125f); }
#pragma unroll
                for (int ks = 1; ks < 4; ++ks)
#pragma unroll
                    for (int i = 0; i < 4; ++i) qw[ks][i] = pk2(lo_bf(qw[ks][i]) * 0.125f, hi_bf(qw[ks][i]) * 0.125f);
#pragma unroll
                for (int ks = 0; ks < 4; ++ks) qf[ks] = __builtin_bit_cast(bf16x8, qw[ks]);
            }
            f32x16 sc[5];
#pragma unroll
            for (int kb = 0; kb < 5; ++kb) {
                f32x16 a;
#pragma unroll
                for (int i = 0; i < 16; ++i) a[i] = 0.f;
#pragma unroll
                for (int ks = 0; ks < 4; ++ks) { const bf16x8 kf = *(const LAS bf16x8*)(Ks + (q0 + 32 * kb + r) * 72 + 16 * ks + 8 * h); a = __builtin_amdgcn_mfma_f32_32x32x16_bf16(kf, qf[ks], a, 0, 0, 0); }
                sc[kb] = a;
            }
            float mx = sink;
#pragma unroll
            for (int kb = 0; kb < 5; ++kb)
#pragma unroll
                for (int i = 0; i < 16; ++i) { const int kr = 32 * kb + crow(i, h); const bool ok = (kr > r) && (kr <= r + 128) && ((nb > 0) || (q0 + kr >= 128));
                    const float s = ok ? sc[kb][i] : -INFINITY; sc[kb][i] = s; mx = fmaxf(mx, s); }
            mx = fmaxf(mx, xshfl(mx, F.lane ^ 32));
            float ls = 0.f;
#pragma unroll
            for (int kb = 0; kb < 5; ++kb)
#pragma unroll
                for (int i = 0; i < 16; ++i) { const float p = __expf(sc[kb][i] - mx); sc[kb][i] = p; ls += p; }
            ls += xshfl(ls, F.lane ^ 32);
            ls += __expf(sink - mx);
            const float inv = 1.0f / ls;
            f32x16 o[2];
#pragma unroll
            for (int db = 0; db < 2; ++db) {
                f32x16 a;
#pragma unroll
                for (int i = 0; i < 16; ++i) a[i] = 0.f;
#pragma unroll
                for (int kb = 0; kb < 5; ++kb)
#pragma unroll
                    for (int s = 0; s < 2; ++s) {
                        u32x4 pw;
#pragma unroll
                        for (int i = 0; i < 4; ++i) pw[i] = pk2(sc[kb][8 * s + 2 * i], sc[kb][8 * s + 2 * i + 1]);
                        const LAS bf16* vb = Vt + (db * 32 + r) * 264 + q0 + 32 * kb + 16 * s + 4 * h;
                        const s16x4 lo = *(const LAS s16x4*)vb, hi = *(const LAS s16x4*)(vb + 8);
                        const bf16x8 vf = __builtin_shufflevector(lo, hi, 0, 1, 2, 3, 4, 5, 6, 7);
                        a = __builtin_amdgcn_mfma_f32_32x32x16_bf16(vf, __builtin_bit_cast(bf16x8, pw), a, 0, 0, 0);
                    }
                o[db] = a;
            }
            bf16* yp = L_Y + (size_t)qtok * DM + 512 + qh * 64;
#pragma unroll
            for (int db = 0; db < 2; ++db)
#pragma unroll
                for (int gg = 0; gg < 4; ++gg) { u32x2 w; w.x = pk2(o[db][4 * gg] * inv, o[db][4 * gg + 1] * inv); w.y = pk2(o[db][4 * gg + 2] * inv, o[db][4 * gg + 3] * inv);
                    *(u32x2*)(yp + db * 32 + 8 * gg + 4 * h) = w; }
        }
    }
    __syncthreads();
}

__device__ __forceinline__ void final_norm(const Frame& F_in) {
    const Frame F = relaunder(F_in);
    float* const L_out = OUTP; const float* const L_norm_final = IN_F(20);
    for (int m = F.gw; m < M; m += F.ngw) {
        f32x4* xr = (f32x4*)(L_out + (size_t)m * DM) + F.lane; const f32x4* gr = (const f32x4*)L_norm_final + F.lane;
        f32x4 v[4]; float s = 0.f;
#pragma unroll
        for (int j = 0; j < 4; ++j) { v[j] = xr[64 * j]; s += (v[j][0] * v[j][0] + v[j][1] * v[j][1]) + (v[j][2] * v[j][2] + v[j][3] * v[j][3]); }
        const float rs = 1.0f / sqrtf(wave_sum(s, F.lane) * (1.0f / DM) + EPS);
#pragma unroll
        for (int j = 0; j < 4; ++j) xr[64 * j] = v[j] * rs * gr[64 * j];
    }
}

#define RLX_AGENT __ATOMIC_RELAXED, __HIP_MEMORY_SCOPE_AGENT
#define XB_TMO      128
#define XB_XCNT(j)  (256  + 64 * (j))
#define XB_XSUB(j)  (1280 + 64 * (j))
#define XB_XGEN(j)  (2304 + 64 * (j))
#define XB_TOP      3328
#define XB_TOPGEN   3392
#define XCD_BAR_WORDS 3456
#define XB_SPIN_CAP (1u << 18)

__device__ __forceinline__ unsigned xb_ld(unsigned* p)              { return __hip_atomic_load(p, __ATOMIC_RELAXED, __HIP_MEMORY_SCOPE_AGENT); }
__device__ __forceinline__ unsigned xb_add(unsigned* p, unsigned v) { return __hip_atomic_fetch_add(p, v, __ATOMIC_RELAXED, __HIP_MEMORY_SCOPE_AGENT); }
__device__ __forceinline__ unsigned xb_xcc_id() { return (unsigned)__builtin_amdgcn_s_getreg((3 << 11) | 20) & 0xFu; }
#define XB_SPIN(cond, bar) do { unsigned _sp = 0; while (cond) { __builtin_amdgcn_s_sleep(1); \
    if ((++_sp & 255u) == 0u) { if (xb_ld(&(bar)[XB_TMO])) break; if (_sp > XB_SPIN_CAP) { atomicAdd(&(bar)[XB_TMO], 1u); break; } } } } while (0)

struct XcdBarrier {
    unsigned* bar; unsigned x;
    volatile LAS unsigned* st;
};

__device__ __forceinline__ XcdBarrier xcd_barrier_post(unsigned* bar, volatile LAS unsigned* st, bool leader) {
    XcdBarrier b; b.bar = bar; b.x = xb_xcc_id(); b.st = st;
    if (leader) (void)xb_add(&bar[XB_XCNT(b.x)], 1u);
    return b;
}
__device__ __forceinline__ void xcd_barrier_complete(unsigned* bar, unsigned x, unsigned& nloc, unsigned& nx) {
    const unsigned G = gridDim.x * gridDim.y * gridDim.z;
    unsigned sum, cnt, mine, sp = 0u;
    for (;;) {
        sum = 0u; cnt = 0u; mine = 0u;
#pragma unroll
        for (unsigned j = 0; j < 16; ++j) { const unsigned c = xb_ld(&bar[XB_XCNT(j)]); sum += c; cnt += (c > 0u) ? 1u : 0u; mine = (j == x) ? c : mine; }
        if (sum == G) break;
        __builtin_amdgcn_s_sleep(1);
        if ((++sp & 255u) == 0u) { if (xb_ld(&bar[XB_TMO])) break; if (sp > XB_SPIN_CAP) { atomicAdd(&bar[XB_TMO], 1u); break; } }
    }
    nloc = mine > 0u ? mine : 1u; nx = cnt > 0u ? cnt : 1u;
}

__device__ __forceinline__ void xcd_barrier(const XcdBarrier& b, bool leader) {
    asm volatile("s_waitcnt vmcnt(0)" ::: "memory");
    __syncthreads();
    if (leader) {
        unsigned* bar = b.bar;
        __builtin_amdgcn_s_waitcnt(0);
        unsigned nloc = b.st[0], nx = b.st[1];
        if (nloc == 0u) { xcd_barrier_complete(bar, b.x, nloc, nx); b.st[0] = nloc; b.st[1] = nx; }
        const unsigned old = xb_add(&bar[XB_XSUB(b.x)], 1u);
        const unsigned gen = old / nloc;
        if (old + 1u == (gen + 1u) * nloc) {
            __builtin_amdgcn_fence(__ATOMIC_RELEASE, "agent");
            asm volatile("s_waitcnt vmcnt(0)" ::: "memory");
            const unsigned og = xb_add(&bar[XB_TOP], 1u);
            const unsigned tg = og / nx;
            if (og + 1u == (tg + 1u) * nx) xb_add(&bar[XB_TOPGEN], 1u);
            else XB_SPIN(xb_ld(&bar[XB_TOPGEN]) == tg, bar);
            __builtin_amdgcn_fence(__ATOMIC_ACQUIRE, "agent");
            xb_add(&bar[XB_XGEN(b.x)], 1u);
            asm volatile("s_waitcnt vmcnt(0)" ::: "memory");
        } else {
            XB_SPIN(xb_ld(&bar[XB_XGEN(b.x)]) == gen, bar);
            __builtin_amdgcn_fence(__ATOMIC_ACQUIRE, "agent");
            asm volatile("s_waitcnt vmcnt(0)" ::: "memory");
        }
    }
    __syncthreads();
}

__device__ __forceinline__ void gbar(const Frame& F_in, int) {
    XcdBarrier b; b.bar = (unsigned*)(WSP + WS_MISC + 65536); b.x = xb_xcc_id(); b.st = (volatile LAS unsigned*)(F_in.lds + LDS_BYTES);
    xcd_barrier(b, F_in.wave == 0 && lane_id_asm() == 0);
}

__global__ void __launch_bounds__(NTHR, 2) hybrid_fwd(Args args) {
    extern __shared__ __attribute__((aligned(16))) unsigned char lds[];
    cg::grid_group grid = cg::this_grid();
    Frame F;
    F.lds = (LAS unsigned char*)lds;
    F.wave = __builtin_amdgcn_readfirstlane((int)threadIdx.x >> 6); F.tid = 0; F.lane = 0;
    F.G = gridDim.x; F.gw = blockIdx.x * NWAVES + F.wave; F.ngw = F.G * NWAVES;

    volatile LAS unsigned* xst = (volatile LAS unsigned*)(F.lds + LDS_BYTES);
    if (threadIdx.x < 16) xst[threadIdx.x] = 0u;
    __syncthreads();
    const int xb = 0; (void)xcd_barrier_post((unsigned*)(WSP + WS_MISC + 65536), xst, F.wave == 0 && lane_id_asm() == 0);
    convert_weights(F, 0, 0);
    p0_prologue(F);
    grid.sync();
#pragma unroll 1
    for (int l = 0; l < NL; ++l) {
#pragma unroll 1
        for (int op = 0; op < 6; ++op) {
            if (op == 1) {
#pragma unroll 1
                for (int rep = 0; rep < REP_MIX; ++rep) {
                gbar(F, xb);
                gdn_prep(F, l);
                mlstm_prep(F, l);
                }
#pragma unroll 1
                for (int rep = 0; rep < REP_MIX; ++rep) {
                gbar(F, xb);
                if (blockIdx.x < 72) {
                    if (F.wave < 4) { int task = (int)blockIdx.x * 4 + F.wave; asm volatile("" : "+s"(task)); if (task < 128) gdn_scan(F, task); else mlstm_scan(F, task - 128); }
                } else { swa_phase(F, l, 72); if (l + 1 < NL) convert_weights(F, l + 1, 72); }
                }
#pragma unroll 1
                for (int rep = 0; rep < REP_MIX; ++rep) {
                gbar(F, xb);
                m2_post(F, l);
                }
            }
            if (op != 5 && (l | op) != 0) gbar(F, xb);
            unsigned char* const ws = WSP; unsigned char* const wb = ws + WS_W + (size_t)l * W_LAYER; float* const outp = OUTP;
            float* const ssq0 = (float*)(ws + WS_SSQ); float* const ssq1 = ssq0 + (size_t)M * 16; float* const ssq2 = ssq0 + (size_t)2 * M * 16;
            bf16* const xb = (bf16*)(ws + WS_XB); unsigned char* const big = ws + WS_BIG;
            pg8::Gemm g; pg8::EpiAny E; g.M = M;
            bf16* const xalt = (bf16*)(big + 192 * MiB);
            E.ssq_in = ssq0; E.ssq_out = ssq0; E.base = outp; E.xout = outp; E.ob = xb; E.pp = (const bf16*)big; E.gates = (float*)(ws + WS_GATES);
            if (op == 0)      { g.A = l == 0 ? xb : xalt; g.Bt = (const bf16*)(wb + WO_IN); g.N = NPAD; g.K = DM; E.mode = 0; E.ssq_in = ssq0; E.ob = (bf16*)big; }
            else if (op == 1) { g.A = (const bf16*)(big + 176 * MiB); g.Bt = (const bf16*)(wb + WO_OUT); g.N = DM; g.K = DM; E.mode = 3; E.ssq_out = ssq1; if (l == 0) E.base = IN_F(0); }
            else if (op == 2) { g.A = xb; g.Bt = (const bf16*)(wb + WO_UP); g.N = FF; g.K = DM; E.mode = 1; E.ssq_in = ssq1; E.ob = (bf16*)big; }
            else if (op == 3) { g.A = (const bf16*)big; g.Bt = (const bf16*)(wb + WO_DOWN); g.N = DM; g.K = FF; E.mode = 3; E.ssq_out = ssq2; }
            else if (op == 4) { g.A = (const bf16*)(ws + WS_PB); g.Bt = (const bf16*)(wb + WO_P); g.N = DM; g.K = PLE; E.mode = 2; E.ob = (bf16*)big; }
            else              { g.A = xb; g.Bt = (const bf16*)(wb + WO_G); g.N = DM; g.K = DM; E.mode = 4; E.ssq_in = ssq2; E.ssq_out = ssq0; E.ob = xalt; }
            pg8::StaticOrder S; S.init(M, g.N, F.G, (int)blockIdx.x);
#pragma unroll 1
            for (int rep = 0; rep < ((op == 0 || op == 2) ? REP_G : 1); ++rep)
            pg8::gemm_phase<pg8::EpiAny, pg8::StaticOrder, true, true>(F.lds, g, S, E, F.wave);
        }
    }
    gbar(F, xb);
    final_norm(F);
}

extern "C" void kernel_launch(void* const* d_in, const int* in_sizes, int n_in, void* d_out, int out_size, void* d_ws, size_t ws_size, hipStream_t stream) {
    static int grid = 0;
    if (grid == 0) {
        if (n_in != 21 || out_size != M * DM || ws_size < WS_END) { fprintf(stderr, "kernel_launch: unexpected shapes (n_in %d out %d ws %zu)\n", n_in, out_size, ws_size); grid = -1; return; }
        int dev = 0, cus = 0, per_cu = 0;
        hipGetDevice(&dev); hipDeviceGetAttribute(&cus, hipDeviceAttributeMultiprocessorCount, dev);
        hipFuncSetAttribute((const void*)hybrid_fwd, hipFuncAttributeMaxDynamicSharedMemorySize, LDS_BYTES + 64);
        hipOccupancyMaxActiveBlocksPerMultiprocessor(&per_cu, (const void*)hybrid_fwd, NTHR, LDS_BYTES + 64);
        (void)hipGetLastError();
        if (per_cu < 1) per_cu = 1;
        grid = cus;
        fprintf(stderr, "kernel_launch: cus %d per_cu %d grid %d ws %zu\n", cus, per_cu, grid, ws_size);
    }
    if (grid < 0) return;
    if (hipMemsetAsync((unsigned char*)d_ws + WS_MISC + 65536, 0, 16384, stream) != hipSuccess) { fprintf(stderr, "kernel_launch: memset failed\n"); return; }
    Args a{};
    for (int i = 0; i < 21; ++i) a.in[i] = d_in[i];
    a.out = (float*)d_out; a.ws = (unsigned char*)d_ws;
    void* kargs[] = {&a};
    hipError_t e = hipLaunchCooperativeKernel((const void*)hybrid_fwd, dim3(grid), dim3(NTHR), kargs, LDS_BYTES + 64, stream);
    if (e != hipSuccess) fprintf(stderr, "cooperative launch failed: %s (grid %d)\n", hipGetErrorString(e), grid);
}
```

```cpp
#include <hip/hip_runtime.h>
#include <hip/hip_cooperative_groups.h>
#include <cstdio>
#include <cstdint>
#include <cmath>
namespace pg8 {
#define PG8_LAS __attribute__((address_space(3)))
typedef unsigned short bf16_t;
typedef short bf16x8 __attribute__((ext_vector_type(8)));
typedef float f32x4 __attribute__((ext_vector_type(4)));
typedef unsigned u32x4 __attribute__((ext_vector_type(4)));
constexpr int BM = 256, BK = 64, HALF = 128, HTB = HALF * BK * 2  , STAGE_BYTES = 8 * HTB, NXCD = 8, WGM = 8;

__host__ __device__ __forceinline__ int lds_byte(int r, int c) { const int st = (r >> 4) * 2 + (c >> 5), rr = r & 15, cc = c & 31, ob = rr * 64 + cc * 2; return st * 1024 + (ob ^ (((ob >> 9) & 1) << 5)); }
__host__ __device__ __forceinline__ void stage_rc(int b, int& R, int& C) { const int st = b / 1024, sb = b % 1024, swz = sb ^ (((sb >> 9) & 1) << 5); R = (st >> 1) * 16 + swz / 64; C = (st & 1) * 32 + (swz % 64) / 2; }
__host__ __device__ __forceinline__ int perm32(int rho) { const int n = rho >> 4, i = rho & 15; return 8 * (i >> 2) + 4 * n + (i & 3); }

struct Unit { int pm, pn; };
struct Gemm { const bf16_t* A; const bf16_t* Bt; int M, N, K; };

struct StaticOrder {
    int nM, nN, nwg, G, c;
    __host__ __device__ void init(int M, int N, int G_, int c_) { nM = M / BM; nN = N / BM; nwg = nM * nN; G = G_; c = c_; }
    __host__ __device__ bool next(int i, Unit& u) const {
        const long L = (long)i * G + c; if (L >= nwg) return false;
        int wgid = (int)L; { const int q = nwg / NXCD, r = nwg % NXCD, xcd = wgid % NXCD, off = wgid / NXCD; wgid = (xcd < r ? xcd * (q + 1) : r * (q + 1) + (xcd - r) * q) + off; }
        const int nig = WGM * nN, gid = wgid / nig, fm = gid * WGM, gsz = (nM - fm) < WGM ? (nM - fm) : WGM;
        u.pm = fm + ((wgid % nig) % gsz); u.pn = (wgid % nig) / gsz; return true;
    }
    __device__ __forceinline__ void a_ready(const Unit&) const {}
    __device__ __forceinline__ void done(const Unit&) const {}
};


__device__ __forceinline__ unsigned cvt_pk_bf16(float lo, float hi) { unsigned r; asm volatile("v_cvt_pk_bf16_f32 %0, %1, %2" : "=v"(r) : "v"(lo), "v"(hi)); return r; }
typedef unsigned u32x2 __attribute__((ext_vector_type(2)));
constexpr float RMS_EPS = 1e-6f;
__device__ __forceinline__ float row_rstd(const float* ssq, int row) {
    const f32x4* p = (const f32x4*)(ssq + (size_t)row * 16);
    const f32x4 a = p[0], b = p[1], c = p[2], d = p[3];
    const float s = ((a[0] + a[1]) + (a[2] + a[3])) + ((b[0] + b[1]) + (b[2] + b[3])) + ((c[0] + c[1]) + (c[2] + c[3])) + ((d[0] + d[1]) + (d[2] + d[3]));
    return 1.0f / sqrtf(s * (1.0f / 1024.0f) + RMS_EPS);
}
struct EpiAny {
    static constexpr bool PERM = true, AFTER_DRAIN = false;
    int mode; const float* ssq_in; float* ssq_out; const float* base; float* xout; bf16_t* ob; const bf16_t* pp; float* gates;
    __device__ __forceinline__ void operator()(const f32x4 (&acc)[2][2][4][2], const Unit& u, int wr, int wc, int fr, int fq) const {
        const int row0 = u.pm * BM + wr * 64 + fr; const int col0 = u.pn * BM + wc * 32 + 8 * fq;
        if (mode <= 1) {
            const int ld = mode == 0 ? 2816 : 4096;
            if (mode == 1 || u.pn < 11) {
#pragma unroll
                for (int ai = 0; ai < 2; ++ai)
#pragma unroll
                    for (int m = 0; m < 4; ++m) { const int row = row0 + ai * HALF + m * 16; const float rs = row_rstd(ssq_in, row); bf16_t* rowp = ob + (size_t)row * ld + col0;
#pragma unroll
                        for (int bj = 0; bj < 2; ++bj) { f32x4 v0 = acc[ai][bj][m][0] * rs, v1 = acc[ai][bj][m][1] * rs;
                            if (mode == 1) {
#pragma unroll
                                for (int e = 0; e < 4; ++e) { const float a = fmaxf(v0[e], 0.f), b = fmaxf(v1[e], 0.f); v0[e] = a * a; v1[e] = b * b; } }
                            u32x4 w; w.x = cvt_pk_bf16(v0[0], v0[1]); w.y = cvt_pk_bf16(v0[2], v0[3]); w.z = cvt_pk_bf16(v1[0], v1[1]); w.w = cvt_pk_bf16(v1[2], v1[3]);
                            *(u32x4*)(rowp + bj * HALF) = w; }
                        asm volatile("" ::: "memory"); }
            } else if (wc == 0 && fq < 2) {
#pragma unroll
                for (int ai = 0; ai < 2; ++ai)
#pragma unroll
                    for (int m = 0; m < 4; ++m) { const int row = row0 + ai * HALF + m * 16; const float rs = row_rstd(ssq_in, row); float* gp = gates + (size_t)row * 16 + 8 * fq;
                        *(f32x4*)(gp) = acc[ai][0][m][0] * rs; *(f32x4*)(gp + 4) = acc[ai][0][m][1] * rs; asm volatile("" ::: "memory"); }
            }
        } else if (mode == 2) {
#pragma unroll
            for (int ai = 0; ai < 2; ++ai)
#pragma unroll
                for (int m = 0; m < 4; ++m) { bf16_t* rowp = ob + (size_t)(row0 + ai * HALF + m * 16) * 1024 + col0;
#pragma unroll
                    for (int bj = 0; bj < 2; ++bj) { const f32x4 v0 = acc[ai][bj][m][0], v1 = acc[ai][bj][m][1];
                        u32x4 w; w.x = cvt_pk_bf16(v0[0], v0[1]); w.y = cvt_pk_bf16(v0[2], v0[3]); w.z = cvt_pk_bf16(v1[0], v1[1]); w.w = cvt_pk_bf16(v1[2], v1[3]);
                        *(u32x4*)(rowp + bj * HALF) = w; }
                    asm volatile("" ::: "memory"); }
        } else {
#pragma unroll
            for (int ai = 0; ai < 2; ++ai)
#pragma unroll
                for (int m = 0; m < 4; ++m) { const int row = row0 + ai * HALF + m * 16; const size_t off = (size_t)row * 1024 + col0;
                    const float* bp = base + off; float* xp = xout + off; bf16_t* op = ob + off; const bf16_t* ppp = pp + off;
                    float rs = 1.f; if (mode == 4) rs = row_rstd(ssq_in, row);
                    float s = 0.f;
#pragma unroll
                    for (int bj = 0; bj < 2; ++bj) {
                        f32x4 a0 = acc[ai][bj][m][0], a1 = acc[ai][bj][m][1];
                        const f32x4 b0 = *(const f32x4*)(bp + bj * HALF), b1 = *(const f32x4*)(bp + bj * HALF + 4);
                        if (mode == 4) { const u32x4 pw = *(const u32x4*)(ppp + bj * HALF);
                            const f32x4 p0 = (f32x4){__uint_as_float(pw.x << 16), __uint_as_float(pw.x & 0xffff0000u), __uint_as_float(pw.y << 16), __uint_as_float(pw.y & 0xffff0000u)}, p1 = (f32x4){__uint_as_float(pw.z << 16), __uint_as_float(pw.z & 0xffff0000u), __uint_as_float(pw.w << 16), __uint_as_float(pw.w & 0xffff0000u)};
#pragma unroll
                            for (int e = 0; e < 4; ++e) { a0[e] = p0[e] / (1.0f + __expf(-a0[e] * rs)); a1[e] = p1[e] / (1.0f + __expf(-a1[e] * rs)); } }
                        const f32x4 o0 = b0 + a0, o1 = b1 + a1;
                        *(f32x4*)(xp + bj * HALF) = o0; *(f32x4*)(xp + bj * HALF + 4) = o1;
                        u32x4 w; w.x = cvt_pk_bf16(o0[0], o0[1]); w.y = cvt_pk_bf16(o0[2], o0[3]); w.z = cvt_pk_bf16(o1[0], o1[1]); w.w = cvt_pk_bf16(o1[2], o1[3]);
                        *(u32x4*)(op + bj * HALF) = w;
                        s += ((o0[0] * o0[0] + o0[1] * o0[1]) + (o0[2] * o0[2] + o0[3] * o0[3])) + ((o1[0] * o1[0] + o1[1] * o1[1]) + (o1[2] * o1[2] + o1[3] * o1[3])); }
                    s += __int_as_float(__builtin_amdgcn_ds_bpermute(((fq ^ 1) * 16 + fr) << 2, __float_as_int(s))); s += __int_as_float(__builtin_amdgcn_ds_bpermute(((fq ^ 2) * 16 + fr) << 2, __float_as_int(s)));
                    if (fq == 0) ssq_out[(size_t)row * 16 + u.pn * 4 + wc] = s;
                    asm volatile("" ::: "memory"); }
        }
    }
};

template <class Epi, class Sched, bool ALIGN_EPI = false, bool SP2 = false>
__device__ __forceinline__ void gemm_phase(PG8_LAS unsigned char* lds, const Gemm g, const Sched& S, const Epi& E, int wave_id) {
    int tid_; asm volatile("v_mbcnt_lo_u32_b32 %0, -1, 0\n\tv_mbcnt_hi_u32_b32 %0, -1, %0" : "=v"(tid_)); tid_ += wave_id * 64; const int tid = tid_, wid = __builtin_amdgcn_readfirstlane(tid >> 6), lane = tid & 63, wr = wid >> 2, wc = wid & 3, fr = lane & 15, fq = lane >> 4;
    const int K = g.K, nt = K / BK;
    unsigned voffA[2], voffB[2];
#pragma unroll
    for (int i = 0; i < 2; ++i) { int R, C; stage_rc(tid * 16 + i * 8192, R, C); const int Rb = Epi::PERM ? ((R & ~31) + perm32(R & 31)) : R;
        voffA[i] = (unsigned)(R * K + C) * 2u; voffB[i] = (unsigned)(Rb * K + C) * 2u; }
    const size_t kstep = (size_t)(BK * 2);
    const size_t hstep = (size_t)HALF * K * 2;
    const size_t tstep = 2 * hstep;
    const unsigned ldsw = (unsigned)wid * 1024u;
    const int aoff = lds_byte(wr * 64 + fr, fq * 8), boff = lds_byte(wc * 32 + fr, fq * 8);
#define PG8_SA(b, h) (((b) * 2 + (h)) * HTB)
#define PG8_SB(b, h) ((4 + (b) * 2 + (h)) * HTB)
#define PG8_STAGE(bufoff, gbase, voff) do { _Pragma("unroll") for (int _i = 0; _i < 2; ++_i) \
        __builtin_amdgcn_global_load_lds((const unsigned*)((const char*)(gbase) + (voff)[_i]), (PG8_LAS unsigned*)(lds + (bufoff) + ldsw + _i * 8192), 16, 0, 0); } while (0)
#define PG8_LDA(dst, b, h) do { _Pragma("unroll") for (int m = 0; m < 4; ++m) _Pragma("unroll") for (int k = 0; k < 2; ++k) dst[m][k] = *(const PG8_LAS bf16x8*)(lds + PG8_SA(b, h) + aoff + m * 2048 + k * 1024); } while (0)
#define PG8_LDB(dst, b, h) do { _Pragma("unroll") for (int n = 0; n < 2; ++n) _Pragma("unroll") for (int k = 0; k < 2; ++k) dst[n][k] = *(const PG8_LAS bf16x8*)(lds + PG8_SB(b, h) + boff + n * 2048 + k * 1024); } while (0)
#define PG8_MMA(ai, bj, At, Bt) do { __builtin_amdgcn_s_setprio(1); _Pragma("unroll") for (int m = 0; m < 4; ++m) _Pragma("unroll") for (int n = 0; n < 2; ++n) _Pragma("unroll") for (int k = 0; k < 2; ++k) \
        acc[ai][bj][m][n] = __builtin_amdgcn_mfma_f32_16x16x32_bf16(Bt[n][k], At[m][k], acc[ai][bj][m][n], 0, 0, 0); __builtin_amdgcn_s_setprio(0); } while (0)
#define PG8_WAIT_V(n) asm volatile("s_waitcnt vmcnt(" #n ")" ::: "memory")
#define PG8_WAIT_L(n) asm volatile("s_waitcnt lgkmcnt(" #n ")" ::: "memory")
#define PG8_BAR __builtin_amdgcn_s_barrier()
#define PG8_SCHED __builtin_amdgcn_sched_barrier(0)
    Unit cur, nxt; int ui = 0;
    if (!S.next(0, cur)) return;
    f32x4 acc[2][2][4][2];
#pragma unroll
    for (int a = 0; a < 2; ++a)
#pragma unroll
        for (int b = 0; b < 2; ++b)
#pragma unroll
            for (int m = 0; m < 4; ++m)
#pragma unroll
                for (int n = 0; n < 2; ++n) acc[a][b][m][n] = (f32x4){0.f, 0.f, 0.f, 0.f};
    bf16x8 At[4][2], B0[2][2], B1[2][2];
    const char* cA = (const char*)g.A + (size_t)cur.pm * tstep; const char* cB = (const char*)g.Bt + (size_t)cur.pn * tstep;
    S.a_ready(cur);
    if constexpr (SP2) {
        PG8_STAGE(PG8_SB(0, 0), cB, voffB); PG8_STAGE(PG8_SB(0, 1), cB + hstep, voffB); PG8_STAGE(PG8_SA(0, 0), cA, voffA); PG8_STAGE(PG8_SA(0, 1), cA + hstep, voffA);
        if (wr == 1) PG8_BAR;
        PG8_WAIT_V(2); PG8_BAR;
        PG8_STAGE(PG8_SB(1, 0), cB + kstep, voffB); PG8_STAGE(PG8_SA(1, 0), cA + kstep, voffA); PG8_STAGE(PG8_SB(1, 1), cB + hstep + kstep, voffB);
        PG8_WAIT_V(6); PG8_BAR;
    } else {
        PG8_STAGE(PG8_SB(0, 0), cB, voffB); PG8_STAGE(PG8_SA(0, 0), cA, voffA); PG8_STAGE(PG8_SB(0, 1), cB + hstep, voffB); PG8_STAGE(PG8_SA(0, 1), cA + hstep, voffA);
        if (wr == 1) PG8_BAR;
        PG8_WAIT_V(4); PG8_BAR;
        PG8_STAGE(PG8_SB(1, 0), cB + kstep, voffB); PG8_STAGE(PG8_SA(1, 0), cA + kstep, voffA); PG8_STAGE(PG8_SB(1, 1), cB + hstep + kstep, voffB);
        PG8_WAIT_V(6); PG8_BAR;
    }
    for (;;) {
        const bool has_next = S.next(ui + 1, nxt);
        const char* nA = has_next ? (const char*)g.A + (size_t)nxt.pm * tstep : cA; const char* nB = has_next ? (const char*)g.Bt + (size_t)nxt.pn * tstep : cB;
        for (int t = 0; t < nt; t += 2) {
            const bool last = (t == nt - 2);
            const char* a1 = cA + (size_t)(t + 1) * kstep;
            const char* a2 = last ? nA : cA + (size_t)(t + 2) * kstep; const char* b2 = last ? nB : cB + (size_t)(t + 2) * kstep;
            const char* a3 = a2 + kstep; const char* b3 = b2 + kstep;
            if (last && has_next) S.a_ready(nxt);
            if constexpr (SP2) {
            PG8_LDB(B0, 0, 0); PG8_LDB(B1, 0, 1); PG8_SCHED; PG8_LDA(At, 0, 0); PG8_STAGE(PG8_SA(1, 1), a1 + hstep, voffA);
            PG8_WAIT_V(8); PG8_WAIT_L(0); PG8_BAR; PG8_MMA(0, 0, At, B0); PG8_MMA(0, 1, At, B1); PG8_BAR; PG8_SCHED;
            PG8_LDA(At, 0, 1); PG8_STAGE(PG8_SB(0, 0), b2, voffB); PG8_STAGE(PG8_SB(0, 1), b2 + hstep, voffB); PG8_STAGE(PG8_SA(0, 0), a2, voffA);
            PG8_WAIT_V(8); PG8_WAIT_L(0); PG8_BAR; PG8_MMA(1, 0, At, B0); PG8_MMA(1, 1, At, B1); PG8_BAR; PG8_SCHED;
            PG8_LDB(B0, 1, 0); PG8_LDB(B1, 1, 1); PG8_SCHED; PG8_LDA(At, 1, 0); PG8_STAGE(PG8_SA(0, 1), a2 + hstep, voffA);
            PG8_WAIT_V(8); PG8_WAIT_L(0); PG8_BAR; PG8_MMA(0, 0, At, B0); PG8_MMA(0, 1, At, B1); PG8_BAR; PG8_SCHED;
            PG8_LDA(At, 1, 1); PG8_STAGE(PG8_SB(1, 0), b3, voffB); PG8_STAGE(PG8_SB(1, 1), b3 + hstep, voffB); PG8_STAGE(PG8_SA(1, 0), a3, voffA);
            PG8_WAIT_V(8); PG8_WAIT_L(0); PG8_BAR; PG8_MMA(1, 0, At, B0); PG8_MMA(1, 1, At, B1); PG8_BAR; PG8_SCHED;
            } else {
            PG8_LDB(B0, 0, 0); PG8_SCHED; PG8_LDA(At, 0, 0); PG8_STAGE(PG8_SA(1, 1), a1 + hstep, voffA);
            PG8_WAIT_L(8); PG8_BAR; PG8_WAIT_L(0); PG8_MMA(0, 0, At, B0); PG8_BAR; PG8_SCHED;
            PG8_LDB(B1, 0, 1); PG8_STAGE(PG8_SB(0, 0), b2, voffB);
            PG8_BAR; PG8_WAIT_L(0); PG8_MMA(0, 1, At, B1); PG8_BAR;
            PG8_LDA(At, 0, 1); PG8_STAGE(PG8_SA(0, 0), a2, voffA);
            PG8_BAR; PG8_WAIT_L(0); PG8_MMA(1, 0, At, B0); PG8_BAR; PG8_SCHED;
            PG8_STAGE(PG8_SB(0, 1), b2 + hstep, voffB);
            PG8_WAIT_V(6); PG8_BAR; PG8_MMA(1, 1, At, B1); PG8_BAR;
            PG8_LDB(B0, 1, 0); PG8_SCHED; PG8_LDA(At, 1, 0); PG8_STAGE(PG8_SA(0, 1), a2 + hstep, voffA);
            PG8_WAIT_L(8); PG8_BAR; PG8_WAIT_L(0); PG8_MMA(0, 0, At, B0); PG8_BAR; PG8_SCHED;
            PG8_LDB(B1, 1, 1); PG8_STAGE(PG8_SB(1, 0), b3, voffB);
            PG8_BAR; PG8_WAIT_L(0); PG8_MMA(0, 1, At, B1); PG8_BAR;
            PG8_LDA(At, 1, 1); PG8_STAGE(PG8_SA(1, 0), a3, voffA);
            PG8_BAR; PG8_WAIT_L(0); PG8_MMA(1, 0, At, B0); PG8_BAR; PG8_SCHED;
            PG8_STAGE(PG8_SB(1, 1), b3 + hstep, voffB);
            PG8_WAIT_V(6); PG8_BAR; PG8_MMA(1, 1, At, B1); PG8_BAR;
            }
        }
        if constexpr (ALIGN_EPI) { if (wr == 0) PG8_BAR; }
        if constexpr (!Epi::AFTER_DRAIN) { E(acc, cur, wr, wc, fr, fq); S.done(cur); }
        if (!has_next) break;
#pragma unroll
        for (int a = 0; a < 2; ++a)
#pragma unroll
            for (int b = 0; b < 2; ++b)
#pragma unroll
                for (int m = 0; m < 4; ++m)
#pragma unroll
                    for (int n = 0; n < 2; ++n) acc[a][b][m][n] = (f32x4){0.f, 0.f, 0.f, 0.f};
        cur = nxt; cA = nA; cB = nB; ++ui;
        if constexpr (ALIGN_EPI) { if (wr == 1) PG8_BAR; }
    }
    PG8_WAIT_V(0);
    if constexpr (!ALIGN_EPI) { if (wr == 0) PG8_BAR; }
    PG8_BAR;
    if constexpr (Epi::AFTER_DRAIN) { E.fused(acc, cur, wr, wc, fr, fq, lds, wid, lane); S.done(cur); }
#undef PG8_SA
#undef PG8_SB
#undef PG8_STAGE
#undef PG8_LDA
#undef PG8_LDB
#undef PG8_MMA
#undef PG8_WAIT_V
#undef PG8_WAIT_L
#undef PG8_BAR
#undef PG8_SCHED
}
}

namespace cg = cooperative_groups;
#define LAS __attribute__((address_space(3)))
typedef unsigned short bf16;
typedef float f32x4 __attribute__((ext_vector_type(4)));
typedef float f32x16 __attribute__((ext_vector_type(16)));
typedef short bf16x8 __attribute__((ext_vector_type(8)));
typedef short s16x4 __attribute__((ext_vector_type(4)));
typedef unsigned u32x4 __attribute__((ext_vector_type(4)));
typedef unsigned u32x2 __attribute__((ext_vector_type(2)));

constexpr int NWAVES = 8, NTHR = 512;
constexpr int BATCH = 8, SEQ = 4096, DM = 1024, M = BATCH * SEQ, NL = 4, FF = 4096, PLE = 256;
constexpr int NPROJ = 2816, NPAD = 3072, INC = 2832;
constexpr float EPS = 1e-6f;
constexpr int LDS_BYTES = 147456;
constexpr int PF_D = 4;
constexpr int REP_MIX = 1, REP_G = 1, REP_BAR = 1, REP_P1 = 1, REP_P2 = 2, REP_P3 = 1;

constexpr size_t MiB = 1u << 20;
constexpr size_t W_LAYER = 27 * MiB;
constexpr size_t WO_IN = 0, WO_OUT = 6 * MiB, WO_UP = 8 * MiB, WO_DOWN = 16 * MiB, WO_G = 24 * MiB, WO_P = 26 * MiB;
constexpr size_t WS_W = 0;
constexpr size_t WS_XB = 108 * MiB;
constexpr size_t WS_SSQ = 172 * MiB;
constexpr size_t WS_ROPE = 178 * MiB;
constexpr size_t WS_GATES = 180 * MiB;
constexpr size_t WS_PB = 182 * MiB;
constexpr size_t WS_QKVC = 198 * MiB;
constexpr size_t WS_BIG = 246 * MiB;
constexpr size_t WS_MISC = 502 * MiB;
constexpr size_t WS_END = 503 * MiB;
constexpr size_t WS_MLB = WS_XB;
constexpr int GU_W = 0, GU_QD = 4096, GU_KD = 8192, GU_U = 12288, GU_QK = 16384, GU_STRIDE = 19456;
constexpr int GDN_NA = 1724;
constexpr int WAVE_LDS = 18432;
constexpr int MU_QB = 0, MU_PT = 4096, MU_KW = 8192, MU_VB = 12288, MU_STRIDE = 16384;

struct Args { const void* in[21]; float* out; unsigned char* ws; };

struct Frame {
    LAS unsigned char* lds;
    int tid, lane, wave, G, gw, ngw;
};
typedef const __attribute__((address_space(4))) void* kptr_t;
__device__ __forceinline__ const void* karg(int i) {
    kptr_t kp = (kptr_t)__builtin_amdgcn_kernarg_segment_ptr();
    asm volatile("" : "+s"(kp));
    return ((const void* const __attribute__((address_space(4)))*)kp)[i];
}
__device__ __forceinline__ int lane_id_asm();
__device__ __forceinline__ Frame relaunder(const Frame& f) {
    Frame r = f;
    r.lane = lane_id_asm(); r.tid = r.wave * 64 + r.lane;
    asm volatile("" : "+v"(r.tid), "+v"(r.lane));
    asm volatile("" : "+s"(r.wave), "+s"(r.gw), "+s"(r.ngw), "+s"(r.G));
    return r;
}
#define IN_F(i) ((const float*)karg(i))
#define OUTP ((float*)karg(21))
#define WSP ((unsigned char*)karg(22))

__device__ __forceinline__ float bf2f(unsigned short b) { return __uint_as_float((unsigned)b << 16); }
typedef float f32x2_t __attribute__((ext_vector_type(2))); typedef __bf16 bf16x2_t __attribute__((ext_vector_type(2)));
__device__ __forceinline__ unsigned pk2(float lo, float hi) { f32x2_t v = {lo, hi}; bf16x2_t b = __builtin_convertvector(v, bf16x2_t); return __builtin_bit_cast(unsigned, b); }
__device__ __forceinline__ unsigned f2bf(float f) { return pk2(f, 0.f) & 0xffffu; }
__device__ __forceinline__ float lo_bf(unsigned w) { return __uint_as_float(w << 16); }
__device__ __forceinline__ float hi_bf(unsigned w) { return __uint_as_float(w & 0xffff0000u); }
__device__ __forceinline__ int lane_id_asm() { int l; asm volatile("v_mbcnt_lo_u32_b32 %0, -1, 0\n\tv_mbcnt_hi_u32_b32 %0, -1, %0" : "=v"(l)); return l; }
__device__ __forceinline__ float xshfl(float v, int src_lane) { return __int_as_float(__builtin_amdgcn_ds_bpermute(src_lane << 2, __float_as_int(v))); }
__device__ __forceinline__ unsigned xshflu(unsigned v, int src_lane) { return (unsigned)__builtin_amdgcn_ds_bpermute(src_lane << 2, (int)v); }
__device__ __forceinline__ float wave_sum(float v, int lane) {
#pragma unroll
    for (int o = 1; o < 64; o <<= 1) v += xshfl(v, lane ^ o);
    return v;
}
#define LDS_WAIT() asm volatile("s_waitcnt lgkmcnt(0)" ::: "memory")
__device__ __forceinline__ float sigmoidf_(float x) { return 1.0f / (1.0f + __expf(-x)); }
__device__ __forceinline__ float softplusf_(float x) { return fmaxf(x, 0.f) + log1pf(__expf(-fabsf(x))); }
__device__ __forceinline__ float sum8(float v) {
    v += __int_as_float(__builtin_amdgcn_update_dpp(0, __float_as_int(v), 0xB1, 0xF, 0xF, true));
    v += __int_as_float(__builtin_amdgcn_update_dpp(0, __float_as_int(v), 0x4E, 0xF, 0xF, true));
    v += __int_as_float(__builtin_amdgcn_update_dpp(0, __float_as_int(v), 0x141, 0xF, 0xF, true));
    return v;
}

__device__ __forceinline__ int win_src_col(int n) {
    if (n < 1024) return n;
    if (n < 2048) return n + 8;
    if (n < 2816) return n + 16;
    if (n < 2824) return 1024 + (n - 2816);
    if (n < 2832) return 2056 + (n - 2824);
    return -1;
}
template <int MAP>
__device__ __forceinline__ void transpose_item(const float* W, int K, int N, bf16* WT, const float* gain, LAS float* scr, int kb, int nb, int lane) {
    const int k0 = 64 * kb, n0 = 32 * nb;
    const int nd = n0 + (lane & 31);
    const int ns = MAP ? win_src_col(nd) : nd;
#pragma unroll 8
    for (int i = 0; i < 32; ++i) { const int kk = 2 * i + (lane >> 5); float v = 0.f; if (ns >= 0) v = W[(size_t)(k0 + kk) * N + ns]; if (gain) v *= gain[k0 + kk]; scr[kk * 33 + (lane & 31)] = v; }
    LDS_WAIT(); asm volatile("" ::: "memory");
    const int c = lane & 7;
#pragma unroll
    for (int j = 0; j < 4; ++j) { const int n = (lane >> 3) + 8 * j; const LAS float* s = scr + (8 * c) * 33 + n;
        u32x4 o; o.x = pk2(s[0 * 33], s[1 * 33]); o.y = pk2(s[2 * 33], s[3 * 33]); o.z = pk2(s[4 * 33], s[5 * 33]); o.w = pk2(s[6 * 33], s[7 * 33]);
        *(u32x4*)(WT + (size_t)(n0 + n) * K + k0 + 8 * c) = o; }
    LDS_WAIT(); asm volatile("" ::: "memory");
}
__device__ __forceinline__ void convert_weights(const Frame& F_in, int l, int idx, int nidx) {
    const Frame F = relaunder(F_in);
    unsigned char* const L_ws = WSP; const float* const L_w_in = IN_F(3); const float* const L_w_out = IN_F(12); const float* const L_w_up = IN_F(15); const float* const L_w_down = IN_F(16); const float* const L_w_g = IN_F(18); const float* const L_w_p = IN_F(19);
    const float* const L_norm_mix = IN_F(13); const float* const L_norm_mlp = IN_F(14); const float* const L_norm_ple = IN_F(17);
    LAS float* scr = (LAS float*)(F.lds + F.wave * 16384);
    constexpr int I_IN = 16 * 96, I_OUT = 16 * 32, I_UP = 16 * 128, I_DOWN = 64 * 32, I_G = 16 * 32, I_P = 4 * 32;
    constexpr int I_LAYER = I_IN + I_OUT + I_UP + I_DOWN + I_G + I_P;
    unsigned char* wb = L_ws + WS_W + (size_t)l * W_LAYER;
    for (int it = idx; it < I_LAYER; it += nidx) {
        int r = it;
        if (r < I_IN) { transpose_item<1>(L_w_in + (size_t)l * DM * INC, DM, INC, (bf16*)(wb + WO_IN), L_norm_mix + l * DM, scr, r / 96, r % 96, F.lane); continue; } r -= I_IN;
        if (r < I_OUT) { transpose_item<0>(L_w_out + (size_t)l * DM * DM, DM, DM, (bf16*)(wb + WO_OUT), nullptr, scr, r / 32, r % 32, F.lane); continue; } r -= I_OUT;
        if (r < I_UP) { transpose_item<0>(L_w_up + (size_t)l * DM * FF, DM, FF, (bf16*)(wb + WO_UP), L_norm_mlp + l * DM, scr, r / 128, r % 128, F.lane); continue; } r -= I_UP;
        if (r < I_DOWN) { transpose_item<0>(L_w_down + (size_t)l * FF * DM, FF, DM, (bf16*)(wb + WO_DOWN), nullptr, scr, r / 32, r % 32, F.lane); continue; } r -= I_DOWN;
        if (r < I_G) { transpose_item<0>(L_w_g + (size_t)l * DM * DM, DM, DM, (bf16*)(wb + WO_G), L_norm_ple + l * DM, scr, r / 32, r % 32, F.lane); continue; } r -= I_G;
        transpose_item<0>(L_w_p + (size_t)l * PLE * DM, PLE, DM, (bf16*)(wb + WO_P), nullptr, scr, r / 32, r % 32, F.lane);
    }
}
__device__ __forceinline__ void p0_prologue(const Frame& F_in) {
    const Frame F = relaunder(F_in);
    unsigned char* const L_ws = WSP; const float* const L_in_x = IN_F(0); const int* const L_in_pos = (const int*)karg(2);
    bf16* const L_XB = (bf16*)(L_ws + WS_XB); float* const L_SSQ = (float*)(L_ws + WS_SSQ); float* const L_ROPE = (float*)(L_ws + WS_ROPE);
    for (int m = F.gw; m < M; m += F.ngw) {
        const f32x4* xr = (const f32x4*)(L_in_x + (size_t)m * DM) + F.lane; float s = 0.f;
        unsigned long long* o8 = (unsigned long long*)(L_XB + (size_t)m * DM) + F.lane;
#pragma unroll
        for (int j = 0; j < 4; ++j) { const f32x4 v = xr[64 * j]; s += (v[0] * v[0] + v[1] * v[1]) + (v[2] * v[2] + v[3] * v[3]);
            o8[64 * j] = (unsigned long long)pk2(v[0], v[1]) | ((unsigned long long)pk2(v[2], v[3]) << 32); }
        s = wave_sum(s, F.lane);
        if (F.lane < 16) L_SSQ[(size_t)m * 16 + F.lane] = (F.lane == 0) ? s : 0.f;
    }
    for (int i = F.gw * 64 + F.lane; i < M * 8; i += F.ngw * 64) {
        const int t = i >> 3, j = i & 7;
        const float inv = (float)exp(-(double)(2 * j) / 16.0 * 13.122363377404328);
        const float ang = (float)L_in_pos[t] * inv;
        const double a = (double)ang; const double rev = a * 0.15915494309189535; const double fr = rev - floor(rev + 0.5);
        const float rad = (float)(fr * 6.283185307179586);
        L_ROPE[i] = cosf(rad); L_ROPE[(size_t)M * 8 + i] = sinf(rad);
    }
}

#define MFMA16(a, b, c) __builtin_amdgcn_mfma_f32_16x16x32_bf16((a), (b), (c), 0, 0, 0)
__device__ __forceinline__ int kperm(int ks, int g, int j) { return 32 * ks + 16 * (j >> 2) + 4 * g + (j & 3); }
__device__ __forceinline__ bf16x8 pack_tiles(const f32x4& a, const f32x4& b) { u32x4 w; w.x = pk2(a[0], a[1]); w.y = pk2(a[2], a[3]); w.z = pk2(b[0], b[1]); w.w = pk2(b[2], b[3]); return __builtin_bit_cast(bf16x8, w); }

__device__ __forceinline__ bf16* gdn_ubuf(unsigned char* ws, int unit) {
    return unit < GDN_NA ? (bf16*)(ws + WS_PB) + (size_t)unit * GU_STRIDE : (bf16*)(ws + WS_BIG + 240 * MiB) + (size_t)(unit - GDN_NA) * GU_STRIDE;
}
__device__ __forceinline__ int qk_idx(int tt, int ks) { return tt < 2 ? tt : 2 + (tt - 2) * 2 + ks; }
__device__ __forceinline__ bf16x8 conv8(const bf16* PROJ, size_t tok, int sp, int ch0, const f32x4 (&w)[4][2]) {
    float a[8];
#pragma unroll
    for (int j = 0; j < 8; ++j) a[j] = 0.f;
#pragma unroll
    for (int tap = 0; tap < 4; ++tap) if (sp - 3 + tap >= 0) {
        const u32x4 raw = *(const u32x4*)(PROJ + (tok - 3 + tap) * NPROJ + ch0);
#pragma unroll
        for (int i = 0; i < 4; ++i) { a[2 * i] += w[tap][i >> 1][(2 * i) & 3] * lo_bf(raw[i]); a[2 * i + 1] += w[tap][i >> 1][(2 * i + 1) & 3] * hi_bf(raw[i]); }
    }
    u32x4 o;
#pragma unroll
    for (int i = 0; i < 4; ++i) o[i] = pk2(a[2 * i] * sigmoidf_(a[2 * i]), a[2 * i + 1] * sigmoidf_(a[2 * i + 1]));
    return __builtin_bit_cast(bf16x8, o);
}
__device__ __forceinline__ void solve64(float (&x)[64], const LAS float* Lm) {
#pragma unroll
    for (int c = 1; c < 64; ++c) {
        int one = 1; asm volatile("" : "+s"(one));
        if (one) {
            float a = x[c];
#pragma unroll
            for (int s4 = 0; s4 < (c + 3) / 4; ++s4) { const f32x4 lv = *(const LAS f32x4*)(Lm + c * 64 + 4 * s4);
#pragma unroll
                for (int i = 0; i < 4; ++i) if (4 * s4 + i < c) a -= lv[i] * x[4 * s4 + i]; }
            x[c] = a;
        }
    }
}
__device__ __forceinline__ void gdn_prep(const Frame& F_in, int l) {
    const Frame F = relaunder(F_in);
    unsigned char* const L_ws = WSP; const float* const cw = IN_F(4) + (size_t)l * 4 * 768; const float* const L_a_log = IN_F(5); const float* const L_dt_bias = IN_F(6);
    const bf16* const PROJ = (const bf16*)(L_ws + WS_BIG); const float* const GATES = (const float*)(L_ws + WS_GATES); float* const GL = (float*)(L_ws + WS_MISC) + 2048;
    LAS float* Lm = (LAS float*)(F.lds + F.wave * WAVE_LDS);
    LAS bf16* T = (LAS bf16*)Lm;
    LAS float* gcv = Lm + 4096; LAS float* bkv = gcv + 64; LAS float* rkv = gcv + 128; LAS float* qdf = gcv + 192; LAS float* wfv = gcv + 256; LAS float* kdf = gcv + 320; LAS float* btv = gcv + 384;
    int g, m, lane;
#define RELANE() do { int ln_ = F.lane; asm volatile("" : "+v"(ln_)); lane = ln_; g = ln_ >> 4; m = ln_ & 15; } while (0)
    for (int unit = F.gw; unit < 2048; unit += F.ngw) {
        RELANE();
        const int h = (unit >> 6) & 3, n = unit & 63; const size_t t0 = (size_t)(unit >> 8) * SEQ + (size_t)n * 64;
        bf16* const ub = gdn_ubuf(L_ws, unit);
        float gl, gc_own, beta_own;
        {
            const float* gr = GATES + (t0 + lane) * 16;
            beta_own = sigmoidf_(gr[h]);
            float gs = -__expf(L_a_log[l * 4 + h]) * softplusf_(gr[4 + h] + L_dt_bias[l * 4 + h]);
#pragma unroll
            for (int o = 1; o < 64; o <<= 1) { const float t = xshfl(gs, lane >= o ? lane - o : lane); if (lane >= o) gs += t; }
            gc_own = gs; gl = __int_as_float(__builtin_amdgcn_readlane(__float_as_int(gs), 63));
            gcv[lane] = gs; btv[lane] = beta_own;
        }
        RELANE();
        bf16x8 FQ[4][2], FK[4][2];
#pragma unroll
        for (int ks = 0; ks < 2; ++ks) {
            f32x4 wq[4][2], wk[4][2];
#pragma unroll
            for (int tap = 0; tap < 4; ++tap) { const float* wp = cw + tap * 768 + h * 64 + 32 * ks + 8 * g; wq[tap][0] = *(const f32x4*)wp; wq[tap][1] = *(const f32x4*)(wp + 4); wk[tap][0] = *(const f32x4*)(wp + 256); wk[tap][1] = *(const f32x4*)(wp + 260); }
#pragma unroll
            for (int mt = 0; mt < 4; ++mt) { int one_ = 1; asm volatile("" : "+s"(one_)); if (one_) {
                FQ[mt][ks] = conv8(PROJ, t0 + 16 * mt + m, 64 * n + 16 * mt + m, h * 64 + 32 * ks + 8 * g, wq);
                FK[mt][ks] = conv8(PROJ, t0 + 16 * mt + m, 64 * n + 16 * mt + m, 256 + h * 64 + 32 * ks + 8 * g, wk);
            } }
        }
        RELANE();
#pragma unroll
        for (int tt = 0; tt < 4; ++tt) {
            f32x4 ak = (f32x4){0.f, 0.f, 0.f, 0.f}, aq = ak;
            ak = MFMA16(FK[tt][0], FK[tt][0], ak); ak = MFMA16(FK[tt][1], FK[tt][1], ak);
            aq = MFMA16(FQ[tt][0], FQ[tt][0], aq); aq = MFMA16(FQ[tt][1], FQ[tt][1], aq);
            const int r = m & 3;
            const float dk_ = r == 0 ? ak[0] : r == 1 ? ak[1] : r == 2 ? ak[2] : ak[3];
            const float dq_ = r == 0 ? aq[0] : r == 1 ? aq[1] : r == 2 ? aq[2] : aq[3];
            if ((m >> 2) == g) { rkv[16 * tt + m] = 1.0f / sqrtf(dk_ + EPS); qdf[16 * tt + m] = 0.125f / sqrtf(dq_ + EPS); }
        }
        LDS_WAIT(); asm volatile("" ::: "memory");
        RELANE();
        {
            const float rk = rkv[lane], rq = qdf[lane];
            LDS_WAIT(); asm volatile("" ::: "memory");
            bkv[lane] = beta_own * rk; wfv[lane] = beta_own * rk * __expf(gc_own); kdf[lane] = rk * __expf(gl - gc_own); qdf[lane] = rq;
        }
        LDS_WAIT(); asm volatile("" ::: "memory");
        RELANE();
#pragma unroll
        for (int tt = 0; tt < 4; ++tt) { int one_ = 1; asm volatile("" : "+s"(one_)); if (one_) {
            const float gct = gcv[16 * tt + m], rqt = qdf[16 * tt + m];
#pragma unroll
            for (int ks = 0; ks < 2; ++ks) if (2 * ks <= tt) {
                u32x4 ow = (u32x4){0u, 0u, 0u, 0u};
#pragma unroll
                for (int hf = 0; hf < 2; ++hf) { const int st = 2 * ks + hf;
                    if (st <= tt) {
                        f32x4 acc = (f32x4){0.f, 0.f, 0.f, 0.f};
                        acc = MFMA16(FK[st][0], FQ[tt][0], acc); acc = MFMA16(FK[st][1], FQ[tt][1], acc);
                        const f32x4 gcs = *(const LAS f32x4*)(gcv + 16 * st + 4 * g), rks = *(const LAS f32x4*)(rkv + 16 * st + 4 * g);
                        float v[4];
#pragma unroll
                        for (int r = 0; r < 4; ++r) { const int sI = 16 * st + 4 * g + r, tI = 16 * tt + m; v[r] = (sI <= tI) ? acc[r] * rqt * rks[r] * __expf(gct - gcs[r]) : 0.f; }
                        ow[2 * hf] = pk2(v[0], v[1]); ow[2 * hf + 1] = pk2(v[2], v[3]);
                    } }
                *(u32x4*)(ub + GU_QK + (qk_idx(tt, ks) * 64 + lane) * 8) = ow;
            }
        } }
        RELANE();
#pragma unroll
        for (int mt = 0; mt < 4; ++mt)
#pragma unroll
            for (int ks = 0; ks < 2; ++ks) *(LAS bf16x8*)(T + (16 * mt + m) * 72 + 32 * ks + 8 * g) = FQ[mt][ks];
        LDS_WAIT(); asm volatile("" ::: "memory");
#pragma unroll
        for (int mt = 0; mt < 4; ++mt) {
            const float f = qdf[16 * mt + m] * __expf(gcv[16 * mt + m]);
#pragma unroll
            for (int ks = 0; ks < 2; ++ks) {
                const u32x2 lo = *(const LAS u32x2*)(T + (16 * mt + m) * 72 + 32 * ks + 4 * g), hi = *(const LAS u32x2*)(T + (16 * mt + m) * 72 + 32 * ks + 16 + 4 * g);
                u32x4 ow; ow.x = pk2(lo_bf(lo.x) * f, hi_bf(lo.x) * f); ow.y = pk2(lo_bf(lo.y) * f, hi_bf(lo.y) * f); ow.z = pk2(lo_bf(hi.x) * f, hi_bf(hi.x) * f); ow.w = pk2(lo_bf(hi.y) * f, hi_bf(hi.y) * f);
                *(u32x4*)(ub + GU_QD + ((mt * 2 + ks) * 64 + lane) * 8) = ow;
            }
        }
        LDS_WAIT(); asm volatile("" ::: "memory");
        RELANE();
        float xw[64];
        {
            const int chk = 256 + h * 64 + lane;
            const float k0 = cw[chk], k1 = cw[768 + chk], k2 = cw[1536 + chk], k3 = cw[2304 + chk];
            float ka = 0.f, kb = 0.f, kc = 0.f;
            if (n > 0) { ka = bf2f(PROJ[(t0 - 3) * NPROJ + chk]); kb = bf2f(PROJ[(t0 - 2) * NPROJ + chk]); kc = bf2f(PROJ[(t0 - 1) * NPROJ + chk]); }
            unsigned short kr[64];
#pragma unroll
            for (int c = 0; c < 64; ++c) kr[c] = PROJ[(t0 + c) * NPROJ + chk];
            asm volatile("" ::: "memory");
#pragma unroll
            for (int c4 = 0; c4 < 16; ++c4) {
                const f32x4 wf4 = *(const LAS f32x4*)(wfv + 4 * c4), kd4 = *(const LAS f32x4*)(kdf + 4 * c4);
                float kt[4];
#pragma unroll
                for (int i = 0; i < 4; ++i) { const int c = 4 * c4 + i; const float kd_ = bf2f(kr[c]);
                    float ak = k0 * ka + k1 * kb + k2 * kc + k3 * kd_; ak = ak * sigmoidf_(ak); ka = kb; kb = kc; kc = kd_;
                    xw[c] = ak * wf4[i]; kt[i] = ak * kd4[i]; }
                u32x2 w2; w2.x = pk2(kt[0], kt[1]); w2.y = pk2(kt[2], kt[3]);
                *(LAS u32x2*)(T + lane * 72 + 4 * c4) = w2;
            }
        }
        LDS_WAIT(); asm volatile("" ::: "memory");
        RELANE();
#pragma unroll
        for (int dt = 0; dt < 4; ++dt)
#pragma unroll
            for (int ks = 0; ks < 2; ++ks) {
                const u32x2 lo = *(const LAS u32x2*)(T + (16 * dt + m) * 72 + 32 * ks + 4 * g), hi = *(const LAS u32x2*)(T + (16 * dt + m) * 72 + 32 * ks + 16 + 4 * g);
                u32x4 ow; ow.x = lo.x; ow.y = lo.y; ow.z = hi.x; ow.w = hi.y;
                *(u32x4*)(ub + GU_KD + ((dt * 2 + ks) * 64 + lane) * 8) = ow;
            }
        LDS_WAIT(); asm volatile("" ::: "memory");
        RELANE();
#pragma unroll
        for (int ct = 0; ct < 4; ++ct) { int one_ = 1; asm volatile("" : "+s"(one_)); if (one_) {
            const f32x4 gcc = *(const LAS f32x4*)(gcv + 16 * ct + 4 * g), bkc = *(const LAS f32x4*)(bkv + 16 * ct + 4 * g);
#pragma unroll
            for (int st = 0; st <= ct; ++st) {
                f32x4 acc = (f32x4){0.f, 0.f, 0.f, 0.f};
                acc = MFMA16(FK[ct][0], FK[st][0], acc); acc = MFMA16(FK[ct][1], FK[st][1], acc);
                const float gcs = gcv[16 * st + m], rks = rkv[16 * st + m];
#pragma unroll
                for (int r = 0; r < 4; ++r) { const int cI = 16 * ct + 4 * g + r, sI = 16 * st + m; Lm[cI * 64 + sI] = (sI < cI) ? acc[r] * bkc[r] * rks * __expf(gcc[r] - gcs) : 0.f; }
            }
        } }
        LDS_WAIT(); asm volatile("" ::: "memory");
        __builtin_amdgcn_sched_barrier(0);
        solve64(xw, Lm);
        __builtin_amdgcn_sched_barrier(0);
        {
            RELANE();
            const int l5 = lane & 31, gp = (l5 >> 2) & 3, jj = ((l5 >> 4) << 2) | (l5 & 3);
            bf16* wp = ub + GU_W + (lane >> 5) * 512 + gp * 128 + jj;
#pragma unroll
            for (int c = 0; c < 64; ++c) wp[(c >> 4) * 1024 + (c & 15) * 8] = (bf16)f2bf(xw[c]);
        }
        __builtin_amdgcn_sched_barrier(0);
        RELANE();
        float xu[64];
        {
            const int chv = 512 + h * 64 + lane;
            const float v0 = cw[chv], v1 = cw[768 + chv], v2 = cw[1536 + chv], v3 = cw[2304 + chv];
            float va = 0.f, vb = 0.f, vc = 0.f;
            if (n > 0) { va = bf2f(PROJ[(t0 - 3) * NPROJ + chv]); vb = bf2f(PROJ[(t0 - 2) * NPROJ + chv]); vc = bf2f(PROJ[(t0 - 1) * NPROJ + chv]); }
            unsigned short vr[64];
#pragma unroll
            for (int c = 0; c < 64; ++c) vr[c] = PROJ[(t0 + c) * NPROJ + chv];
            asm volatile("" ::: "memory");
#pragma unroll
            for (int c4 = 0; c4 < 16; ++c4) {
                const f32x4 bt4 = *(const LAS f32x4*)(btv + 4 * c4);
#pragma unroll
                for (int i = 0; i < 4; ++i) { const int c = 4 * c4 + i; const float vd_ = bf2f(vr[c]);
                    float av = v0 * va + v1 * vb + v2 * vc + v3 * vd_; av = av * sigmoidf_(av); va = vb; vb = vc; vc = vd_;
                    xu[c] = av * bt4[i]; }
            }
        }
        __builtin_amdgcn_sched_barrier(0);
        solve64(xu, Lm);
        __builtin_amdgcn_sched_barrier(0);
        LDS_WAIT(); asm volatile("" ::: "memory");
        RELANE();
        {
            const int sl = lane >> 4, e = lane & 15;
#pragma unroll
            for (int mt = 0; mt < 4; ++mt)
#pragma unroll
                for (int gp = 0; gp < 4; ++gp) { const int c = 16 * mt + 4 * gp; u32x2 w2; w2.x = pk2(xu[c], xu[c + 1]); w2.y = pk2(xu[c + 2], xu[c + 3]);
                    *(u32x2*)(ub + GU_U + ((sl * 4 + mt) * 64 + gp * 16 + e) * 4) = w2; }
        }
        if (lane == 0) GL[unit] = __expf(gl);
        LDS_WAIT(); asm volatile("" ::: "memory");
    }
#undef RELANE
}
__device__ __forceinline__ void gdn_scan(const Frame& F_in, int task) {
    const Frame F = relaunder(F_in);
    unsigned char* const L_ws = WSP; bf16* const PROJ = (bf16*)(L_ws + WS_BIG); const float* const GL = (const float*)(L_ws + WS_MISC) + 2048;
    const int bh = task >> 2, sl = task & 3;
    const int b = bh >> 2, h = bh & 3, unit0 = b * 256 + h * 64;
    f32x4 St[4];
#pragma unroll
    for (int i = 0; i < 4; ++i) St[i] = (f32x4){0.f, 0.f, 0.f, 0.f};
    bf16x8 W[8], QD[8], KD[8], QK[6]; u32x2 U[4], UN[4]; float gl; int vz = 0; asm volatile("" : "+v"(vz)); unsigned pA = 0, pB = 0;
    {
        const bf16* u0 = gdn_ubuf(L_ws, unit0) + F.lane * 8;
#pragma unroll
        for (int f = 0; f < 8; ++f) { W[f] = *(const bf16x8*)(u0 + GU_W + f * 512); QD[f] = *(const bf16x8*)(u0 + GU_QD + f * 512); KD[f] = *(const bf16x8*)(u0 + GU_KD + f * 512); }
#pragma unroll
        for (int f = 0; f < 6; ++f) QK[f] = *(const bf16x8*)(u0 + GU_QK + f * 512);
#pragma unroll
        for (int mt = 0; mt < 4; ++mt) U[mt] = *(const u32x2*)(u0 - F.lane * 8 + GU_U + ((sl * 4 + mt) * 64 + F.lane) * 4);
        gl = GL[unit0 + vz];
    }
#pragma unroll 1
    for (int n = 0; n < 64; ++n) {
        const int nn = n < 63 ? n + 1 : 63;
        int ln_ = F.lane; asm volatile("" : "+v"(ln_)); const int g = ln_ >> 4, e = ln_ & 15;
        const bf16* un = gdn_ubuf(L_ws, unit0 + nn) + ln_ * 8;
        const float cgl = gl; gl = GL[unit0 + nn + vz];
        unsigned tA, tB;
        { const int np = n + PF_D < 64 ? n + PF_D : 63; const unsigned char* pb = (const unsigned char*)gdn_ubuf(L_ws, unit0 + np) + (sl * 80) * 128;
          tA = *(const unsigned*)(pb + ln_ * 128); tB = *(const unsigned*)(pb + (64 + (ln_ & 15)) * 128); }
#pragma unroll
        for (int mt = 0; mt < 4; ++mt) UN[mt] = *(const u32x2*)(un - ln_ * 8 + GU_U + ((sl * 4 + mt) * 64 + ln_) * 4);
        const bf16x8 SB0 = pack_tiles(St[0], St[1]), SB1 = pack_tiles(St[2], St[3]);
        const size_t t0 = (size_t)b * SEQ + (size_t)n * 64;
        f32x4 vn[4];
#pragma unroll
        for (int tt = 0; tt < 4; ++tt) {
            f32x4 ws_ = (f32x4){0.f, 0.f, 0.f, 0.f};
            ws_ = MFMA16(W[tt * 2], SB0, ws_); ws_ = MFMA16(W[tt * 2 + 1], SB1, ws_);
            W[tt * 2] = *(const bf16x8*)(un + GU_W + (tt * 2) * 512); W[tt * 2 + 1] = *(const bf16x8*)(un + GU_W + (tt * 2 + 1) * 512);
            vn[tt] = (f32x4){lo_bf(U[tt].x), hi_bf(U[tt].x), lo_bf(U[tt].y), hi_bf(U[tt].y)} - ws_;
        }
        const bf16x8 VB0 = pack_tiles(vn[0], vn[1]), VB1 = pack_tiles(vn[2], vn[3]);
#pragma unroll
        for (int tt = 0; tt < 4; ++tt) {
            f32x4 o = (f32x4){0.f, 0.f, 0.f, 0.f};
            o = MFMA16(QD[tt * 2], SB0, o); o = MFMA16(QD[tt * 2 + 1], SB1, o);
            QD[tt * 2] = *(const bf16x8*)(un + GU_QD + (tt * 2) * 512); QD[tt * 2 + 1] = *(const bf16x8*)(un + GU_QD + (tt * 2 + 1) * 512);
            o = MFMA16(QK[qk_idx(tt, 0)], VB0, o); QK[qk_idx(tt, 0)] = *(const bf16x8*)(un + GU_QK + qk_idx(tt, 0) * 512);
            if (tt >= 2) { o = MFMA16(QK[qk_idx(tt, 1)], VB1, o); QK[qk_idx(tt, 1)] = *(const bf16x8*)(un + GU_QK + qk_idx(tt, 1) * 512); }
#pragma unroll
            for (int r = 0; r < 4; ++r) PROJ[(t0 + 16 * tt + 4 * g + r) * NPROJ + 512 + h * 64 + 16 * sl + e] = (bf16)f2bf(o[r]);
        }
#pragma unroll
        for (int dt = 0; dt < 4; ++dt) { f32x4 c = St[dt] * cgl; c = MFMA16(KD[dt * 2], VB0, c); c = MFMA16(KD[dt * 2 + 1], VB1, c); St[dt] = c;
            KD[dt * 2] = *(const bf16x8*)(un + GU_KD + (dt * 2) * 512); KD[dt * 2 + 1] = *(const bf16x8*)(un + GU_KD + (dt * 2 + 1) * 512); }
#pragma unroll
        for (int mt = 0; mt < 4; ++mt) U[mt] = UN[mt];
        asm volatile("" :: "v"(pA), "v"(pB)); pA = tA; pB = tB;
    }
}

__device__ __forceinline__ void mlstm_prep(const Frame& F_in, int l) {
    const Frame F = relaunder(F_in);
    unsigned char* const L_ws = WSP; const float* const L_i_bias = IN_F(8); const float* const L_f_bias = IN_F(9);
    const bf16* const PROJ = (const bf16*)(L_ws + WS_BIG); const float* const GATES = (const float*)(L_ws + WS_GATES); float* const FL = (float*)(L_ws + WS_MISC);
    LAS float* bvec = (LAS float*)(F.lds + F.wave * WAVE_LDS); LAS float* avec = bvec + 64;
    const int g = F.lane >> 4, m = F.lane & 15;
    for (int unit = F.gw; unit < 2048; unit += F.ngw) {
        const int h = (unit >> 6) & 3; const size_t t0 = (size_t)(unit >> 8) * SEQ + (size_t)(unit & 63) * 64;
        bf16* const ub = (bf16*)(L_ws + WS_MLB) + (size_t)unit * MU_STRIDE;
        float bl;
        {
            const float* gr = GATES + (t0 + F.lane) * 16;
            const float iv = 15.0f * tanhf((gr[8 + h] + L_i_bias[l * 4 + h]) * (1.0f / 15.0f));
            const float c = 15.0f * tanhf((gr[12 + h] + L_f_bias[l * 4 + h]) * (1.0f / 15.0f));
            float bs = -softplusf_(-c);
#pragma unroll
            for (int o = 1; o < 64; o <<= 1) { const float t = xshfl(bs, F.lane >= o ? F.lane - o : F.lane); if (F.lane >= o) bs += t; }
            bl = __int_as_float(__builtin_amdgcn_readlane(__float_as_int(bs), 63));
            bvec[F.lane] = bs; avec[F.lane] = iv - bs;
        }
        LDS_WAIT(); asm volatile("" ::: "memory");
        const bf16* qrow = PROJ + (t0 + m) * NPROJ + 1024 + h * 64;
        bf16x8 FQ[4][2], FK[4][2];
#pragma unroll
        for (int mt = 0; mt < 4; ++mt)
#pragma unroll
            for (int ks = 0; ks < 2; ++ks) { FQ[mt][ks] = *(const bf16x8*)(qrow + (size_t)(16 * mt) * NPROJ + 32 * ks + 8 * g); FK[mt][ks] = *(const bf16x8*)(qrow + (size_t)(16 * mt) * NPROJ + 256 + 32 * ks + 8 * g); }
#pragma unroll
        for (int tt = 0; tt < 4; ++tt) {
            const float bt = bvec[16 * tt + m];
#pragma unroll
            for (int ks = 0; ks < 2; ++ks) {
                u32x4 ow = (u32x4){0u, 0u, 0u, 0u};
#pragma unroll
                for (int hf = 0; hf < 2; ++hf) { const int st = 2 * ks + hf;
                    if (st <= tt) {
                        f32x4 acc = (f32x4){0.f, 0.f, 0.f, 0.f};
                        acc = MFMA16(FK[st][0], FQ[tt][0], acc); acc = MFMA16(FK[st][1], FQ[tt][1], acc);
                        const f32x4 av = *(const LAS f32x4*)(avec + 16 * st + 4 * g);
                        float v[4];
#pragma unroll
                        for (int r = 0; r < 4; ++r) { const int sI = 16 * st + 4 * g + r, tI = 16 * tt + m; v[r] = (sI <= tI) ? acc[r] * 0.125f * __expf(bt + av[r]) : 0.f; }
                        ow[2 * hf] = pk2(v[0], v[1]); ow[2 * hf + 1] = pk2(v[2], v[3]);
                    } }
                *(u32x4*)(ub + MU_PT + ((tt * 2 + ks) * 64 + F.lane) * 8) = ow;
            }
        }
#pragma unroll
        for (int mt = 0; mt < 4; ++mt) {
            const float f = __expf(bvec[16 * mt + m]);
#pragma unroll
            for (int ks = 0; ks < 2; ++ks) {
                const u32x2 lo = *(const u32x2*)(qrow + (size_t)(16 * mt) * NPROJ + 32 * ks + 4 * g), hi = *(const u32x2*)(qrow + (size_t)(16 * mt) * NPROJ + 32 * ks + 16 + 4 * g);
                u32x4 ow; ow.x = pk2(lo_bf(lo.x) * f, hi_bf(lo.x) * f); ow.y = pk2(lo_bf(lo.y) * f, hi_bf(lo.y) * f); ow.z = pk2(lo_bf(hi.x) * f, hi_bf(hi.x) * f); ow.w = pk2(lo_bf(hi.y) * f, hi_bf(hi.y) * f);
                *(u32x4*)(ub + MU_QB + ((mt * 2 + ks) * 64 + F.lane) * 8) = ow;
            }
        }
#pragma unroll
        for (int ks = 0; ks < 2; ++ks) {
            const f32x4 a0 = *(const LAS f32x4*)(avec + 32 * ks + 4 * g), a1 = *(const LAS f32x4*)(avec + 32 * ks + 16 + 4 * g);
            float fac[8];
#pragma unroll
            for (int j = 0; j < 4; ++j) { fac[j] = 0.125f * __expf(bl + a0[j]); fac[4 + j] = 0.125f * __expf(bl + a1[j]); }
            const bf16* kcol = PROJ + (t0 + 32 * ks + 4 * g) * NPROJ + 1280 + h * 64 + m;
#pragma unroll
            for (int dt = 0; dt < 4; ++dt) {
                float kv[8];
#pragma unroll
                for (int j = 0; j < 8; ++j) kv[j] = bf2f(kcol[(size_t)(16 * (j >> 2) + (j & 3)) * NPROJ + 16 * dt]) * fac[j];
                u32x4 ow; ow.x = pk2(kv[0], kv[1]); ow.y = pk2(kv[2], kv[3]); ow.z = pk2(kv[4], kv[5]); ow.w = pk2(kv[6], kv[7]);
                *(u32x4*)(ub + MU_KW + ((dt * 2 + ks) * 64 + F.lane) * 8) = ow;
            }
#pragma unroll
            for (int sl = 0; sl < 4; ++sl) {
                unsigned short vv[8];
#pragma unroll
                for (int j = 0; j < 8; ++j) vv[j] = kcol[(size_t)(16 * (j >> 2) + (j & 3)) * NPROJ + 256 + 16 * sl];
                u32x4 ow; ow.x = vv[0] | ((unsigned)vv[1] << 16); ow.y = vv[2] | ((unsigned)vv[3] << 16); ow.z = vv[4] | ((unsigned)vv[5] << 16); ow.w = vv[6] | ((unsigned)vv[7] << 16);
                *(u32x4*)(ub + MU_VB + ((sl * 2 + ks) * 64 + F.lane) * 8) = ow;
            }
        }
        if (F.lane == 0) FL[unit] = __expf(bl);
        LDS_WAIT(); asm volatile("" ::: "memory");
    }
}
__device__ __forceinline__ void mlstm_scan(const Frame& F_in, int task) {
    const Frame F = relaunder(F_in);
    unsigned char* const L_ws = WSP; bf16* const PROJ = (bf16*)(L_ws + WS_BIG); float* const GATES = (float*)(L_ws + WS_GATES); const float* const FL = (const float*)(L_ws + WS_MISC);
    const int bh = task / 5, sl = task % 5;
    const int b = bh >> 2, h = bh & 3;
    const bf16* ub0 = (const bf16*)(L_ws + WS_MLB) + (size_t)(b * 256 + h * 64) * MU_STRIDE; const bf16* ub = ub0 + F.lane * 8;
    const u32x4 ones = (u32x4){0x3f803f80u, 0x3f803f80u, 0x3f803f80u, 0x3f803f80u};
    f32x4 Ct[4];
#pragma unroll
    for (int i = 0; i < 4; ++i) Ct[i] = (f32x4){0.f, 0.f, 0.f, 0.f};
    bf16x8 QB[8], PT[8], KW[8], VB[2], VN[2]; float fl; unsigned pA = 0, pB = 0, pC = 0, pD = 0;
#define ML_VB(dst, n_) do { const bf16* u_ = ub + (size_t)(n_) * MU_STRIDE; if (sl < 4) { dst[0] = *(const bf16x8*)(u_ + MU_VB + (sl * 2) * 512); dst[1] = *(const bf16x8*)(u_ + MU_VB + (sl * 2 + 1) * 512); } else { dst[0] = __builtin_bit_cast(bf16x8, ones); dst[1] = dst[0]; } } while (0)
#pragma unroll
    for (int f = 0; f < 8; ++f) { QB[f] = *(const bf16x8*)(ub + MU_QB + f * 512); PT[f] = *(const bf16x8*)(ub + MU_PT + f * 512); KW[f] = *(const bf16x8*)(ub + MU_KW + f * 512); }
    int vz = 0; asm volatile("" : "+v"(vz)); ML_VB(VB, 0); fl = FL[b * 256 + h * 64 + vz];
#pragma unroll 1
    for (int n = 0; n < 64; ++n) {
        const int nn = n < 63 ? n + 1 : 63;
        int ln_ = F.lane; asm volatile("" : "+v"(ln_)); const int g = ln_ >> 4, e = ln_ & 15;
        const bf16* un = ub0 + ln_ * 8 + (size_t)nn * MU_STRIDE;
        const float cfl = fl; fl = FL[b * 256 + h * 64 + nn + vz];
        unsigned tA, tB, tC, tD;
        { const int np = n + PF_D < 64 ? n + PF_D : 63; const unsigned char* pb = (const unsigned char*)(ub0 + (size_t)np * MU_STRIDE) + ln_ * 128;
          tA = *(const unsigned*)pb; tB = *(const unsigned*)(pb + 8192); tC = *(const unsigned*)(pb + 16384); tD = *(const unsigned*)(pb + 24576); }
        ML_VB(VN, nn);
        const bf16x8 CB0 = pack_tiles(Ct[0], Ct[1]), CB1 = pack_tiles(Ct[2], Ct[3]);
        const size_t t0 = (size_t)b * SEQ + (size_t)n * 64;
#pragma unroll
        for (int tt = 0; tt < 4; ++tt) {
            f32x4 o = (f32x4){0.f, 0.f, 0.f, 0.f};
            o = MFMA16(QB[tt * 2], CB0, o); o = MFMA16(QB[tt * 2 + 1], CB1, o); o = MFMA16(PT[tt * 2], VB[0], o); o = MFMA16(PT[tt * 2 + 1], VB[1], o);
            QB[tt * 2] = *(const bf16x8*)(un + MU_QB + (tt * 2) * 512); QB[tt * 2 + 1] = *(const bf16x8*)(un + MU_QB + (tt * 2 + 1) * 512);
            PT[tt * 2] = *(const bf16x8*)(un + MU_PT + (tt * 2) * 512); PT[tt * 2 + 1] = *(const bf16x8*)(un + MU_PT + (tt * 2 + 1) * 512);
            if (sl < 4) {
#pragma unroll
                for (int r = 0; r < 4; ++r) PROJ[(t0 + 16 * tt + 4 * g + r) * NPROJ + 1536 + h * 64 + 16 * sl + e] = (bf16)f2bf(o[r]);
            } else if (e == 0) {
#pragma unroll
                for (int r = 0; r < 4; ++r) GATES[(t0 + 16 * tt + 4 * g + r) * 16 + 8 + h] = o[r];
            }
        }
#pragma unroll
        for (int dt = 0; dt < 4; ++dt) { f32x4 c = Ct[dt] * cfl; c = MFMA16(KW[dt * 2], VB[0], c); c = MFMA16(KW[dt * 2 + 1], VB[1], c); Ct[dt] = c;
            KW[dt * 2] = *(const bf16x8*)(un + MU_KW + (dt * 2) * 512); KW[dt * 2 + 1] = *(const bf16x8*)(un + MU_KW + (dt * 2 + 1) * 512); }
        VB[0] = VN[0]; VB[1] = VN[1];
        asm volatile("" :: "v"(pA), "v"(pB), "v"(pC), "v"(pD)); pA = tA; pB = tB; pC = tC; pD = tD;
    }
#undef ML_VB
}

__device__ __forceinline__ float sum16(float v) {
    v += __int_as_float(__builtin_amdgcn_update_dpp(0, __float_as_int(v), 0xB1, 0xF, 0xF, true));
    v += __int_as_float(__builtin_amdgcn_update_dpp(0, __float_as_int(v), 0x4E, 0xF, 0xF, true));
    v += __int_as_float(__builtin_amdgcn_update_dpp(0, __float_as_int(v), 0x141, 0xF, 0xF, true));
    v += __int_as_float(__builtin_amdgcn_update_dpp(0, __float_as_int(v), 0x140, 0xF, 0xF, true));
    return v;
}
__device__ __forceinline__ void m2_post(const Frame& F_in, int l) {
    const Frame F = relaunder(F_in);
    unsigned char* const L_ws = WSP;
    {
        const f32x4* ps = (const f32x4*)(IN_F(1) + (size_t)l * M * PLE); u32x2* pb = (u32x2*)(L_ws + WS_PB);
        const int stride = F.ngw * 64;
        for (int i = F.gw * 64 + F.lane; i < M * PLE / 4; i += 4 * stride) {
            f32x4 v[4];
#pragma unroll
            for (int u = 0; u < 4; ++u) v[u] = ps[i + u * stride];
#pragma unroll
            for (int u = 0; u < 4; ++u) { u32x2 w; w.x = pk2(v[u][0], v[u][1]); w.y = pk2(v[u][2], v[u][3]); pb[i + u * stride] = w; }
        }
    }
    const bf16* const PROJ = (const bf16*)(L_ws + WS_BIG); bf16* const Y = (bf16*)(L_ws + WS_BIG + 176 * MiB); const float* const GATES = (const float*)(L_ws + WS_GATES);
    const f32x4 gn = *(const f32x4*)(IN_F(7) + l * 64 + ((4 * F.lane) & 63)), mn = *(const f32x4*)(IN_F(10) + l * 256 + 4 * F.lane);
    for (int t = F.gw * 4; t < M; t += F.ngw * 4) {
        u32x2 og[4], zg[4], om[4], pm[4]; float dn[4];
#pragma unroll
        for (int u = 0; u < 4; ++u) { const bf16* row = PROJ + (size_t)(t + u) * NPROJ + 4 * F.lane;
            og[u] = *(const u32x2*)(row + 512); zg[u] = *(const u32x2*)(row + 768); om[u] = *(const u32x2*)(row + 1536); pm[u] = *(const u32x2*)(row + 1792);
            dn[u] = GATES[(size_t)(t + u) * 16 + 8 + (F.lane >> 4)]; }
#pragma unroll
        for (int u = 0; u < 4; ++u) {
            float o[4] = {lo_bf(og[u].x), hi_bf(og[u].x), lo_bf(og[u].y), hi_bf(og[u].y)}, z[4] = {lo_bf(zg[u].x), hi_bf(zg[u].x), lo_bf(zg[u].y), hi_bf(zg[u].y)};
            float rs = 1.0f / sqrtf(sum16((o[0] * o[0] + o[1] * o[1]) + (o[2] * o[2] + o[3] * o[3])) * (1.0f / 64.0f) + EPS);
            float y[4];
#pragma unroll
            for (int i = 0; i < 4; ++i) y[i] = o[i] * rs * gn[i] * (z[i] * sigmoidf_(z[i]));
            u32x2 w; w.x = pk2(y[0], y[1]); w.y = pk2(y[2], y[3]);
            *(u32x2*)(Y + (size_t)(t + u) * DM + 4 * F.lane) = w;
            const float inv = 1.0f / fmaxf(fabsf(dn[u]), 1.0f);
            float hm[4] = {lo_bf(om[u].x) * inv, hi_bf(om[u].x) * inv, lo_bf(om[u].y) * inv, hi_bf(om[u].y) * inv}, p[4] = {lo_bf(pm[u].x), hi_bf(pm[u].x), lo_bf(pm[u].y), hi_bf(pm[u].y)};
            rs = 1.0f / sqrtf(sum16((hm[0] * hm[0] + hm[1] * hm[1]) + (hm[2] * hm[2] + hm[3] * hm[3])) * (1.0f / 64.0f) + EPS);
#pragma unroll
            for (int i = 0; i < 4; ++i) y[i] = hm[i] * rs * mn[i] * sigmoidf_(p[i]);
            w.x = pk2(y[0], y[1]); w.y = pk2(y[2], y[3]);
            *(u32x2*)(Y + (size_t)(t + u) * DM + 256 + 4 * F.lane) = w;
        }
    }
}

__device__ __forceinline__ int crow(int reg, int h) { return (reg & 3) + 8 * (reg >> 2) + 4 * h; }
__device__ __forceinline__ void swa_phase(const Frame& F_in, int l, int blk0) {
    const Frame F = relaunder(F_in);
    unsigned char* const L_ws = WSP; const float* const L_sinks = IN_F(11); const bf16* const L_PROJ = (const bf16*)(L_ws + WS_BIG); bf16* const L_Y = (bf16*)(L_ws + WS_BIG + 176 * MiB); const float* const L_ROPE = (const float*)(L_ws + WS_ROPE);
    LAS bf16* Ks = (LAS bf16*)F.lds;
    LAS bf16* Vt = (LAS bf16*)(F.lds + 36864);
    const float* COS = L_ROPE; const float* SIN = L_ROPE + (size_t)M * 8;
    const int r = F.lane & 31, h = F.lane >> 5;
    for (int unit = (int)blockIdx.x - blk0; unit < 512; unit += F.G - blk0) {
        const int b = unit >> 6, kvh = (unit >> 5) & 1, nb = unit & 31;
        const int tok0 = b * SEQ + nb * 128;
        __syncthreads();
        {
            const int key = F.tid >> 1, half = F.tid & 1; const int tok = tok0 - 128 + key; const bool valid = (nb > 0) || (key >= 128);
            u32x4 kq[4], vq[4];
#pragma unroll
            for (int i = 0; i < 4; ++i) { kq[i] = (u32x4){0u, 0u, 0u, 0u}; vq[i] = (u32x4){0u, 0u, 0u, 0u}; }
            if (valid) {
                const bf16* ksrc = L_PROJ + (size_t)tok * NPROJ + 2560 + kvh * 64 + half * 32;
                const bf16* vsrc = L_PROJ + (size_t)tok * NPROJ + 2688 + kvh * 64 + half * 32;
#pragma unroll
                for (int i = 0; i < 4; ++i) { kq[i] = *(const u32x4*)(ksrc + 8 * i); vq[i] = *(const u32x4*)(vsrc + 8 * i); }
                if (half == 0) {
                    const f32x4 c0 = *(const f32x4*)(COS + (size_t)tok * 8), c1 = *(const f32x4*)(COS + (size_t)tok * 8 + 4);
                    const f32x4 s0 = *(const f32x4*)(SIN + (size_t)tok * 8), s1 = *(const f32x4*)(SIN + (size_t)tok * 8 + 4);
                    float x1[8], x2[8], cs[8], sn[8];
#pragma unroll
                    for (int i = 0; i < 4; ++i) { x1[2 * i] = lo_bf(kq[0][i]); x1[2 * i + 1] = hi_bf(kq[0][i]); x2[2 * i] = lo_bf(kq[1][i]); x2[2 * i + 1] = hi_bf(kq[1][i]); cs[i] = c0[i]; cs[4 + i] = c1[i]; sn[i] = s0[i]; sn[4 + i] = s1[i]; }
#pragma unroll
                    for (int i = 0; i < 4; ++i) {
                        kq[0][i] = pk2(x1[2 * i] * cs[2 * i] - x2[2 * i] * sn[2 * i], x1[2 * i + 1] * cs[2 * i + 1] - x2[2 * i + 1] * sn[2 * i + 1]);
                        kq[1][i] = pk2(x2[2 * i] * cs[2 * i] + x1[2 * i] * sn[2 * i], x2[2 * i + 1] * cs[2 * i + 1] + x1[2 * i + 1] * sn[2 * i + 1]); }
                }
            }
#pragma unroll
            for (int i = 0; i < 4; ++i) *(LAS u32x4*)(Ks + key * 72 + half * 32 + 8 * i) = kq[i];
#pragma unroll
            for (int i = 0; i < 4; ++i)
#pragma unroll
                for (int e = 0; e < 4; ++e) { const int d = half * 32 + 8 * i + 2 * e; Vt[d * 264 + key] = (bf16)(vq[i][e] & 0xffffu); Vt[(d + 1) * 264 + key] = (bf16)(vq[i][e] >> 16); }
        }
        __syncthreads();
        const int g = F.wave >> 1, qhalf = F.wave & 1, qh = kvh * 4 + g;
        const float sink = L_sinks[l * 8 + qh];
#pragma unroll 1
        for (int sub = 0; sub < 2; ++sub) {
            const int q0 = qhalf * 64 + sub * 32;
            const int qtok = tok0 + q0 + r;
            bf16x8 qf[4];
            {
                const bf16* qsrc = L_PROJ + (size_t)qtok * NPROJ + 2048 + qh * 64 + 8 * h;
                u32x4 qw[4];
#pragma unroll
                for (int ks = 0; ks < 4; ++ks) qw[ks] = *(const u32x4*)(qsrc + 16 * ks);
                const f32x4 c0 = *(const f32x4*)(COS + (size_t)qtok * 8), c1 = *(const f32x4*)(COS + (size_t)qtok * 8 + 4);
                const f32x4 s0 = *(const f32x4*)(SIN + (size_t)qtok * 8), s1 = *(const f32x4*)(SIN + (size_t)qtok * 8 + 4);
                float cs[8], sn[8];
#pragma unroll
                for (int i = 0; i < 4; ++i) { cs[i] = c0[i]; cs[4 + i] = c1[i]; sn[i] = s0[i]; sn[4 + i] = s1[i]; }
                u32x4 ow;
#pragma unroll
                for (int i = 0; i < 4; ++i) ow[i] = xshflu(qw[0][i], F.lane ^ 32);
                const float sg = h ? 1.0f : -1.0f;
#pragma unroll
                for (int i = 0; i < 4; ++i) {
                    const float a0 = lo_bf(qw[0][i]), a1 = hi_bf(qw[0][i]), b0 = lo_bf(ow[i]), b1 = hi_bf(ow[i]);
                    qw[0][i] = pk2((a0 * cs[2 * i] + sg * b0 * sn[2 * i]) * 0.125f, (a1 * cs[2 * i + 1] + sg * b1 * sn[2 * i + 1]) * 0.125f); }
#pragma unroll
                for (int ks = 1; ks < 4; ++ks)
#pragma unroll
                    for (int i = 0; i < 4; ++i) qw[ks][i] = pk2(lo_bf(qw[ks][i]) * 0.125f, hi_bf(qw[ks][i]) * 0.125f);
#pragma unroll
                for (int ks = 0; ks < 4; ++ks) qf[ks] = __builtin_bit_cast(bf16x8, qw[ks]);
            }
            f32x16 sc[5];
#pragma unroll
            for (int kb = 0; kb < 5; ++kb) {
                f32x16 a;
#pragma unroll
                for (int i = 0; i < 16; ++i) a[i] = 0.f;
#pragma unroll
                for (int ks = 0; ks < 4; ++ks) { const bf16x8 kf = *(const LAS bf16x8*)(Ks + (q0 + 32 * kb + r) * 72 + 16 * ks + 8 * h); a = __builtin_amdgcn_mfma_f32_32x32x16_bf16(kf, qf[ks], a, 0, 0, 0); }
                sc[kb] = a;
            }
            float mx = sink;
#pragma unroll
            for (int kb = 0; kb < 5; ++kb)
#pragma unroll
                for (int i = 0; i < 16; ++i) { const int kr = 32 * kb + crow(i, h); const bool ok = (kr > r) && (kr <= r + 128) && ((nb > 0) || (q0 + kr >= 128));
                    const float s = ok ? sc[kb][i] : -INFINITY; sc[kb][i] = s; mx = fmaxf(mx, s); }
            mx = fmaxf(mx, xshfl(mx, F.lane ^ 32));
            float ls = 0.f;
#pragma unroll
            for (int kb = 0; kb < 5; ++kb)
#pragma unroll
                for (int i = 0; i < 16; ++i) { const float p = __expf(sc[kb][i] - mx); sc[kb][i] = p; ls += p; }
            ls += xshfl(ls, F.lane ^ 32);
            ls += __expf(sink - mx);
            const float inv = 1.0f / ls;
            f32x16 o[2];
#pragma unroll
            for (int db = 0; db < 2; ++db) {
                f32x16 a;
#pragma unroll
                for (int i = 0; i < 16; ++i) a[i] = 0.f;
#pragma unroll
                for (int kb = 0; kb < 5; ++kb)
#pragma unroll
                    for (int s = 0; s < 2; ++s) {
                        u32x4 pw;
#pragma unroll
                        for (int i = 0; i < 4; ++i) pw[i] = pk2(sc[kb][8 * s + 2 * i], sc[kb][8 * s + 2 * i + 1]);
                        const LAS bf16* vb = Vt + (db * 32 + r) * 264 + q0 + 32 * kb + 16 * s + 4 * h;
                        const s16x4 lo = *(const LAS s16x4*)vb, hi = *(const LAS s16x4*)(vb + 8);
                        const bf16x8 vf = __builtin_shufflevector(lo, hi, 0, 1, 2, 3, 4, 5, 6, 7);
                        a = __builtin_amdgcn_mfma_f32_32x32x16_bf16(vf, __builtin_bit_cast(bf16x8, pw), a, 0, 0, 0);
                    }
                o[db] = a;
            }
            bf16* yp = L_Y + (size_t)qtok * DM + 512 + qh * 64;
#pragma unroll
            for (int db = 0; db < 2; ++db)
#pragma unroll
                for (int gg = 0; gg < 4; ++gg) { u32x2 w; w.x = pk2(o[db][4 * gg] * inv, o[db][4 * gg + 1] * inv); w.y = pk2(o[db][4 * gg + 2] * inv, o[db][4 * gg + 3] * inv);
                    *(u32x2*)(yp + db * 32 + 8 * gg + 4 * h) = w; }
        }
    }
    __syncthreads();
}

__device__ __forceinline__ void final_norm(const Frame& F_in) {
    const Frame F = relaunder(F_in);
    float* const L_out = OUTP; const float* const L_norm_final = IN_F(20);
    for (int m = F.gw; m < M; m += F.ngw) {
        f32x4* xr = (f32x4*)(L_out + (size_t)m * DM) + F.lane; const f32x4* gr = (const f32x4*)L_norm_final + F.lane;
        f32x4 v[4]; float s = 0.f;
#pragma unroll
        for (int j = 0; j < 4; ++j) { v[j] = xr[64 * j]; s += (v[j][0] * v[j][0] + v[j][1] * v[j][1]) + (v[j][2] * v[j][2] + v[j][3] * v[j][3]); }
        const float rs = 1.0f / sqrtf(wave_sum(s, F.lane) * (1.0f / DM) + EPS);
#pragma unroll
        for (int j = 0; j < 4; ++j) xr[64 * j] = v[j] * rs * gr[64 * j];
    }
}

#define RLX_AGENT __ATOMIC_RELAXED, __HIP_MEMORY_SCOPE_AGENT
#define XB_TMO      128
#define XB_XCNT(j)  (256  + 64 * (j))
#define XB_XSUB(j)  (1280 + 64 * (j))
#define XB_XGEN(j)  (2304 + 64 * (j))
#define XB_TOP      3328
#define XB_TOPGEN   3392
#define XCD_BAR_WORDS 3456
#define XB_SPIN_CAP (1u << 18)

__device__ __forceinline__ unsigned xb_ld(unsigned* p)              { return __hip_atomic_load(p, __ATOMIC_RELAXED, __HIP_MEMORY_SCOPE_AGENT); }
__device__ __forceinline__ unsigned xb_add(unsigned* p, unsigned v) { return __hip_atomic_fetch_add(p, v, __ATOMIC_RELAXED, __HIP_MEMORY_SCOPE_AGENT); }
__device__ __forceinline__ unsigned xb_xcc_id() { return (unsigned)__builtin_amdgcn_s_getreg((3 << 11) | 20) & 0xFu; }
#define XB_SPIN(cond, bar) do { unsigned _sp = 0; while (cond) { __builtin_amdgcn_s_sleep(1); \
    if ((++_sp & 255u) == 0u) { if (xb_ld(&(bar)[XB_TMO])) break; if (_sp > XB_SPIN_CAP) { atomicAdd(&(bar)[XB_TMO], 1u); break; } } } } while (0)

struct XcdBarrier {
    unsigned* bar; unsigned x;
    volatile LAS unsigned* st;
};

__device__ __forceinline__ XcdBarrier xcd_barrier_post(unsigned* bar, volatile LAS unsigned* st, bool leader) {
    XcdBarrier b; b.bar = bar; b.x = xb_xcc_id(); b.st = st;
    if (leader) (void)xb_add(&bar[XB_XCNT(b.x)], 1u);
    return b;
}
__device__ __forceinline__ void xcd_barrier_complete(unsigned* bar, unsigned x, unsigned& nloc, unsigned& nx) {
    const unsigned G = gridDim.x * gridDim.y * gridDim.z;
    unsigned sum, cnt, mine, sp = 0u;
    for (;;) {
        sum = 0u; cnt = 0u; mine = 0u;
#pragma unroll
        for (unsigned j = 0; j < 16; ++j) { const unsigned c = xb_ld(&bar[XB_XCNT(j)]); sum += c; cnt += (c > 0u) ? 1u : 0u; mine = (j == x) ? c : mine; }
        if (sum == G) break;
        __builtin_amdgcn_s_sleep(1);
        if ((++sp & 255u) == 0u) { if (xb_ld(&bar[XB_TMO])) break; if (sp > XB_SPIN_CAP) { atomicAdd(&bar[XB_TMO], 1u); break; } }
    }
    nloc = mine > 0u ? mine : 1u; nx = cnt > 0u ? cnt : 1u;
}

__device__ __forceinline__ void xcd_barrier(const XcdBarrier& b, bool leader) {
    asm volatile("s_waitcnt vmcnt(0)" ::: "memory");
    __syncthreads();
    if (leader) {
        unsigned* bar = b.bar;
        __builtin_amdgcn_s_waitcnt(0);
        unsigned nloc = b.st[0], nx = b.st[1];
        if (nloc == 0u) { xcd_barrier_complete(bar, b.x, nloc, nx); b.st[0] = nloc; b.st[1] = nx; }
        const unsigned old = xb_add(&bar[XB_XSUB(b.x)], 1u);
        const unsigned gen = old / nloc;
        if (old + 1u == (gen + 1u) * nloc) {
            __builtin_amdgcn_fence(__ATOMIC_RELEASE, "agent");
            asm volatile("s_waitcnt vmcnt(0)" ::: "memory");
            const unsigned og = xb_add(&bar[XB_TOP], 1u);
            const unsigned tg = og / nx;
            if (og + 1u == (tg + 1u) * nx) xb_add(&bar[XB_TOPGEN], 1u);
            else XB_SPIN(xb_ld(&bar[XB_TOPGEN]) == tg, bar);
            __builtin_amdgcn_fence(__ATOMIC_ACQUIRE, "agent");
            xb_add(&bar[XB_XGEN(b.x)], 1u);
            asm volatile("s_waitcnt vmcnt(0)" ::: "memory");
        } else {
            XB_SPIN(xb_ld(&bar[XB_XGEN(b.x)]) == gen, bar);
            __builtin_amdgcn_fence(__ATOMIC_ACQUIRE, "agent");
            asm volatile("s_waitcnt vmcnt(0)" ::: "memory");
        }
    }
    __syncthreads();
}

__device__ __forceinline__ void gbar(const Frame& F_in, int) {
    XcdBarrier b; b.bar = (unsigned*)(WSP + WS_MISC + 65536); b.x = xb_xcc_id(); b.st = (volatile LAS unsigned*)(F_in.lds + LDS_BYTES);
    int w_ = F_in.wave; asm volatile("" : "+s"(w_));
    xcd_barrier(b, w_ == 0 && lane_id_asm() == 0);
}

__global__ void __launch_bounds__(NTHR, 2) hybrid_fwd(Args args) {
    extern __shared__ __attribute__((aligned(16))) unsigned char lds[];
    cg::grid_group grid = cg::this_grid();
    Frame F;
    F.lds = (LAS unsigned char*)lds;
    F.wave = __builtin_amdgcn_readfirstlane((int)threadIdx.x >> 6); F.tid = 0; F.lane = 0;
    F.G = gridDim.x; F.gw = blockIdx.x * NWAVES + F.wave; F.ngw = F.G * NWAVES;

    volatile LAS unsigned* xst = (volatile LAS unsigned*)(F.lds + LDS_BYTES);
    if (threadIdx.x < 16) xst[threadIdx.x] = 0u;
    __syncthreads();
    const int xb = 0; (void)xcd_barrier_post((unsigned*)(WSP + WS_MISC + 65536), xst, F.wave == 0 && lane_id_asm() == 0);
    convert_weights(F, 0, F.gw, F.ngw);
    p0_prologue(F);
    grid.sync();
#pragma unroll 1
    for (int l = 0; l < NL; ++l) {
#pragma unroll 1
        for (int op = 0; op < 6; ++op) {
            if (op == 1) {
                gbar(F, xb);
                gdn_prep(F, l);
                mlstm_prep(F, l);
                swa_phase(F, l, 0);
                gbar(F, xb);
                {
                    int c = (int)blockIdx.x; asm volatile("" : "+s"(c));
                    if (F.wave == 0) {
                        if (c < 128) gdn_scan(F, ((c & 7) + 8 * (c >> 5)) * 4 + ((c >> 3) & 3));
                        else { const int q = c - 128, j = q >> 3; mlstm_scan(F, ((q & 7) + 8 * (j / 5)) * 5 + (j % 5)); }
                    } else if (F.wave == 2 && c < 32) { const int q = 128 + c, j = q >> 3; mlstm_scan(F, ((q & 7) + 8 * (j / 5)) * 5 + (j % 5)); }
                    else if (F.wave >= 4 && l + 1 < NL) convert_weights(F, l + 1, c * 4 + (F.wave - 4), F.G * 4);
                }
                gbar(F, xb);
                m2_post(F, l);
            }
            if (op != 5 && (l | op) != 0) gbar(F, xb);
            unsigned char* const ws = WSP; unsigned char* const wb = ws + WS_W + (size_t)l * W_LAYER; float* const outp = OUTP;
            float* const ssq0 = (float*)(ws + WS_SSQ); float* const ssq1 = ssq0 + (size_t)M * 16; float* const ssq2 = ssq0 + (size_t)2 * M * 16;
            bf16* const xb = (bf16*)(ws + WS_XB); unsigned char* const big = ws + WS_BIG;
            pg8::Gemm g; pg8::EpiAny E; g.M = M;
            bf16* const xalt = (bf16*)(big + 192 * MiB);
            E.ssq_in = ssq0; E.ssq_out = ssq0; E.base = outp; E.xout = outp; E.ob = xb; E.pp = (const bf16*)big; E.gates = (float*)(ws + WS_GATES);
            if (op == 0)      { g.A = l == 0 ? xb : xalt; g.Bt = (const bf16*)(wb + WO_IN); g.N = NPAD; g.K = DM; E.mode = 0; E.ssq_in = ssq0; E.ob = (bf16*)big; }
            else if (op == 1) { g.A = (const bf16*)(big + 176 * MiB); g.Bt = (const bf16*)(wb + WO_OUT); g.N = DM; g.K = DM; E.mode = 3; E.ssq_out = ssq1; if (l == 0) E.base = IN_F(0); }
            else if (op == 2) { g.A = xb; g.Bt = (const bf16*)(wb + WO_UP); g.N = FF; g.K = DM; E.mode = 1; E.ssq_in = ssq1; E.ob = (bf16*)big; }
            else if (op == 3) { g.A = (const bf16*)big; g.Bt = (const bf16*)(wb + WO_DOWN); g.N = DM; g.K = FF; E.mode = 3; E.ssq_out = ssq2; }
            else if (op == 4) { g.A = (const bf16*)(ws + WS_PB); g.Bt = (const bf16*)(wb + WO_P); g.N = DM; g.K = PLE; E.mode = 2; E.ob = (bf16*)big; }
            else              { g.A = xb; g.Bt = (const bf16*)(wb + WO_G); g.N = DM; g.K = DM; E.mode = 4; E.ssq_in = ssq2; E.ssq_out = ssq0; E.ob = xalt; }
            pg8::StaticOrder S; S.init(M, g.N, F.G, (int)blockIdx.x);
#pragma unroll 1
            for (int rep = 0; rep < ((op == 0 || op == 2) ? REP_G : 1); ++rep)
            pg8::gemm_phase<pg8::EpiAny, pg8::StaticOrder, true, true>(F.lds, g, S, E, F.wave);
        }
    }
    gbar(F, xb);
    final_norm(F);
}

extern "C" void kernel_launch(void* const* d_in, const int* in_sizes, int n_in, void* d_out, int out_size, void* d_ws, size_t ws_size, hipStream_t stream) {
    static int grid = 0;
    if (grid == 0) {
        if (n_in != 21 || out_size != M * DM || ws_size < WS_END) { fprintf(stderr, "kernel_launch: unexpected shapes (n_in %d out %d ws %zu)\n", n_in, out_size, ws_size); grid = -1; return; }
        int dev = 0, cus = 0, per_cu = 0;
        hipGetDevice(&dev); hipDeviceGetAttribute(&cus, hipDeviceAttributeMultiprocessorCount, dev);
        hipFuncSetAttribute((const void*)hybrid_fwd, hipFuncAttributeMaxDynamicSharedMemorySize, LDS_BYTES + 64);
        hipOccupancyMaxActiveBlocksPerMultiprocessor(&per_cu, (const void*)hybrid_fwd, NTHR, LDS_BYTES + 64);
        (void)hipGetLastError();
        if (per_cu < 1) per_cu = 1;
        grid = cus;
        fprintf(stderr, "kernel_launch: cus %d per_cu %d grid %d ws %zu\n", cus, per_cu, grid, ws_size);
    }
    if (grid < 0) return;
    if (hipMemsetAsync((unsigned char*)d_ws + WS_MISC + 65536, 0, 16384, stream) != hipSuccess) { fprintf(stderr, "kernel_launch: memset failed\n"); return; }
    Args a{};
    for (int i = 0; i < 21; ++i) a.in[i] = d_in[i];
    a.out = (float*)d_out; a.ws = (unsigned char*)d_ws;
    void* kargs[] = {&a};
    hipError_t e = hipLaunchCooperativeKernel((const void*)hybrid_fwd, dim3(grid), dim3(NTHR), kargs, LDS_BYTES + 64, stream);
    if (e != hipSuccess) fprintf(stderr, "cooperative launch failed: %s (grid %d)\n", hipGetErrorString(e), grid);
}
```

```cpp
#include <hip/hip_runtime.h>
#include <hip/hip_cooperative_groups.h>
#include <cstdio>
#include <cstdint>
#include <cmath>
namespace pg8 {
#define PG8_LAS __attribute__((address_space(3)))
typedef unsigned short bf16_t;
typedef short bf16x8 __attribute__((ext_vector_type(8)));
typedef float f32x4 __attribute__((ext_vector_type(4)));
typedef unsigned u32x4 __attribute__((ext_vector_type(4)));
constexpr int BM = 256, BK = 64, HALF = 128, HTB = HALF * BK * 2  , STAGE_BYTES = 8 * HTB, NXCD = 8, WGM = 8;

__host__ __device__ __forceinline__ int lds_byte(int r, int c) { const int st = (r >> 4) * 2 + (c >> 5), rr = r & 15, cc = c & 31, ob = rr * 64 + cc * 2; return st * 1024 + (ob ^ (((ob >> 9) & 1) << 5)); }
__host__ __device__ __forceinline__ void stage_rc(int b, int& R, int& C) { const int st = b / 1024, sb = b % 1024, swz = sb ^ (((sb >> 9) & 1) << 5); R = (st >> 1) * 16 + swz / 64; C = (st & 1) * 32 + (swz % 64) / 2; }
__host__ __device__ __forceinline__ int perm32(int rho) { const int n = rho >> 4, i = rho & 15; return 8 * (i >> 2) + 4 * n + (i & 3); }

struct Unit { int pm, pn; };
struct Gemm { const bf16_t* A; const bf16_t* Bt; int M, N, K; };

struct StaticOrder {
    int nM, nN, nwg, G, c;
    __host__ __device__ void init(int M, int N, int G_, int c_) { nM = M / BM; nN = N / BM; nwg = nM * nN; G = G_; c = c_; }
    __host__ __device__ bool next(int i, Unit& u) const {
        const long L = (long)i * G + c; if (L >= nwg) return false;
        int wgid = (int)L; { const int q = nwg / NXCD, r = nwg % NXCD, xcd = wgid % NXCD, off = wgid / NXCD; wgid = (xcd < r ? xcd * (q + 1) : r * (q + 1) + (xcd - r) * q) + off; }
        const int nig = WGM * nN, gid = wgid / nig, fm = gid * WGM, gsz = (nM - fm) < WGM ? (nM - fm) : WGM;
        u.pm = fm + ((wgid % nig) % gsz); u.pn = (wgid % nig) / gsz; return true;
    }
    __device__ __forceinline__ void a_ready(const Unit&) const {}
    __device__ __forceinline__ void done(const Unit&) const {}
};


__device__ __forceinline__ unsigned cvt_pk_bf16(float lo, float hi) { unsigned r; asm volatile("v_cvt_pk_bf16_f32 %0, %1, %2" : "=v"(r) : "v"(lo), "v"(hi)); return r; }
typedef unsigned u32x2 __attribute__((ext_vector_type(2)));
constexpr float RMS_EPS = 1e-6f;
__device__ __forceinline__ float row_rstd(const float* ssq, int row) {
    const f32x4* p = (const f32x4*)(ssq + (size_t)row * 16);
    const f32x4 a = p[0], b = p[1], c = p[2], d = p[3];
    const float s = ((a[0] + a[1]) + (a[2] + a[3])) + ((b[0] + b[1]) + (b[2] + b[3])) + ((c[0] + c[1]) + (c[2] + c[3])) + ((d[0] + d[1]) + (d[2] + d[3]));
    return 1.0f / sqrtf(s * (1.0f / 1024.0f) + RMS_EPS);
}
struct EpiAny {
    static constexpr bool PERM = true, AFTER_DRAIN = false;
    int mode; const float* ssq_in; float* ssq_out; const float* base; float* xout; bf16_t* ob; const bf16_t* pp; float* gates;
    __device__ __forceinline__ void operator()(const f32x4 (&acc)[2][2][4][2], const Unit& u, int wr, int wc, int fr, int fq) const {
        const int row0 = u.pm * BM + wr * 64 + fr; const int col0 = u.pn * BM + wc * 32 + 8 * fq;
        if (mode <= 1) {
            const int ld = mode == 0 ? 2816 : 4096;
            if (mode == 1 || u.pn < 11) {
#pragma unroll
                for (int ai = 0; ai < 2; ++ai)
#pragma unroll
                    for (int m = 0; m < 4; ++m) { const int row = row0 + ai * HALF + m * 16; const float rs = row_rstd(ssq_in, row); bf16_t* rowp = ob + (size_t)row * ld + col0;
#pragma unroll
                        for (int bj = 0; bj < 2; ++bj) { f32x4 v0 = acc[ai][bj][m][0] * rs, v1 = acc[ai][bj][m][1] * rs;
                            if (mode == 1) {
#pragma unroll
                                for (int e = 0; e < 4; ++e) { const float a = fmaxf(v0[e], 0.f), b = fmaxf(v1[e], 0.f); v0[e] = a * a; v1[e] = b * b; } }
                            u32x4 w; w.x = cvt_pk_bf16(v0[0], v0[1]); w.y = cvt_pk_bf16(v0[2], v0[3]); w.z = cvt_pk_bf16(v1[0], v1[1]); w.w = cvt_pk_bf16(v1[2], v1[3]);
                            *(u32x4*)(rowp + bj * HALF) = w; }
                        asm volatile("" ::: "memory"); }
            } else if (wc == 0 && fq < 2) {
#pragma unroll
                for (int ai = 0; ai < 2; ++ai)
#pragma unroll
                    for (int m = 0; m < 4; ++m) { const int row = row0 + ai * HALF + m * 16; const float rs = row_rstd(ssq_in, row); float* gp = gates + (size_t)row * 16 + 8 * fq;
                        *(f32x4*)(gp) = acc[ai][0][m][0] * rs; *(f32x4*)(gp + 4) = acc[ai][0][m][1] * rs; asm volatile("" ::: "memory"); }
            }
        } else if (mode == 2) {
#pragma unroll
            for (int ai = 0; ai < 2; ++ai)
#pragma unroll
                for (int m = 0; m < 4; ++m) { bf16_t* rowp = ob + (size_t)(row0 + ai * HALF + m * 16) * 1024 + col0;
#pragma unroll
                    for (int bj = 0; bj < 2; ++bj) { const f32x4 v0 = acc[ai][bj][m][0], v1 = acc[ai][bj][m][1];
                        u32x4 w; w.x = cvt_pk_bf16(v0[0], v0[1]); w.y = cvt_pk_bf16(v0[2], v0[3]); w.z = cvt_pk_bf16(v1[0], v1[1]); w.w = cvt_pk_bf16(v1[2], v1[3]);
                        *(u32x4*)(rowp + bj * HALF) = w; }
                    asm volatile("" ::: "memory"); }
        } else {
#pragma unroll
            for (int ai = 0; ai < 2; ++ai)
#pragma unroll
                for (int m = 0; m < 4; ++m) { const int row = row0 + ai * HALF + m * 16; const size_t off = (size_t)row * 1024 + col0;
                    const float* bp = base + off; float* xp = xout + off; bf16_t* op = ob + off; const bf16_t* ppp = pp + off;
                    float rs = 1.f; if (mode == 4) rs = row_rstd(ssq_in, row);
                    float s = 0.f;
#pragma unroll
                    for (int bj = 0; bj < 2; ++bj) {
                        f32x4 a0 = acc[ai][bj][m][0], a1 = acc[ai][bj][m][1];
                        const f32x4 b0 = *(const f32x4*)(bp + bj * HALF), b1 = *(const f32x4*)(bp + bj * HALF + 4);
                        if (mode == 4) { const u32x4 pw = *(const u32x4*)(ppp + bj * HALF);
                            const f32x4 p0 = (f32x4){__uint_as_float(pw.x << 16), __uint_as_float(pw.x & 0xffff0000u), __uint_as_float(pw.y << 16), __uint_as_float(pw.y & 0xffff0000u)}, p1 = (f32x4){__uint_as_float(pw.z << 16), __uint_as_float(pw.z & 0xffff0000u), __uint_as_float(pw.w << 16), __uint_as_float(pw.w & 0xffff0000u)};
#pragma unroll
                            for (int e = 0; e < 4; ++e) { a0[e] = p0[e] / (1.0f + __expf(-a0[e] * rs)); a1[e] = p1[e] / (1.0f + __expf(-a1[e] * rs)); } }
                        const f32x4 o0 = b0 + a0, o1 = b1 + a1;
                        *(f32x4*)(xp + bj * HALF) = o0; *(f32x4*)(xp + bj * HALF + 4) = o1;
                        u32x4 w; w.x = cvt_pk_bf16(o0[0], o0[1]); w.y = cvt_pk_bf16(o0[2], o0[3]); w.z = cvt_pk_bf16(o1[0], o1[1]); w.w = cvt_pk_bf16(o1[2], o1[3]);
                        *(u32x4*)(op + bj * HALF) = w;
                        s += ((o0[0] * o0[0] + o0[1] * o0[1]) + (o0[2] * o0[2] + o0[3] * o0[3])) + ((o1[0] * o1[0] + o1[1] * o1[1]) + (o1[2] * o1[2] + o1[3] * o1[3])); }
                    s += __int_as_float(__builtin_amdgcn_ds_bpermute(((fq ^ 1) * 16 + fr) << 2, __float_as_int(s))); s += __int_as_float(__builtin_amdgcn_ds_bpermute(((fq ^ 2) * 16 + fr) << 2, __float_as_int(s)));
                    if (fq == 0) ssq_out[(size_t)row * 16 + u.pn * 4 + wc] = s;
                    asm volatile("" ::: "memory"); }
        }
    }
};

template <class Epi, class Sched, bool ALIGN_EPI = false, bool SP2 = false>
__device__ __forceinline__ void gemm_phase(PG8_LAS unsigned char* lds, const Gemm g, const Sched& S, const Epi& E, int wave_id) {
    int tid_; asm volatile("v_mbcnt_lo_u32_b32 %0, -1, 0\n\tv_mbcnt_hi_u32_b32 %0, -1, %0" : "=v"(tid_)); tid_ += wave_id * 64; const int tid = tid_, wid = __builtin_amdgcn_readfirstlane(tid >> 6), lane = tid & 63, wr = wid >> 2, wc = wid & 3, fr = lane & 15, fq = lane >> 4;
    const int K = g.K, nt = K / BK;
    unsigned voffA[2], voffB[2];
#pragma unroll
    for (int i = 0; i < 2; ++i) { int R, C; stage_rc(tid * 16 + i * 8192, R, C); const int Rb = Epi::PERM ? ((R & ~31) + perm32(R & 31)) : R;
        voffA[i] = (unsigned)(R * K + C) * 2u; voffB[i] = (unsigned)(Rb * K + C) * 2u; }
    const size_t kstep = (size_t)(BK * 2);
    const size_t hstep = (size_t)HALF * K * 2;
    const size_t tstep = 2 * hstep;
    const unsigned ldsw = (unsigned)wid * 1024u;
    const int aoff = lds_byte(wr * 64 + fr, fq * 8), boff = lds_byte(wc * 32 + fr, fq * 8);
#define PG8_SA(b, h) (((b) * 2 + (h)) * HTB)
#define PG8_SB(b, h) ((4 + (b) * 2 + (h)) * HTB)
#define PG8_STAGE(bufoff, gbase, voff) do { _Pragma("unroll") for (int _i = 0; _i < 2; ++_i) \
        __builtin_amdgcn_global_load_lds((const unsigned*)((const char*)(gbase) + (voff)[_i]), (PG8_LAS unsigned*)(lds + (bufoff) + ldsw + _i * 8192), 16, 0, 0); } while (0)
#define PG8_LDA(dst, b, h) do { _Pragma("unroll") for (int m = 0; m < 4; ++m) _Pragma("unroll") for (int k = 0; k < 2; ++k) dst[m][k] = *(const PG8_LAS bf16x8*)(lds + PG8_SA(b, h) + aoff + m * 2048 + k * 1024); } while (0)
#define PG8_LDB(dst, b, h) do { _Pragma("unroll") for (int n = 0; n < 2; ++n) _Pragma("unroll") for (int k = 0; k < 2; ++k) dst[n][k] = *(const PG8_LAS bf16x8*)(lds + PG8_SB(b, h) + boff + n * 2048 + k * 1024); } while (0)
#define PG8_MMA(ai, bj, At, Bt) do { __builtin_amdgcn_s_setprio(1); _Pragma("unroll") for (int m = 0; m < 4; ++m) _Pragma("unroll") for (int n = 0; n < 2; ++n) _Pragma("unroll") for (int k = 0; k < 2; ++k) \
        acc[ai][bj][m][n] = __builtin_amdgcn_mfma_f32_16x16x32_bf16(Bt[n][k], At[m][k], acc[ai][bj][m][n], 0, 0, 0); __builtin_amdgcn_s_setprio(0); } while (0)
#define PG8_WAIT_V(n) asm volatile("s_waitcnt vmcnt(" #n ")" ::: "memory")
#define PG8_WAIT_L(n) asm volatile("s_waitcnt lgkmcnt(" #n ")" ::: "memory")
#define PG8_BAR __builtin_amdgcn_s_barrier()
#define PG8_SCHED __builtin_amdgcn_sched_barrier(0)
    Unit cur, nxt; int ui = 0;
    if (!S.next(0, cur)) return;
    f32x4 acc[2][2][4][2];
#pragma unroll
    for (int a = 0; a < 2; ++a)
#pragma unroll
        for (int b = 0; b < 2; ++b)
#pragma unroll
            for (int m = 0; m < 4; ++m)
#pragma unroll
                for (int n = 0; n < 2; ++n) acc[a][b][m][n] = (f32x4){0.f, 0.f, 0.f, 0.f};
    bf16x8 At[4][2], B0[2][2], B1[2][2];
    const char* cA = (const char*)g.A + (size_t)cur.pm * tstep; const char* cB = (const char*)g.Bt + (size_t)cur.pn * tstep;
    S.a_ready(cur);
    if constexpr (SP2) {
        PG8_STAGE(PG8_SB(0, 0), cB, voffB); PG8_STAGE(PG8_SB(0, 1), cB + hstep, voffB); PG8_STAGE(PG8_SA(0, 0), cA, voffA); PG8_STAGE(PG8_SA(0, 1), cA + hstep, voffA);
        if (wr == 1) PG8_BAR;
        PG8_WAIT_V(2); PG8_BAR;
        PG8_STAGE(PG8_SB(1, 0), cB + kstep, voffB); PG8_STAGE(PG8_SA(1, 0), cA + kstep, voffA); PG8_STAGE(PG8_SB(1, 1), cB + hstep + kstep, voffB);
        PG8_WAIT_V(6); PG8_BAR;
    } else {
        PG8_STAGE(PG8_SB(0, 0), cB, voffB); PG8_STAGE(PG8_SA(0, 0), cA, voffA); PG8_STAGE(PG8_SB(0, 1), cB + hstep, voffB); PG8_STAGE(PG8_SA(0, 1), cA + hstep, voffA);
        if (wr == 1) PG8_BAR;
        PG8_WAIT_V(4); PG8_BAR;
        PG8_STAGE(PG8_SB(1, 0), cB + kstep, voffB); PG8_STAGE(PG8_SA(1, 0), cA + kstep, voffA); PG8_STAGE(PG8_SB(1, 1), cB + hstep + kstep, voffB);
        PG8_WAIT_V(6); PG8_BAR;
    }
    for (;;) {
        const bool has_next = S.next(ui + 1, nxt);
        const char* nA = has_next ? (const char*)g.A + (size_t)nxt.pm * tstep : cA; const char* nB = has_next ? (const char*)g.Bt + (size_t)nxt.pn * tstep : cB;
        for (int t = 0; t < nt; t += 2) {
            const bool last = (t == nt - 2);
            const char* a1 = cA + (size_t)(t + 1) * kstep;
            const char* a2 = last ? nA : cA + (size_t)(t + 2) * kstep; const char* b2 = last ? nB : cB + (size_t)(t + 2) * kstep;
            const char* a3 = a2 + kstep; const char* b3 = b2 + kstep;
            if (last && has_next) S.a_ready(nxt);
            if constexpr (SP2) {
            PG8_LDB(B0, 0, 0); PG8_LDB(B1, 0, 1); PG8_SCHED; PG8_LDA(At, 0, 0); PG8_STAGE(PG8_SA(1, 1), a1 + hstep, voffA);
            PG8_WAIT_V(8); PG8_WAIT_L(0); PG8_BAR; PG8_MMA(0, 0, At, B0); PG8_MMA(0, 1, At, B1); PG8_BAR; PG8_SCHED;
            PG8_LDA(At, 0, 1); PG8_STAGE(PG8_SB(0, 0), b2, voffB); PG8_STAGE(PG8_SB(0, 1), b2 + hstep, voffB); PG8_STAGE(PG8_SA(0, 0), a2, voffA);
            PG8_WAIT_V(8); PG8_WAIT_L(0); PG8_BAR; PG8_MMA(1, 0, At, B0); PG8_MMA(1, 1, At, B1); PG8_BAR; PG8_SCHED;
            PG8_LDB(B0, 1, 0); PG8_LDB(B1, 1, 1); PG8_SCHED; PG8_LDA(At, 1, 0); PG8_STAGE(PG8_SA(0, 1), a2 + hstep, voffA);
            PG8_WAIT_V(8); PG8_WAIT_L(0); PG8_BAR; PG8_MMA(0, 0, At, B0); PG8_MMA(0, 1, At, B1); PG8_BAR; PG8_SCHED;
            PG8_LDA(At, 1, 1); PG8_STAGE(PG8_SB(1, 0), b3, voffB); PG8_STAGE(PG8_SB(1, 1), b3 + hstep, voffB); PG8_STAGE(PG8_SA(1, 0), a3, voffA);
            PG8_WAIT_V(8); PG8_WAIT_L(0); PG8_BAR; PG8_MMA(1, 0, At, B0); PG8_MMA(1, 1, At, B1); PG8_BAR; PG8_SCHED;
            } else {
            PG8_LDB(B0, 0, 0); PG8_SCHED; PG8_LDA(At, 0, 0); PG8_STAGE(PG8_SA(1, 1), a1 + hstep, voffA);
            PG8_WAIT_L(8); PG8_BAR; PG8_WAIT_L(0); PG8_MMA(0, 0, At, B0); PG8_BAR; PG8_SCHED;
            PG8_LDB(B1, 0, 1); PG8_STAGE(PG8_SB(0, 0), b2, voffB);
            PG8_BAR; PG8_WAIT_L(0); PG8_MMA(0, 1, At, B1); PG8_BAR;
            PG8_LDA(At, 0, 1); PG8_STAGE(PG8_SA(0, 0), a2, voffA);
            PG8_BAR; PG8_WAIT_L(0); PG8_MMA(1, 0, At, B0); PG8_BAR; PG8_SCHED;
            PG8_STAGE(PG8_SB(0, 1), b2 + hstep, voffB);
            PG8_WAIT_V(6); PG8_BAR; PG8_MMA(1, 1, At, B1); PG8_BAR;
            PG8_LDB(B0, 1, 0); PG8_SCHED; PG8_LDA(At, 1, 0); PG8_STAGE(PG8_SA(0, 1), a2 + hstep, voffA);
            PG8_WAIT_L(8); PG8_BAR; PG8_WAIT_L(0); PG8_MMA(0, 0, At, B0); PG8_BAR; PG8_SCHED;
            PG8_LDB(B1, 1, 1); PG8_STAGE(PG8_SB(1, 0), b3, voffB);
            PG8_BAR; PG8_WAIT_L(0); PG8_MMA(0, 1, At, B1); PG8_BAR;
            PG8_LDA(At, 1, 1); PG8_STAGE(PG8_SA(1, 0), a3, voffA);
            PG8_BAR; PG8_WAIT_L(0); PG8_MMA(1, 0, At, B0); PG8_BAR; PG8_SCHED;
            PG8_STAGE(PG8_SB(1, 1), b3 + hstep, voffB);
            PG8_WAIT_V(6); PG8_BAR; PG8_MMA(1, 1, At, B1); PG8_BAR;
            }
        }
        if constexpr (ALIGN_EPI) { if (wr == 0) PG8_BAR; }
        if constexpr (!Epi::AFTER_DRAIN) { E(acc, cur, wr, wc, fr, fq); S.done(cur); }
        if (!has_next) break;
#pragma unroll
        for (int a = 0; a < 2; ++a)
#pragma unroll
            for (int b = 0; b < 2; ++b)
#pragma unroll
                for (int m = 0; m < 4; ++m)
#pragma unroll
                    for (int n = 0; n < 2; ++n) acc[a][b][m][n] = (f32x4){0.f, 0.f, 0.f, 0.f};
        cur = nxt; cA = nA; cB = nB; ++ui;
        if constexpr (ALIGN_EPI) { if (wr == 1) PG8_BAR; }
    }
    PG8_WAIT_V(0);
    if constexpr (!ALIGN_EPI) { if (wr == 0) PG8_BAR; }
    PG8_BAR;
    if constexpr (Epi::AFTER_DRAIN) { E.fused(acc, cur, wr, wc, fr, fq, lds, wid, lane); S.done(cur); }
#undef PG8_SA
#undef PG8_SB
#undef PG8_STAGE
#undef PG8_LDA
#undef PG8_LDB
#undef PG8_MMA
#undef PG8_WAIT_V
#undef PG8_WAIT_L
#undef PG8_BAR
#undef PG8_SCHED
}
}

namespace cg = cooperative_groups;
#define LAS __attribute__((address_space(3)))
typedef unsigned short bf16;
typedef float f32x4 __attribute__((ext_vector_type(4)));
typedef float f32x16 __attribute__((ext_vector_type(16)));
typedef short bf16x8 __attribute__((ext_vector_type(8)));
typedef short s16x4 __attribute__((ext_vector_type(4)));
typedef unsigned u32x4 __attribute__((ext_vector_type(4)));
typedef unsigned u32x2 __attribute__((ext_vector_type(2)));

constexpr int NWAVES = 8, NTHR = 512;
constexpr int BATCH = 8, SEQ = 4096, DM = 1024, M = BATCH * SEQ, NL = 4, FF = 4096, PLE = 256;
constexpr int NPROJ = 2816, NPAD = 3072, INC = 2832;
constexpr float EPS = 1e-6f;
constexpr int LDS_BYTES = 147456;
constexpr int PF_D = 4;
constexpr int REP_MIX = 1, REP_G = 1, REP_BAR = 1, REP_P1 = 1, REP_P2 = 2, REP_P3 = 1;

constexpr size_t MiB = 1u << 20;
constexpr size_t W_LAYER = 27 * MiB;
constexpr size_t WO_IN = 0, WO_OUT = 6 * MiB, WO_UP = 8 * MiB, WO_DOWN = 16 * MiB, WO_G = 24 * MiB, WO_P = 26 * MiB;
constexpr size_t WS_W = 0;
constexpr size_t WS_XB = 108 * MiB;
constexpr size_t WS_SSQ = 172 * MiB;
constexpr size_t WS_ROPE = 178 * MiB;
constexpr size_t WS_GATES = 180 * MiB;
constexpr size_t WS_PB = 182 * MiB;
constexpr size_t WS_QKVC = 198 * MiB;
constexpr size_t WS_BIG = 246 * MiB;
constexpr size_t WS_MISC = 502 * MiB;
constexpr size_t WS_END = 503 * MiB;
constexpr size_t WS_MLB = WS_XB;
constexpr int GU_W = 0, GU_QD = 4096, GU_KD = 8192, GU_U = 12288, GU_QK = 16384, GU_STRIDE = 19456;
constexpr int GDN_NA = 1724;
constexpr int WAVE_LDS = 18432;
constexpr int MU_QB = 0, MU_PT = 4096, MU_KW = 8192, MU_VB = 12288, MU_STRIDE = 16384;

struct Args { const void* in[21]; float* out; unsigned char* ws; };

struct Frame {
    LAS unsigned char* lds;
    int tid, lane, wave, G, gw, ngw;
};
typedef const __attribute__((address_space(4))) void* kptr_t;
__device__ __forceinline__ const void* karg(int i) {
    kptr_t kp = (kptr_t)__builtin_amdgcn_kernarg_segment_ptr();
    asm volatile("" : "+s"(kp));
    return ((const void* const __attribute__((address_space(4)))*)kp)[i];
}
__device__ __forceinline__ int lane_id_asm();
__device__ __forceinline__ Frame relaunder(const Frame& f) {
    Frame r = f;
    r.lane = lane_id_asm(); r.tid = r.wave * 64 + r.lane;
    asm volatile("" : "+v"(r.tid), "+v"(r.lane));
    asm volatile("" : "+s"(r.wave), "+s"(r.gw), "+s"(r.ngw), "+s"(r.G));
    return r;
}
#define IN_F(i) ((const float*)karg(i))
#define OUTP ((float*)karg(21))
#define WSP ((unsigned char*)karg(22))

__device__ __forceinline__ float bf2f(unsigned short b) { return __uint_as_float((unsigned)b << 16); }
typedef float f32x2_t __attribute__((ext_vector_type(2))); typedef __bf16 bf16x2_t __attribute__((ext_vector_type(2)));
__device__ __forceinline__ unsigned pk2(float lo, float hi) { f32x2_t v = {lo, hi}; bf16x2_t b = __builtin_convertvector(v, bf16x2_t); return __builtin_bit_cast(unsigned, b); }
__device__ __forceinline__ unsigned f2bf(float f) { return pk2(f, 0.f) & 0xffffu; }
__device__ __forceinline__ float lo_bf(unsigned w) { return __uint_as_float(w << 16); }
__device__ __forceinline__ float hi_bf(unsigned w) { return __uint_as_float(w & 0xffff0000u); }
__device__ __forceinline__ int lane_id_asm() { int l; asm volatile("v_mbcnt_lo_u32_b32 %0, -1, 0\n\tv_mbcnt_hi_u32_b32 %0, -1, %0" : "=v"(l)); return l; }
__device__ __forceinline__ float xshfl(float v, int src_lane) { return __int_as_float(__builtin_amdgcn_ds_bpermute(src_lane << 2, __float_as_int(v))); }
__device__ __forceinline__ unsigned xshflu(unsigned v, int src_lane) { return (unsigned)__builtin_amdgcn_ds_bpermute(src_lane << 2, (int)v); }
__device__ __forceinline__ float wave_sum(float v, int lane) {
#pragma unroll
    for (int o = 1; o < 64; o <<= 1) v += xshfl(v, lane ^ o);
    return v;
}
#define LDS_WAIT() asm volatile("s_waitcnt lgkmcnt(0)" ::: "memory")
__device__ __forceinline__ float sigmoidf_(float x) { return 1.0f / (1.0f + __expf(-x)); }
__device__ __forceinline__ float softplusf_(float x) { return fmaxf(x, 0.f) + log1pf(__expf(-fabsf(x))); }
__device__ __forceinline__ float sum8(float v) {
    v += __int_as_float(__builtin_amdgcn_update_dpp(0, __float_as_int(v), 0xB1, 0xF, 0xF, true));
    v += __int_as_float(__builtin_amdgcn_update_dpp(0, __float_as_int(v), 0x4E, 0xF, 0xF, true));
    v += __int_as_float(__builtin_amdgcn_update_dpp(0, __float_as_int(v), 0x141, 0xF, 0xF, true));
    return v;
}

__device__ __forceinline__ int win_src_col(int n) {
    if (n < 1024) return n;
    if (n < 2048) return n + 8;
    if (n < 2816) return n + 16;
    if (n < 2824) return 1024 + (n - 2816);
    if (n < 2832) return 2056 + (n - 2824);
    return -1;
}
template <int MAP>
__device__ __forceinline__ void transpose_item(const float* W, int K, int N, bf16* WT, const float* gain, LAS float* scr, int kb, int nb, int lane) {
    const int k0 = 64 * kb, n0 = 32 * nb;
    const int nd = n0 + (lane & 31);
    const int ns = MAP ? win_src_col(nd) : nd;
#pragma unroll 8
    for (int i = 0; i < 32; ++i) { const int kk = 2 * i + (lane >> 5); float v = 0.f; if (ns >= 0) v = W[(size_t)(k0 + kk) * N + ns]; if (gain) v *= gain[k0 + kk]; scr[kk * 33 + (lane & 31)] = v; }
    LDS_WAIT(); asm volatile("" ::: "memory");
    const int c = lane & 7;
#pragma unroll
    for (int j = 0; j < 4; ++j) { const int n = (lane >> 3) + 8 * j; const LAS float* s = scr + (8 * c) * 33 + n;
        u32x4 o; o.x = pk2(s[0 * 33], s[1 * 33]); o.y = pk2(s[2 * 33], s[3 * 33]); o.z = pk2(s[4 * 33], s[5 * 33]); o.w = pk2(s[6 * 33], s[7 * 33]);
        *(u32x4*)(WT + (size_t)(n0 + n) * K + k0 + 8 * c) = o; }
    LDS_WAIT(); asm volatile("" ::: "memory");
}
__device__ __forceinline__ void convert_weights(const Frame& F_in, int l, int idx, int nidx) {
    const Frame F = relaunder(F_in);
    unsigned char* const L_ws = WSP; const float* const L_w_in = IN_F(3); const float* const L_w_out = IN_F(12); const float* const L_w_up = IN_F(15); const float* const L_w_down = IN_F(16); const float* const L_w_g = IN_F(18); const float* const L_w_p = IN_F(19);
    const float* const L_norm_mix = IN_F(13); const float* const L_norm_mlp = IN_F(14); const float* const L_norm_ple = IN_F(17);
    LAS float* scr = (LAS float*)(F.lds + F.wave * 16384);
    constexpr int I_IN = 16 * 96, I_OUT = 16 * 32, I_UP = 16 * 128, I_DOWN = 64 * 32, I_G = 16 * 32, I_P = 4 * 32;
    constexpr int I_LAYER = I_IN + I_OUT + I_UP + I_DOWN + I_G + I_P;
    unsigned char* wb = L_ws + WS_W + (size_t)(l & 1) * W_LAYER;
    for (int it = idx; it < I_LAYER; it += nidx) {
        int r = it;
        if (r < I_IN) { transpose_item<1>(L_w_in + (size_t)l * DM * INC, DM, INC, (bf16*)(wb + WO_IN), L_norm_mix + l * DM, scr, r / 96, r % 96, F.lane); continue; } r -= I_IN;
        if (r < I_OUT) { transpose_item<0>(L_w_out + (size_t)l * DM * DM, DM, DM, (bf16*)(wb + WO_OUT), nullptr, scr, r / 32, r % 32, F.lane); continue; } r -= I_OUT;
        if (r < I_UP) { transpose_item<0>(L_w_up + (size_t)l * DM * FF, DM, FF, (bf16*)(wb + WO_UP), L_norm_mlp + l * DM, scr, r / 128, r % 128, F.lane); continue; } r -= I_UP;
        if (r < I_DOWN) { transpose_item<0>(L_w_down + (size_t)l * FF * DM, FF, DM, (bf16*)(wb + WO_DOWN), nullptr, scr, r / 32, r % 32, F.lane); continue; } r -= I_DOWN;
        if (r < I_G) { transpose_item<0>(L_w_g + (size_t)l * DM * DM, DM, DM, (bf16*)(wb + WO_G), L_norm_ple + l * DM, scr, r / 32, r % 32, F.lane); continue; } r -= I_G;
        transpose_item<0>(L_w_p + (size_t)l * PLE * DM, PLE, DM, (bf16*)(wb + WO_P), nullptr, scr, r / 32, r % 32, F.lane);
    }
}
__device__ __forceinline__ void p0_prologue(const Frame& F_in) {
    const Frame F = relaunder(F_in);
    unsigned char* const L_ws = WSP; const float* const L_in_x = IN_F(0); const int* const L_in_pos = (const int*)karg(2);
    bf16* const L_XB = (bf16*)(L_ws + WS_XB); float* const L_SSQ = (float*)(L_ws + WS_SSQ); float* const L_ROPE = (float*)(L_ws + WS_ROPE);
    for (int m = F.gw; m < M; m += F.ngw) {
        const f32x4* xr = (const f32x4*)(L_in_x + (size_t)m * DM) + F.lane; float s = 0.f;
        unsigned long long* o8 = (unsigned long long*)(L_XB + (size_t)m * DM) + F.lane;
#pragma unroll
        for (int j = 0; j < 4; ++j) { const f32x4 v = xr[64 * j]; s += (v[0] * v[0] + v[1] * v[1]) + (v[2] * v[2] + v[3] * v[3]);
            o8[64 * j] = (unsigned long long)pk2(v[0], v[1]) | ((unsigned long long)pk2(v[2], v[3]) << 32); }
        s = wave_sum(s, F.lane);
        if (F.lane < 16) L_SSQ[(size_t)m * 16 + F.lane] = (F.lane == 0) ? s : 0.f;
    }
    for (int i = F.gw * 64 + F.lane; i < M * 8; i += F.ngw * 64) {
        const int t = i >> 3, j = i & 7;
        const float inv = (float)exp(-(double)(2 * j) / 16.0 * 13.122363377404328);
        const float ang = (float)L_in_pos[t] * inv;
        const double a = (double)ang; const double rev = a * 0.15915494309189535; const double fr = rev - floor(rev + 0.5);
        const float rad = (float)(fr * 6.283185307179586);
        L_ROPE[i] = cosf(rad); L_ROPE[(size_t)M * 8 + i] = sinf(rad);
    }
}

#define MFMA16(a, b, c) __builtin_amdgcn_mfma_f32_16x16x32_bf16((a), (b), (c), 0, 0, 0)
__device__ __forceinline__ int kperm(int ks, int g, int j) { return 32 * ks + 16 * (j >> 2) + 4 * g + (j & 3); }
__device__ __forceinline__ bf16x8 pack_tiles(const f32x4& a, const f32x4& b) { u32x4 w; w.x = pk2(a[0], a[1]); w.y = pk2(a[2], a[3]); w.z = pk2(b[0], b[1]); w.w = pk2(b[2], b[3]); return __builtin_bit_cast(bf16x8, w); }

__device__ __forceinline__ bf16* gdn_ubuf(unsigned char* ws, int unit) {
    return unit < GDN_NA ? (bf16*)(ws + WS_PB) + (size_t)unit * GU_STRIDE : (bf16*)(ws + WS_BIG + 240 * MiB) + (size_t)(unit - GDN_NA) * GU_STRIDE;
}
__device__ __forceinline__ int qk_idx(int tt, int ks) { return tt < 2 ? tt : 2 + (tt - 2) * 2 + ks; }
__device__ __forceinline__ bf16x8 conv8(const bf16* PROJ, size_t tok, int sp, int ch0, const f32x4 (&w)[4][2]) {
    float a[8];
#pragma unroll
    for (int j = 0; j < 8; ++j) a[j] = 0.f;
#pragma unroll
    for (int tap = 0; tap < 4; ++tap) if (sp - 3 + tap >= 0) {
        const u32x4 raw = *(const u32x4*)(PROJ + (tok - 3 + tap) * NPROJ + ch0);
#pragma unroll
        for (int i = 0; i < 4; ++i) { a[2 * i] += w[tap][i >> 1][(2 * i) & 3] * lo_bf(raw[i]); a[2 * i + 1] += w[tap][i >> 1][(2 * i + 1) & 3] * hi_bf(raw[i]); }
    }
    u32x4 o;
#pragma unroll
    for (int i = 0; i < 4; ++i) o[i] = pk2(a[2 * i] * sigmoidf_(a[2 * i]), a[2 * i + 1] * sigmoidf_(a[2 * i + 1]));
    return __builtin_bit_cast(bf16x8, o);
}
__device__ __forceinline__ void solve64(float (&x)[64], const LAS float* Lm) {
#pragma unroll
    for (int c = 1; c < 64; ++c) {
        int one = 1; asm volatile("" : "+s"(one));
        if (one) {
            float a = x[c];
#pragma unroll
            for (int s4 = 0; s4 < (c + 3) / 4; ++s4) { const f32x4 lv = *(const LAS f32x4*)(Lm + c * 64 + 4 * s4);
#pragma unroll
                for (int i = 0; i < 4; ++i) if (4 * s4 + i < c) a -= lv[i] * x[4 * s4 + i]; }
            x[c] = a;
        }
    }
}
__device__ __forceinline__ void gdn_prep(const Frame& F_in, int l) {
    const Frame F = relaunder(F_in);
    unsigned char* const L_ws = WSP; const float* const cw = IN_F(4) + (size_t)l * 4 * 768; const float* const L_a_log = IN_F(5); const float* const L_dt_bias = IN_F(6);
    const bf16* const PROJ = (const bf16*)(L_ws + WS_BIG); const float* const GATES = (const float*)(L_ws + WS_GATES); float* const GL = (float*)(L_ws + WS_MISC) + 2048;
    LAS float* Lm = (LAS float*)(F.lds + F.wave * WAVE_LDS);
    LAS bf16* T = (LAS bf16*)Lm;
    LAS float* gcv = Lm + 4096; LAS float* bkv = gcv + 64; LAS float* rkv = gcv + 128; LAS float* qdf = gcv + 192; LAS float* wfv = gcv + 256; LAS float* kdf = gcv + 320; LAS float* btv = gcv + 384;
    int g, m, lane;
#define RELANE() do { int ln_ = F.lane; asm volatile("" : "+v"(ln_)); lane = ln_; g = ln_ >> 4; m = ln_ & 15; } while (0)
    for (int unit = F.gw; unit < 2048; unit += F.ngw) {
        RELANE();
        const int h = (unit >> 6) & 3, n = unit & 63; const size_t t0 = (size_t)(unit >> 8) * SEQ + (size_t)n * 64;
        bf16* const ub = gdn_ubuf(L_ws, unit);
        float gl, gc_own, beta_own;
        {
            const float* gr = GATES + (t0 + lane) * 16;
            beta_own = sigmoidf_(gr[h]);
            float gs = -__expf(L_a_log[l * 4 + h]) * softplusf_(gr[4 + h] + L_dt_bias[l * 4 + h]);
#pragma unroll
            for (int o = 1; o < 64; o <<= 1) { const float t = xshfl(gs, lane >= o ? lane - o : lane); if (lane >= o) gs += t; }
            gc_own = gs; gl = __int_as_float(__builtin_amdgcn_readlane(__float_as_int(gs), 63));
            gcv[lane] = gs; btv[lane] = beta_own;
        }
        RELANE();
        bf16x8 FQ[4][2], FK[4][2];
#pragma unroll
        for (int ks = 0; ks < 2; ++ks) {
            f32x4 wq[4][2], wk[4][2];
#pragma unroll
            for (int tap = 0; tap < 4; ++tap) { const float* wp = cw + tap * 768 + h * 64 + 32 * ks + 8 * g; wq[tap][0] = *(const f32x4*)wp; wq[tap][1] = *(const f32x4*)(wp + 4); wk[tap][0] = *(const f32x4*)(wp + 256); wk[tap][1] = *(const f32x4*)(wp + 260); }
#pragma unroll
            for (int mt = 0; mt < 4; ++mt) { int one_ = 1; asm volatile("" : "+s"(one_)); if (one_) {
                FQ[mt][ks] = conv8(PROJ, t0 + 16 * mt + m, 64 * n + 16 * mt + m, h * 64 + 32 * ks + 8 * g, wq);
                FK[mt][ks] = conv8(PROJ, t0 + 16 * mt + m, 64 * n + 16 * mt + m, 256 + h * 64 + 32 * ks + 8 * g, wk);
            } }
        }
        RELANE();
#pragma unroll
        for (int tt = 0; tt < 4; ++tt) {
            f32x4 ak = (f32x4){0.f, 0.f, 0.f, 0.f}, aq = ak;
            ak = MFMA16(FK[tt][0], FK[tt][0], ak); ak = MFMA16(FK[tt][1], FK[tt][1], ak);
            aq = MFMA16(FQ[tt][0], FQ[tt][0], aq); aq = MFMA16(FQ[tt][1], FQ[tt][1], aq);
            const int r = m & 3;
            const float dk_ = r == 0 ? ak[0] : r == 1 ? ak[1] : r == 2 ? ak[2] : ak[3];
            const float dq_ = r == 0 ? aq[0] : r == 1 ? aq[1] : r == 2 ? aq[2] : aq[3];
            if ((m >> 2) == g) { rkv[16 * tt + m] = 1.0f / sqrtf(dk_ + EPS); qdf[16 * tt + m] = 0.125f / sqrtf(dq_ + EPS); }
        }
        LDS_WAIT(); asm volatile("" ::: "memory");
        RELANE();
        {
            const float rk = rkv[lane], rq = qdf[lane];
            LDS_WAIT(); asm volatile("" ::: "memory");
            bkv[lane] = beta_own * rk; wfv[lane] = beta_own * rk * __expf(gc_own); kdf[lane] = rk * __expf(gl - gc_own); qdf[lane] = rq;
        }
        LDS_WAIT(); asm volatile("" ::: "memory");
        RELANE();
#pragma unroll
        for (int tt = 0; tt < 4; ++tt) { int one_ = 1; asm volatile("" : "+s"(one_)); if (one_) {
            const float gct = gcv[16 * tt + m], rqt = qdf[16 * tt + m];
#pragma unroll
            for (int ks = 0; ks < 2; ++ks) if (2 * ks <= tt) {
                u32x4 ow = (u32x4){0u, 0u, 0u, 0u};
#pragma unroll
                for (int hf = 0; hf < 2; ++hf) { const int st = 2 * ks + hf;
                    if (st <= tt) {
                        f32x4 acc = (f32x4){0.f, 0.f, 0.f, 0.f};
                        acc = MFMA16(FK[st][0], FQ[tt][0], acc); acc = MFMA16(FK[st][1], FQ[tt][1], acc);
                        const f32x4 gcs = *(const LAS f32x4*)(gcv + 16 * st + 4 * g), rks = *(const LAS f32x4*)(rkv + 16 * st + 4 * g);
                        float v[4];
#pragma unroll
                        for (int r = 0; r < 4; ++r) { const int sI = 16 * st + 4 * g + r, tI = 16 * tt + m; v[r] = (sI <= tI) ? acc[r] * rqt * rks[r] * __expf(gct - gcs[r]) : 0.f; }
                        ow[2 * hf] = pk2(v[0], v[1]); ow[2 * hf + 1] = pk2(v[2], v[3]);
                    } }
                *(u32x4*)(ub + GU_QK + (qk_idx(tt, ks) * 64 + lane) * 8) = ow;
            }
        } }
        RELANE();
#pragma unroll
        for (int mt = 0; mt < 4; ++mt)
#pragma unroll
            for (int ks = 0; ks < 2; ++ks) *(LAS bf16x8*)(T + (16 * mt + m) * 72 + 32 * ks + 8 * g) = FQ[mt][ks];
        LDS_WAIT(); asm volatile("" ::: "memory");
#pragma unroll
        for (int mt = 0; mt < 4; ++mt) {
            const float f = qdf[16 * mt + m] * __expf(gcv[16 * mt + m]);
#pragma unroll
            for (int ks = 0; ks < 2; ++ks) {
                const u32x2 lo = *(const LAS u32x2*)(T + (16 * mt + m) * 72 + 32 * ks + 4 * g), hi = *(const LAS u32x2*)(T + (16 * mt + m) * 72 + 32 * ks + 16 + 4 * g);
                u32x4 ow; ow.x = pk2(lo_bf(lo.x) * f, hi_bf(lo.x) * f); ow.y = pk2(lo_bf(lo.y) * f, hi_bf(lo.y) * f); ow.z = pk2(lo_bf(hi.x) * f, hi_bf(hi.x) * f); ow.w = pk2(lo_bf(hi.y) * f, hi_bf(hi.y) * f);
                *(u32x4*)(ub + GU_QD + ((mt * 2 + ks) * 64 + lane) * 8) = ow;
            }
        }
        LDS_WAIT(); asm volatile("" ::: "memory");
        RELANE();
        float xw[64];
        {
            const int chk = 256 + h * 64 + lane;
            const float k0 = cw[chk], k1 = cw[768 + chk], k2 = cw[1536 + chk], k3 = cw[2304 + chk];
            float ka = 0.f, kb = 0.f, kc = 0.f;
            if (n > 0) { ka = bf2f(PROJ[(t0 - 3) * NPROJ + chk]); kb = bf2f(PROJ[(t0 - 2) * NPROJ + chk]); kc = bf2f(PROJ[(t0 - 1) * NPROJ + chk]); }
            unsigned short kr[64];
#pragma unroll
            for (int c = 0; c < 64; ++c) kr[c] = PROJ[(t0 + c) * NPROJ + chk];
            asm volatile("" ::: "memory");
#pragma unroll
            for (int c4 = 0; c4 < 16; ++c4) {
                const f32x4 wf4 = *(const LAS f32x4*)(wfv + 4 * c4), kd4 = *(const LAS f32x4*)(kdf + 4 * c4);
                float kt[4];
#pragma unroll
                for (int i = 0; i < 4; ++i) { const int c = 4 * c4 + i; const float kd_ = bf2f(kr[c]);
                    float ak = k0 * ka + k1 * kb + k2 * kc + k3 * kd_; ak = ak * sigmoidf_(ak); ka = kb; kb = kc; kc = kd_;
                    xw[c] = ak * wf4[i]; kt[i] = ak * kd4[i]; }
                u32x2 w2; w2.x = pk2(kt[0], kt[1]); w2.y = pk2(kt[2], kt[3]);
                *(LAS u32x2*)(T + lane * 72 + 4 * c4) = w2;
            }
        }
        LDS_WAIT(); asm volatile("" ::: "memory");
        RELANE();
#pragma unroll
        for (int dt = 0; dt < 4; ++dt)
#pragma unroll
            for (int ks = 0; ks < 2; ++ks) {
                const u32x2 lo = *(const LAS u32x2*)(T + (16 * dt + m) * 72 + 32 * ks + 4 * g), hi = *(const LAS u32x2*)(T + (16 * dt + m) * 72 + 32 * ks + 16 + 4 * g);
                u32x4 ow; ow.x = lo.x; ow.y = lo.y; ow.z = hi.x; ow.w = hi.y;
                *(u32x4*)(ub + GU_KD + ((dt * 2 + ks) * 64 + lane) * 8) = ow;
            }
        LDS_WAIT(); asm volatile("" ::: "memory");
        RELANE();
#pragma unroll
        for (int ct = 0; ct < 4; ++ct) { int one_ = 1; asm volatile("" : "+s"(one_)); if (one_) {
            const f32x4 gcc = *(const LAS f32x4*)(gcv + 16 * ct + 4 * g), bkc = *(const LAS f32x4*)(bkv + 16 * ct + 4 * g);
#pragma unroll
            for (int st = 0; st <= ct; ++st) {
                f32x4 acc = (f32x4){0.f, 0.f, 0.f, 0.f};
                acc = MFMA16(FK[ct][0], FK[st][0], acc); acc = MFMA16(FK[ct][1], FK[st][1], acc);
                const float gcs = gcv[16 * st + m], rks = rkv[16 * st + m];
#pragma unroll
                for (int r = 0; r < 4; ++r) { const int cI = 16 * ct + 4 * g + r, sI = 16 * st + m; Lm[cI * 64 + sI] = (sI < cI) ? acc[r] * bkc[r] * rks * __expf(gcc[r] - gcs) : 0.f; }
            }
        } }
        LDS_WAIT(); asm volatile("" ::: "memory");
        __builtin_amdgcn_sched_barrier(0);
        solve64(xw, Lm);
        __builtin_amdgcn_sched_barrier(0);
        {
            RELANE();
            const int l5 = lane & 31, gp = (l5 >> 2) & 3, jj = ((l5 >> 4) << 2) | (l5 & 3);
            bf16* wp = ub + GU_W + (lane >> 5) * 512 + gp * 128 + jj;
#pragma unroll
            for (int c = 0; c < 64; ++c) wp[(c >> 4) * 1024 + (c & 15) * 8] = (bf16)f2bf(xw[c]);
        }
        __builtin_amdgcn_sched_barrier(0);
        RELANE();
        float xu[64];
        {
            const int chv = 512 + h * 64 + lane;
            const float v0 = cw[chv], v1 = cw[768 + chv], v2 = cw[1536 + chv], v3 = cw[2304 + chv];
            float va = 0.f, vb = 0.f, vc = 0.f;
            if (n > 0) { va = bf2f(PROJ[(t0 - 3) * NPROJ + chv]); vb = bf2f(PROJ[(t0 - 2) * NPROJ + chv]); vc = bf2f(PROJ[(t0 - 1) * NPROJ + chv]); }
            unsigned short vr[64];
#pragma unroll
            for (int c = 0; c < 64; ++c) vr[c] = PROJ[(t0 + c) * NPROJ + chv];
            asm volatile("" ::: "memory");
#pragma unroll
            for (int c4 = 0; c4 < 16; ++c4) {
                const f32x4 bt4 = *(const LAS f32x4*)(btv + 4 * c4);
#pragma unroll
                for (int i = 0; i < 4; ++i) { const int c = 4 * c4 + i; const float vd_ = bf2f(vr[c]);
                    float av = v0 * va + v1 * vb + v2 * vc + v3 * vd_; av = av * sigmoidf_(av); va = vb; vb = vc; vc = vd_;
                    xu[c] = av * bt4[i]; }
            }
        }
        __builtin_amdgcn_sched_barrier(0);
        solve64(xu, Lm);
        __builtin_amdgcn_sched_barrier(0);
        LDS_WAIT(); asm volatile("" ::: "memory");
        RELANE();
        {
            const int sl = lane >> 4, e = lane & 15;
#pragma unroll
            for (int mt = 0; mt < 4; ++mt)
#pragma unroll
                for (int gp = 0; gp < 4; ++gp) { const int c = 16 * mt + 4 * gp; u32x2 w2; w2.x = pk2(xu[c], xu[c + 1]); w2.y = pk2(xu[c + 2], xu[c + 3]);
                    *(u32x2*)(ub + GU_U + ((sl * 4 + mt) * 64 + gp * 16 + e) * 4) = w2; }
        }
        if (lane == 0) GL[unit] = __expf(gl);
        LDS_WAIT(); asm volatile("" ::: "memory");
    }
#undef RELANE
}
__device__ __forceinline__ void gdn_scan(const Frame& F_in, int task) {
    const Frame F = relaunder(F_in);
    unsigned char* const L_ws = WSP; bf16* const PROJ = (bf16*)(L_ws + WS_BIG); const float* const GL = (const float*)(L_ws + WS_MISC) + 2048;
    const int bh = task >> 2, sl = task & 3;
    const int b = bh >> 2, h = bh & 3, unit0 = b * 256 + h * 64;
    f32x4 St[4];
#pragma unroll
    for (int i = 0; i < 4; ++i) St[i] = (f32x4){0.f, 0.f, 0.f, 0.f};
    bf16x8 W[8], QD[8], KD[8], QK[6]; u32x2 U[4], UN[4]; float gl; int vz = 0; asm volatile("" : "+v"(vz)); unsigned pA = 0, pB = 0;
    {
        const bf16* u0 = gdn_ubuf(L_ws, unit0) + F.lane * 8;
#pragma unroll
        for (int f = 0; f < 8; ++f) { W[f] = *(const bf16x8*)(u0 + GU_W + f * 512); QD[f] = *(const bf16x8*)(u0 + GU_QD + f * 512); KD[f] = *(const bf16x8*)(u0 + GU_KD + f * 512); }
#pragma unroll
        for (int f = 0; f < 6; ++f) QK[f] = *(const bf16x8*)(u0 + GU_QK + f * 512);
#pragma unroll
        for (int mt = 0; mt < 4; ++mt) U[mt] = *(const u32x2*)(u0 - F.lane * 8 + GU_U + ((sl * 4 + mt) * 64 + F.lane) * 4);
        gl = GL[unit0 + vz];
    }
#pragma unroll 1
    for (int n = 0; n < 64; ++n) {
        const int nn = n < 63 ? n + 1 : 63;
        int ln_ = F.lane; asm volatile("" : "+v"(ln_)); const int g = ln_ >> 4, e = ln_ & 15;
        const bf16* un = gdn_ubuf(L_ws, unit0 + nn) + ln_ * 8;
        const float cgl = gl; gl = GL[unit0 + nn + vz];
        const bf16x8 SB0 = pack_tiles(St[0], St[1]), SB1 = pack_tiles(St[2], St[3]);
        const size_t t0 = (size_t)b * SEQ + (size_t)n * 64;
        f32x4 vn[4];
#pragma unroll
        for (int tt = 0; tt < 4; ++tt) {
            f32x4 ws_ = (f32x4){0.f, 0.f, 0.f, 0.f};
            ws_ = MFMA16(W[tt * 2], SB0, ws_); ws_ = MFMA16(W[tt * 2 + 1], SB1, ws_);
            W[tt * 2] = *(const bf16x8*)(un + GU_W + (tt * 2) * 512); W[tt * 2 + 1] = *(const bf16x8*)(un + GU_W + (tt * 2 + 1) * 512);
            vn[tt] = (f32x4){lo_bf(U[tt].x), hi_bf(U[tt].x), lo_bf(U[tt].y), hi_bf(U[tt].y)} - ws_;
            U[tt] = *(const u32x2*)(un - ln_ * 8 + GU_U + ((sl * 4 + tt) * 64 + ln_) * 4);
        }
        const bf16x8 VB0 = pack_tiles(vn[0], vn[1]), VB1 = pack_tiles(vn[2], vn[3]);
#pragma unroll
        for (int tt = 0; tt < 4; ++tt) {
            f32x4 o = (f32x4){0.f, 0.f, 0.f, 0.f};
            o = MFMA16(QD[tt * 2], SB0, o); o = MFMA16(QD[tt * 2 + 1], SB1, o);
            QD[tt * 2] = *(const bf16x8*)(un + GU_QD + (tt * 2) * 512); QD[tt * 2 + 1] = *(const bf16x8*)(un + GU_QD + (tt * 2 + 1) * 512);
            o = MFMA16(QK[qk_idx(tt, 0)], VB0, o); QK[qk_idx(tt, 0)] = *(const bf16x8*)(un + GU_QK + qk_idx(tt, 0) * 512);
            if (tt >= 2) { o = MFMA16(QK[qk_idx(tt, 1)], VB1, o); QK[qk_idx(tt, 1)] = *(const bf16x8*)(un + GU_QK + qk_idx(tt, 1) * 512); }
#pragma unroll
            for (int r = 0; r < 4; ++r) PROJ[(t0 + 16 * tt + 4 * g + r) * NPROJ + 512 + h * 64 + 16 * sl + e] = (bf16)f2bf(o[r]);
        }
#pragma unroll
        for (int dt = 0; dt < 4; ++dt) { f32x4 c = St[dt] * cgl; c = MFMA16(KD[dt * 2], VB0, c); c = MFMA16(KD[dt * 2 + 1], VB1, c); St[dt] = c;
            KD[dt * 2] = *(const bf16x8*)(un + GU_KD + (dt * 2) * 512); KD[dt * 2 + 1] = *(const bf16x8*)(un + GU_KD + (dt * 2 + 1) * 512); }
    }
}

__device__ __forceinline__ void mlstm_prep(const Frame& F_in, int l) {
    const Frame F = relaunder(F_in);
    unsigned char* const L_ws = WSP; const float* const L_i_bias = IN_F(8); const float* const L_f_bias = IN_F(9);
    const bf16* const PROJ = (const bf16*)(L_ws + WS_BIG); const float* const GATES = (const float*)(L_ws + WS_GATES); float* const FL = (float*)(L_ws + WS_MISC);
    LAS float* bvec = (LAS float*)(F.lds + F.wave * WAVE_LDS); LAS float* avec = bvec + 64;
    const int g = F.lane >> 4, m = F.lane & 15;
    for (int unit = F.gw; unit < 2048; unit += F.ngw) {
        const int h = (unit >> 6) & 3; const size_t t0 = (size_t)(unit >> 8) * SEQ + (size_t)(unit & 63) * 64;
        bf16* const ub = (bf16*)(L_ws + WS_MLB) + (size_t)unit * MU_STRIDE;
        float bl;
        {
            const float* gr = GATES + (t0 + F.lane) * 16;
            const float iv = 15.0f * tanhf((gr[8 + h] + L_i_bias[l * 4 + h]) * (1.0f / 15.0f));
            const float c = 15.0f * tanhf((gr[12 + h] + L_f_bias[l * 4 + h]) * (1.0f / 15.0f));
            float bs = -softplusf_(-c);
#pragma unroll
            for (int o = 1; o < 64; o <<= 1) { const float t = xshfl(bs, F.lane >= o ? F.lane - o : F.lane); if (F.lane >= o) bs += t; }
            bl = __int_as_float(__builtin_amdgcn_readlane(__float_as_int(bs), 63));
            bvec[F.lane] = bs; avec[F.lane] = iv - bs;
        }
        LDS_WAIT(); asm volatile("" ::: "memory");
        const bf16* qrow = PROJ + (t0 + m) * NPROJ + 1024 + h * 64;
        bf16x8 FQ[4][2], FK[4][2];
#pragma unroll
        for (int mt = 0; mt < 4; ++mt)
#pragma unroll
            for (int ks = 0; ks < 2; ++ks) { FQ[mt][ks] = *(const bf16x8*)(qrow + (size_t)(16 * mt) * NPROJ + 32 * ks + 8 * g); FK[mt][ks] = *(const bf16x8*)(qrow + (size_t)(16 * mt) * NPROJ + 256 + 32 * ks + 8 * g); }
#pragma unroll
        for (int tt = 0; tt < 4; ++tt) {
            const float bt = bvec[16 * tt + m];
#pragma unroll
            for (int ks = 0; ks < 2; ++ks) {
                u32x4 ow = (u32x4){0u, 0u, 0u, 0u};
#pragma unroll
                for (int hf = 0; hf < 2; ++hf) { const int st = 2 * ks + hf;
                    if (st <= tt) {
                        f32x4 acc = (f32x4){0.f, 0.f, 0.f, 0.f};
                        acc = MFMA16(FK[st][0], FQ[tt][0], acc); acc = MFMA16(FK[st][1], FQ[tt][1], acc);
                        const f32x4 av = *(const LAS f32x4*)(avec + 16 * st + 4 * g);
                        float v[4];
#pragma unroll
                        for (int r = 0; r < 4; ++r) { const int sI = 16 * st + 4 * g + r, tI = 16 * tt + m; v[r] = (sI <= tI) ? acc[r] * 0.125f * __expf(bt + av[r]) : 0.f; }
                        ow[2 * hf] = pk2(v[0], v[1]); ow[2 * hf + 1] = pk2(v[2], v[3]);
                    } }
                *(u32x4*)(ub + MU_PT + ((tt * 2 + ks) * 64 + F.lane) * 8) = ow;
            }
        }
#pragma unroll
        for (int mt = 0; mt < 4; ++mt) {
            const float f = __expf(bvec[16 * mt + m]);
#pragma unroll
            for (int ks = 0; ks < 2; ++ks) {
                const u32x2 lo = *(const u32x2*)(qrow + (size_t)(16 * mt) * NPROJ + 32 * ks + 4 * g), hi = *(const u32x2*)(qrow + (size_t)(16 * mt) * NPROJ + 32 * ks + 16 + 4 * g);
                u32x4 ow; ow.x = pk2(lo_bf(lo.x) * f, hi_bf(lo.x) * f); ow.y = pk2(lo_bf(lo.y) * f, hi_bf(lo.y) * f); ow.z = pk2(lo_bf(hi.x) * f, hi_bf(hi.x) * f); ow.w = pk2(lo_bf(hi.y) * f, hi_bf(hi.y) * f);
                *(u32x4*)(ub + MU_QB + ((mt * 2 + ks) * 64 + F.lane) * 8) = ow;
            }
        }
#pragma unroll
        for (int ks = 0; ks < 2; ++ks) {
            const f32x4 a0 = *(const LAS f32x4*)(avec + 32 * ks + 4 * g), a1 = *(const LAS f32x4*)(avec + 32 * ks + 16 + 4 * g);
            float fac[8];
#pragma unroll
            for (int j = 0; j < 4; ++j) { fac[j] = 0.125f * __expf(bl + a0[j]); fac[4 + j] = 0.125f * __expf(bl + a1[j]); }
            const bf16* kcol = PROJ + (t0 + 32 * ks + 4 * g) * NPROJ + 1280 + h * 64 + m;
#pragma unroll
            for (int dt = 0; dt < 4; ++dt) {
                float kv[8];
#pragma unroll
                for (int j = 0; j < 8; ++j) kv[j] = bf2f(kcol[(size_t)(16 * (j >> 2) + (j & 3)) * NPROJ + 16 * dt]) * fac[j];
                u32x4 ow; ow.x = pk2(kv[0], kv[1]); ow.y = pk2(kv[2], kv[3]); ow.z = pk2(kv[4], kv[5]); ow.w = pk2(kv[6], kv[7]);
                *(u32x4*)(ub + MU_KW + ((dt * 2 + ks) * 64 + F.lane) * 8) = ow;
            }
#pragma unroll
            for (int sl = 0; sl < 4; ++sl) {
                unsigned short vv[8];
#pragma unroll
                for (int j = 0; j < 8; ++j) vv[j] = kcol[(size_t)(16 * (j >> 2) + (j & 3)) * NPROJ + 256 + 16 * sl];
                u32x4 ow; ow.x = vv[0] | ((unsigned)vv[1] << 16); ow.y = vv[2] | ((unsigned)vv[3] << 16); ow.z = vv[4] | ((unsigned)vv[5] << 16); ow.w = vv[6] | ((unsigned)vv[7] << 16);
                *(u32x4*)(ub + MU_VB + ((sl * 2 + ks) * 64 + F.lane) * 8) = ow;
            }
        }
        if (F.lane == 0) FL[unit] = __expf(bl);
        LDS_WAIT(); asm volatile("" ::: "memory");
    }
}
__device__ __forceinline__ void mlstm_scan(const Frame& F_in, int task) {
    const Frame F = relaunder(F_in);
    unsigned char* const L_ws = WSP; bf16* const PROJ = (bf16*)(L_ws + WS_BIG); float* const GATES = (float*)(L_ws + WS_GATES); const float* const FL = (const float*)(L_ws + WS_MISC);
    const int bh = task / 5, sl = task % 5;
    const int b = bh >> 2, h = bh & 3;
    const bf16* ub0 = (const bf16*)(L_ws + WS_MLB) + (size_t)(b * 256 + h * 64) * MU_STRIDE; const bf16* ub = ub0 + F.lane * 8;
    const u32x4 ones = (u32x4){0x3f803f80u, 0x3f803f80u, 0x3f803f80u, 0x3f803f80u};
    f32x4 Ct[4];
#pragma unroll
    for (int i = 0; i < 4; ++i) Ct[i] = (f32x4){0.f, 0.f, 0.f, 0.f};
    bf16x8 QB[8], PT[8], KW[8], VB[2], VN[2]; float fl; unsigned pA = 0, pB = 0, pC = 0, pD = 0;
#define ML_VB(dst, n_) do { const bf16* u_ = ub + (size_t)(n_) * MU_STRIDE; if (sl < 4) { dst[0] = *(const bf16x8*)(u_ + MU_VB + (sl * 2) * 512); dst[1] = *(const bf16x8*)(u_ + MU_VB + (sl * 2 + 1) * 512); } else { dst[0] = __builtin_bit_cast(bf16x8, ones); dst[1] = dst[0]; } } while (0)
#pragma unroll
    for (int f = 0; f < 8; ++f) { QB[f] = *(const bf16x8*)(ub + MU_QB + f * 512); PT[f] = *(const bf16x8*)(ub + MU_PT + f * 512); KW[f] = *(const bf16x8*)(ub + MU_KW + f * 512); }
    int vz = 0; asm volatile("" : "+v"(vz)); ML_VB(VB, 0); fl = FL[b * 256 + h * 64 + vz];
#pragma unroll 1
    for (int n = 0; n < 64; ++n) {
        const int nn = n < 63 ? n + 1 : 63;
        int ln_ = F.lane; asm volatile("" : "+v"(ln_)); const int g = ln_ >> 4, e = ln_ & 15;
        const bf16* un = ub0 + ln_ * 8 + (size_t)nn * MU_STRIDE;
        const float cfl = fl; fl = FL[b * 256 + h * 64 + nn + vz];
        ML_VB(VN, nn);
        const bf16x8 CB0 = pack_tiles(Ct[0], Ct[1]), CB1 = pack_tiles(Ct[2], Ct[3]);
        const size_t t0 = (size_t)b * SEQ + (size_t)n * 64;
#pragma unroll
        for (int tt = 0; tt < 4; ++tt) {
            f32x4 o = (f32x4){0.f, 0.f, 0.f, 0.f};
            o = MFMA16(QB[tt * 2], CB0, o); o = MFMA16(QB[tt * 2 + 1], CB1, o); o = MFMA16(PT[tt * 2], VB[0], o); o = MFMA16(PT[tt * 2 + 1], VB[1], o);
            QB[tt * 2] = *(const bf16x8*)(un + MU_QB + (tt * 2) * 512); QB[tt * 2 + 1] = *(const bf16x8*)(un + MU_QB + (tt * 2 + 1) * 512);
            PT[tt * 2] = *(const bf16x8*)(un + MU_PT + (tt * 2) * 512); PT[tt * 2 + 1] = *(const bf16x8*)(un + MU_PT + (tt * 2 + 1) * 512);
            if (sl < 4) {
#pragma unroll
                for (int r = 0; r < 4; ++r) PROJ[(t0 + 16 * tt + 4 * g + r) * NPROJ + 1536 + h * 64 + 16 * sl + e] = (bf16)f2bf(o[r]);
            } else if (e == 0) {
#pragma unroll
                for (int r = 0; r < 4; ++r) GATES[(t0 + 16 * tt + 4 * g + r) * 16 + 8 + h] = o[r];
            }
        }
#pragma unroll
        for (int dt = 0; dt < 4; ++dt) { f32x4 c = Ct[dt] * cfl; c = MFMA16(KW[dt * 2], VB[0], c); c = MFMA16(KW[dt * 2 + 1], VB[1], c); Ct[dt] = c;
            KW[dt * 2] = *(const bf16x8*)(un + MU_KW + (dt * 2) * 512); KW[dt * 2 + 1] = *(const bf16x8*)(un + MU_KW + (dt * 2 + 1) * 512); }
        VB[0] = VN[0]; VB[1] = VN[1];
    }
#undef ML_VB
}

__device__ __forceinline__ float sum16(float v) {
    v += __int_as_float(__builtin_amdgcn_update_dpp(0, __float_as_int(v), 0xB1, 0xF, 0xF, true));
    v += __int_as_float(__builtin_amdgcn_update_dpp(0, __float_as_int(v), 0x4E, 0xF, 0xF, true));
    v += __int_as_float(__builtin_amdgcn_update_dpp(0, __float_as_int(v), 0x141, 0xF, 0xF, true));
    v += __int_as_float(__builtin_amdgcn_update_dpp(0, __float_as_int(v), 0x140, 0xF, 0xF, true));
    return v;
}
__device__ __forceinline__ void m2_post(const Frame& F_in, int l) {
    const Frame F = relaunder(F_in);
    unsigned char* const L_ws = WSP;
    {
        const f32x4* ps = (const f32x4*)(IN_F(1) + (size_t)l * M * PLE); u32x2* pb = (u32x2*)(L_ws + WS_PB);
        const int stride = F.ngw * 64;
        for (int i = F.gw * 64 + F.lane; i < M * PLE / 4; i += 4 * stride) {
            f32x4 v[4];
#pragma unroll
            for (int u = 0; u < 4; ++u) v[u] = ps[i + u * stride];
#pragma unroll
            for (int u = 0; u < 4; ++u) { u32x2 w; w.x = pk2(v[u][0], v[u][1]); w.y = pk2(v[u][2], v[u][3]); pb[i + u * stride] = w; }
        }
    }
    const bf16* const PROJ = (const bf16*)(L_ws + WS_BIG); bf16* const Y = (bf16*)(L_ws + WS_BIG + 176 * MiB); const float* const GATES = (const float*)(L_ws + WS_GATES);
    const f32x4 gn = *(const f32x4*)(IN_F(7) + l * 64 + ((4 * F.lane) & 63)), mn = *(const f32x4*)(IN_F(10) + l * 256 + 4 * F.lane);
    for (int t = F.gw * 4; t < M; t += F.ngw * 4) {
        u32x2 og[4], zg[4], om[4], pm[4]; float dn[4];
#pragma unroll
        for (int u = 0; u < 4; ++u) { const bf16* row = PROJ + (size_t)(t + u) * NPROJ + 4 * F.lane;
            og[u] = *(const u32x2*)(row + 512); zg[u] = *(const u32x2*)(row + 768); om[u] = *(const u32x2*)(row + 1536); pm[u] = *(const u32x2*)(row + 1792);
            dn[u] = GATES[(size_t)(t + u) * 16 + 8 + (F.lane >> 4)]; }
#pragma unroll
        for (int u = 0; u < 4; ++u) {
            float o[4] = {lo_bf(og[u].x), hi_bf(og[u].x), lo_bf(og[u].y), hi_bf(og[u].y)}, z[4] = {lo_bf(zg[u].x), hi_bf(zg[u].x), lo_bf(zg[u].y), hi_bf(zg[u].y)};
            float rs = 1.0f / sqrtf(sum16((o[0] * o[0] + o[1] * o[1]) + (o[2] * o[2] + o[3] * o[3])) * (1.0f / 64.0f) + EPS);
            float y[4];
#pragma unroll
            for (int i = 0; i < 4; ++i) y[i] = o[i] * rs * gn[i] * (z[i] * sigmoidf_(z[i]));
            u32x2 w; w.x = pk2(y[0], y[1]); w.y = pk2(y[2], y[3]);
            *(u32x2*)(Y + (size_t)(t + u) * DM + 4 * F.lane) = w;
            const float inv = 1.0f / fmaxf(fabsf(dn[u]), 1.0f);
            float hm[4] = {lo_bf(om[u].x) * inv, hi_bf(om[u].x) * inv, lo_bf(om[u].y) * inv, hi_bf(om[u].y) * inv}, p[4] = {lo_bf(pm[u].x), hi_bf(pm[u].x), lo_bf(pm[u].y), hi_bf(pm[u].y)};
            rs = 1.0f / sqrtf(sum16((hm[0] * hm[0] + hm[1] * hm[1]) + (hm[2] * hm[2] + hm[3] * hm[3])) * (1.0f / 64.0f) + EPS);
#pragma unroll
            for (int i = 0; i < 4; ++i) y[i] = hm[i] * rs * mn[i] * sigmoidf_(p[i]);
            w.x = pk2(y[0], y[1]); w.y = pk2(y[2], y[3]);
            *(u32x2*)(Y + (size_t)(t + u) * DM + 256 + 4 * F.lane) = w;
        }
    }
}

__device__ __forceinline__ int crow(int reg, int h) { return (reg & 3) + 8 * (reg >> 2) + 4 * h; }
__device__ __forceinline__ void swa_phase(const Frame& F_in, int l, int blk0) {
    const Frame F = relaunder(F_in);
    unsigned char* const L_ws = WSP; const float* const L_sinks = IN_F(11); const bf16* const L_PROJ = (const bf16*)(L_ws + WS_BIG); bf16* const L_Y = (bf16*)(L_ws + WS_BIG + 176 * MiB); const float* const L_ROPE = (const float*)(L_ws + WS_ROPE);
    LAS bf16* Ks = (LAS bf16*)F.lds;
    LAS bf16* Vt = (LAS bf16*)(F.lds + 36864);
    const float* COS = L_ROPE; const float* SIN = L_ROPE + (size_t)M * 8;
    const int r = F.lane & 31, h = F.lane >> 5;
    for (int unit = (int)blockIdx.x - blk0; unit < 512; unit += F.G - blk0) {
        const int b = unit >> 6, kvh = (unit >> 5) & 1, nb = unit & 31;
        const int tok0 = b * SEQ + nb * 128;
        __syncthreads();
        {
            const int key = F.tid >> 1, half = F.tid & 1; const int tok = tok0 - 128 + key; const bool valid = (nb > 0) || (key >= 128);
            u32x4 kq[4], vq[4];
#pragma unroll
            for (int i = 0; i < 4; ++i) { kq[i] = (u32x4){0u, 0u, 0u, 0u}; vq[i] = (u32x4){0u, 0u, 0u, 0u}; }
            if (valid) {
                const bf16* ksrc = L_PROJ + (size_t)tok * NPROJ + 2560 + kvh * 64 + half * 32;
                const bf16* vsrc = L_PROJ + (size_t)tok * NPROJ + 2688 + kvh * 64 + half * 32;
#pragma unroll
                for (int i = 0; i < 4; ++i) { kq[i] = *(const u32x4*)(ksrc + 8 * i); vq[i] = *(const u32x4*)(vsrc + 8 * i); }
                if (half == 0) {
                    const f32x4 c0 = *(const f32x4*)(COS + (size_t)tok * 8), c1 = *(const f32x4*)(COS + (size_t)tok * 8 + 4);
                    const f32x4 s0 = *(const f32x4*)(SIN + (size_t)tok * 8), s1 = *(const f32x4*)(SIN + (size_t)tok * 8 + 4);
                    float x1[8], x2[8], cs[8], sn[8];
#pragma unroll
                    for (int i = 0; i < 4; ++i) { x1[2 * i] = lo_bf(kq[0][i]); x1[2 * i + 1] = hi_bf(kq[0][i]); x2[2 * i] = lo_bf(kq[1][i]); x2[2 * i + 1] = hi_bf(kq[1][i]); cs[i] = c0[i]; cs[4 + i] = c1[i]; sn[i] = s0[i]; sn[4 + i] = s1[i]; }
#pragma unroll
                    for (int i = 0; i < 4; ++i) {
                        kq[0][i] = pk2(x1[2 * i] * cs[2 * i] - x2[2 * i] * sn[2 * i], x1[2 * i + 1] * cs[2 * i + 1] - x2[2 * i + 1] * sn[2 * i + 1]);
                        kq[1][i] = pk2(x2[2 * i] * cs[2 * i] + x1[2 * i] * sn[2 * i], x2[2 * i + 1] * cs[2 * i + 1] + x1[2 * i + 1] * sn[2 * i + 1]); }
                }
            }
#pragma unroll
            for (int i = 0; i < 4; ++i) *(LAS u32x4*)(Ks + key * 72 + half * 32 + 8 * i) = kq[i];
#pragma unroll
            for (int i = 0; i < 4; ++i)
#pragma unroll
                for (int e = 0; e < 4; ++e) { const int d = half * 32 + 8 * i + 2 * e; Vt[d * 264 + key] = (bf16)(vq[i][e] & 0xffffu); Vt[(d + 1) * 264 + key] = (bf16)(vq[i][e] >> 16); }
        }
        __syncthreads();
        const int g = F.wave >> 1, qhalf = F.wave & 1, qh = kvh * 4 + g;
        const float sink = L_sinks[l * 8 + qh];
#pragma unroll 1
        for (int sub = 0; sub < 2; ++sub) {
            const int q0 = qhalf * 64 + sub * 32;
            const int qtok = tok0 + q0 + r;
            bf16x8 qf[4];
            {
                const bf16* qsrc = L_PROJ + (size_t)qtok * NPROJ + 2048 + qh * 64 + 8 * h;
                u32x4 qw[4];
#pragma unroll
                for (int ks = 0; ks < 4; ++ks) qw[ks] = *(const u32x4*)(qsrc + 16 * ks);
                const f32x4 c0 = *(const f32x4*)(COS + (size_t)qtok * 8), c1 = *(const f32x4*)(COS + (size_t)qtok * 8 + 4);
                const f32x4 s0 = *(const f32x4*)(SIN + (size_t)qtok * 8), s1 = *(const f32x4*)(SIN + (size_t)qtok * 8 + 4);
                float cs[8], sn[8];
#pragma unroll
                for (int i = 0; i < 4; ++i) { cs[i] = c0[i]; cs[4 + i] = c1[i]; sn[i] = s0[i]; sn[4 + i] = s1[i]; }
                u32x4 ow;
#pragma unroll
                for (int i = 0; i < 4; ++i) ow[i] = xshflu(qw[0][i], F.lane ^ 32);
                const float sg = h ? 1.0f : -1.0f;
#pragma unroll
                for (int i = 0; i < 4; ++i) {
                    const float a0 = lo_bf(qw[0][i]), a1 = hi_bf(qw[0][i]), b0 = lo_bf(ow[i]), b1 = hi_bf(ow[i]);
                    qw[0][i] = pk2((a0 * cs[2 * i] + sg * b0 * sn[2 * i]) * 0.125f, (a1 * cs[2 * i + 1] + sg * b1 * sn[2 * i + 1]) * 0.125f); }
#pragma unroll
                for (int ks = 1; ks < 4; ++ks)
#pragma unroll
                    for (int i = 0; i < 4; ++i) qw[ks][i] = pk2(lo_bf(qw[ks][i]) * 0.125f, hi_bf(qw[ks][i]) * 0.125f);
#pragma unroll
                for (int ks = 0; ks < 4; ++ks) qf[ks] = __builtin_bit_cast(bf16x8, qw[ks]);
            }
            f32x16 sc[5];
#pragma unroll
            for (int kb = 0; kb < 5; ++kb) {
                f32x16 a;
#pragma unroll
                for (int i = 0; i < 16; ++i) a[i] = 0.f;
#pragma unroll
                for (int ks = 0; ks < 4; ++ks) { const bf16x8 kf = *(const LAS bf16x8*)(Ks + (q0 + 32 * kb + r) * 72 + 16 * ks + 8 * h); a = __builtin_amdgcn_mfma_f32_32x32x16_bf16(kf, qf[ks], a, 0, 0, 0); }
                sc[kb] = a;
            }
            float mx = sink;
#pragma unroll
            for (int kb = 0; kb < 5; ++kb)
#pragma unroll
                for (int i = 0; i < 16; ++i) { const int kr = 32 * kb + crow(i, h); const bool ok = (kr > r) && (kr <= r + 128) && ((nb > 0) || (q0 + kr >= 128));
                    const float s = ok ? sc[kb][i] : -INFINITY; sc[kb][i] = s; mx = fmaxf(mx, s); }
            mx = fmaxf(mx, xshfl(mx, F.lane ^ 32));
            float ls = 0.f;
#pragma unroll
            for (int kb = 0; kb < 5; ++kb)
#pragma unroll
                for (int i = 0; i < 16; ++i) { const float p = __expf(sc[kb][i] - mx); sc[kb][i] = p; ls += p; }
            ls += xshfl(ls, F.lane ^ 32);
            ls += __expf(sink - mx);
            const float inv = 1.0f / ls;
            f32x16 o[2];
#pragma unroll
            for (int db = 0; db < 2; ++db) {
                f32x16 a;
#pragma unroll
                for (int i = 0; i < 16; ++i) a[i] = 0.f;
#pragma unroll
                for (int kb = 0; kb < 5; ++kb)
#pragma unroll
                    for (int s = 0; s < 2; ++s) {
                        u32x4 pw;
#pragma unroll
                        for (int i = 0; i < 4; ++i) pw[i] = pk2(sc[kb][8 * s + 2 * i], sc[kb][8 * s + 2 * i + 1]);
                        const LAS bf16* vb = Vt + (db * 32 + r) * 264 + q0 + 32 * kb + 16 * s + 4 * h;
                        const s16x4 lo = *(const LAS s16x4*)vb, hi = *(const LAS s16x4*)(vb + 8);
                        const bf16x8 vf = __builtin_shufflevector(lo, hi, 0, 1, 2, 3, 4, 5, 6, 7);
                        a = __builtin_amdgcn_mfma_f32_32x32x16_bf16(vf, __builtin_bit_cast(bf16x8, pw), a, 0, 0, 0);
                    }
                o[db] = a;
            }
            bf16* yp = L_Y + (size_t)qtok * DM + 512 + qh * 64;
#pragma unroll
            for (int db = 0; db < 2; ++db)
#pragma unroll
                for (int gg = 0; gg < 4; ++gg) { u32x2 w; w.x = pk2(o[db][4 * gg] * inv, o[db][4 * gg + 1] * inv); w.y = pk2(o[db][4 * gg + 2] * inv, o[db][4 * gg + 3] * inv);
                    *(u32x2*)(yp + db * 32 + 8 * gg + 4 * h) = w; }
        }
    }
    __syncthreads();
}

__device__ __forceinline__ void final_norm(const Frame& F_in) {
    const Frame F = relaunder(F_in);
    float* const L_out = OUTP; const float* const L_norm_final = IN_F(20);
    for (int m = F.gw; m < M; m += F.ngw) {
        f32x4* xr = (f32x4*)(L_out + (size_t)m * DM) + F.lane; const f32x4* gr = (const f32x4*)L_norm_final + F.lane;
        f32x4 v[4]; float s = 0.f;
#pragma unroll
        for (int j = 0; j < 4; ++j) { v[j] = xr[64 * j]; s += (v[j][0] * v[j][0] + v[j][1] * v[j][1]) + (v[j][2] * v[j][2] + v[j][3] * v[j][3]); }
        const float rs = 1.0f / sqrtf(wave_sum(s, F.lane) * (1.0f / DM) + EPS);
#pragma unroll
        for (int j = 0; j < 4; ++j) xr[64 * j] = v[j] * rs * gr[64 * j];
    }
}

#define RLX_AGENT __ATOMIC_RELAXED, __HIP_MEMORY_SCOPE_AGENT
#define XB_TMO      128
#define XB_XCNT(j)  (256  + 64 * (j))
#define XB_XSUB(j)  (1280 + 64 * (j))
#define XB_XGEN(j)  (2304 + 64 * (j))
#define XB_TOP      3328
#define XB_TOPGEN   3392
#define XCD_BAR_WORDS 3456
#define XB_SPIN_CAP (1u << 18)

__device__ __forceinline__ unsigned xb_ld(unsigned* p)              { return __hip_atomic_load(p, __ATOMIC_RELAXED, __HIP_MEMORY_SCOPE_AGENT); }
__device__ __forceinline__ unsigned xb_add(unsigned* p, unsigned v) { return __hip_atomic_fetch_add(p, v, __ATOMIC_RELAXED, __HIP_MEMORY_SCOPE_AGENT); }
__device__ __forceinline__ unsigned xb_xcc_id() { return (unsigned)__builtin_amdgcn_s_getreg((3 << 11) | 20) & 0xFu; }
#define XB_SPIN(cond, bar) do { unsigned _sp = 0; while (cond) { __builtin_amdgcn_s_sleep(1); \
    if ((++_sp & 255u) == 0u) { if (xb_ld(&(bar)[XB_TMO])) break; if (_sp > XB_SPIN_CAP) { atomicAdd(&(bar)[XB_TMO], 1u); break; } } } } while (0)

struct XcdBarrier {
    unsigned* bar; unsigned x;
    volatile LAS unsigned* st;
};

__device__ __forceinline__ XcdBarrier xcd_barrier_post(unsigned* bar, volatile LAS unsigned* st, bool leader) {
    XcdBarrier b; b.bar = bar; b.x = xb_xcc_id(); b.st = st;
    if (leader) (void)xb_add(&bar[XB_XCNT(b.x)], 1u);
    return b;
}
__device__ __forceinline__ void xcd_barrier_complete(unsigned* bar, unsigned x, unsigned& nloc, unsigned& nx) {
    const unsigned G = gridDim.x * gridDim.y * gridDim.z;
    unsigned sum, cnt, mine, sp = 0u;
    for (;;) {
        sum = 0u; cnt = 0u; mine = 0u;
#pragma unroll
        for (unsigned j = 0; j < 16; ++j) { const unsigned c = xb_ld(&bar[XB_XCNT(j)]); sum += c; cnt += (c > 0u) ? 1u : 0u; mine = (j == x) ? c : mine; }
        if (sum == G) break;
        __builtin_amdgcn_s_sleep(1);
        if ((++sp & 255u) == 0u) { if (xb_ld(&bar[XB_TMO])) break; if (sp > XB_SPIN_CAP) { atomicAdd(&bar[XB_TMO], 1u); break; } }
    }
    nloc = mine > 0u ? mine : 1u; nx = cnt > 0u ? cnt : 1u;
}

__device__ __forceinline__ void xcd_barrier(const XcdBarrier& b, bool leader) {
    asm volatile("s_waitcnt vmcnt(0)" ::: "memory");
    __syncthreads();
    if (leader) {
        unsigned* bar = b.bar;
        __builtin_amdgcn_s_waitcnt(0);
        unsigned nloc = b.st[0], nx = b.st[1];
        if (nloc == 0u) { xcd_barrier_complete(bar, b.x, nloc, nx); b.st[0] = nloc; b.st[1] = nx; }
        const unsigned old = xb_add(&bar[XB_XSUB(b.x)], 1u);
        const unsigned gen = old / nloc;
        if (old + 1u == (gen + 1u) * nloc) {
            __builtin_amdgcn_fence(__ATOMIC_RELEASE, "agent");
            asm volatile("s_waitcnt vmcnt(0)" ::: "memory");
            const unsigned og = xb_add(&bar[XB_TOP], 1u);
            const unsigned tg = og / nx;
            if (og + 1u == (tg + 1u) * nx) xb_add(&bar[XB_TOPGEN], 1u);
            else XB_SPIN(xb_ld(&bar[XB_TOPGEN]) == tg, bar);
            __builtin_amdgcn_fence(__ATOMIC_ACQUIRE, "agent");
            xb_add(&bar[XB_XGEN(b.x)], 1u);
            asm volatile("s_waitcnt vmcnt(0)" ::: "memory");
        } else {
            XB_SPIN(xb_ld(&bar[XB_XGEN(b.x)]) == gen, bar);
            __builtin_amdgcn_fence(__ATOMIC_ACQUIRE, "agent");
            asm volatile("s_waitcnt vmcnt(0)" ::: "memory");
        }
    }
    __syncthreads();
}

__device__ __forceinline__ void gbar(const Frame& F_in, int) {
    XcdBarrier b; b.bar = (unsigned*)(WSP + WS_MISC + 65536); b.x = xb_xcc_id(); b.st = (volatile LAS unsigned*)(F_in.lds + LDS_BYTES);
    int w_ = F_in.wave; asm volatile("" : "+s"(w_));
    xcd_barrier(b, w_ == 0 && lane_id_asm() == 0);
}

__global__ void __launch_bounds__(NTHR, 2) hybrid_fwd(Args args) {
    extern __shared__ __attribute__((aligned(16))) unsigned char lds[];
    cg::grid_group grid = cg::this_grid();
    Frame F;
    F.lds = (LAS unsigned char*)lds;
    F.wave = __builtin_amdgcn_readfirstlane((int)threadIdx.x >> 6); F.tid = 0; F.lane = 0;
    F.G = gridDim.x; F.gw = blockIdx.x * NWAVES + F.wave; F.ngw = F.G * NWAVES;

    volatile LAS unsigned* xst = (volatile LAS unsigned*)(F.lds + LDS_BYTES);
    if (threadIdx.x < 16) xst[threadIdx.x] = 0u;
    __syncthreads();
    const int xb = 0; (void)xcd_barrier_post((unsigned*)(WSP + WS_MISC + 65536), xst, F.wave == 0 && lane_id_asm() == 0);
    convert_weights(F, 0, F.gw, F.ngw);
    p0_prologue(F);
    grid.sync();
#pragma unroll 1
    for (int l = 0; l < NL; ++l) {
#pragma unroll 1
        for (int op = 0; op < 6; ++op) {
            if (op == 1) {
                gbar(F, xb);
                gdn_prep(F, l);
                mlstm_prep(F, l);
                swa_phase(F, l, 0);
                gbar(F, xb);
                {
                    int c = (int)blockIdx.x; asm volatile("" : "+s"(c));
                    if (F.wave == 0) {
                        if (c < 128) gdn_scan(F, ((c & 7) + 8 * (c >> 5)) * 4 + ((c >> 3) & 3));
                        else { const int q = c - 128, j = q >> 3; mlstm_scan(F, ((q & 7) + 8 * (j / 5)) * 5 + (j % 5)); }
                    } else if (F.wave == 2 && c < 32) { const int q = 128 + c, j = q >> 3; mlstm_scan(F, ((q & 7) + 8 * (j / 5)) * 5 + (j % 5)); }
                    else if (F.wave >= 4 && l + 1 < NL) convert_weights(F, l + 1, c * 4 + (F.wave - 4), F.G * 4);
                }
                gbar(F, xb);
                m2_post(F, l);
            }
            if (op != 5 && (l | op) != 0) gbar(F, xb);
            unsigned char* const ws = WSP; unsigned char* const wb = ws + WS_W + (size_t)(l & 1) * W_LAYER; float* const outp = OUTP;
            float* const ssq0 = (float*)(ws + WS_SSQ); float* const ssq1 = ssq0 + (size_t)M * 16; float* const ssq2 = ssq0 + (size_t)2 * M * 16;
            bf16* const xb = (bf16*)(ws + WS_XB); unsigned char* const big = ws + WS_BIG;
            pg8::Gemm g; pg8::EpiAny E; g.M = M;
            bf16* const xalt = (bf16*)(big + 192 * MiB);
            E.ssq_in = ssq0; E.ssq_out = ssq0; E.base = outp; E.xout = outp; E.ob = xb; E.pp = (const bf16*)big; E.gates = (float*)(ws + WS_GATES);
            if (op == 0)      { g.A = l == 0 ? xb : xalt; g.Bt = (const bf16*)(wb + WO_IN); g.N = NPAD; g.K = DM; E.mode = 0; E.ssq_in = ssq0; E.ob = (bf16*)big; }
            else if (op == 1) { g.A = (const bf16*)(big + 176 * MiB); g.Bt = (const bf16*)(wb + WO_OUT); g.N = DM; g.K = DM; E.mode = 3; E.ssq_out = ssq1; if (l == 0) E.base = IN_F(0); }
            else if (op == 2) { g.A = xb; g.Bt = (const bf16*)(wb + WO_UP); g.N = FF; g.K = DM; E.mode = 1; E.ssq_in = ssq1; E.ob = (bf16*)big; }
            else if (op == 3) { g.A = (const bf16*)big; g.Bt = (const bf16*)(wb + WO_DOWN); g.N = DM; g.K = FF; E.mode = 3; E.ssq_out = ssq2; }
            else if (op == 4) { g.A = (const bf16*)(ws + WS_PB); g.Bt = (const bf16*)(wb + WO_P); g.N = DM; g.K = PLE; E.mode = 2; E.ob = (bf16*)big; }
            else              { g.A = xb; g.Bt = (const bf16*)(wb + WO_G); g.N = DM; g.K = DM; E.mode = 4; E.ssq_in = ssq2; E.ssq_out = ssq0; E.ob = xalt; }
            pg8::StaticOrder S; S.init(M, g.N, F.G, (int)blockIdx.x);
#pragma unroll 1
            for (int rep = 0; rep < ((op == 0 || op == 2) ? REP_G : 1); ++rep)
            pg8::gemm_phase<pg8::EpiAny, pg8::StaticOrder, true, true>(F.lds, g, S, E, F.wave);
        }
    }
    gbar(F, xb);
    final_norm(F);
}

extern "C" void kernel_launch(void* const* d_in, const int* in_sizes, int n_in, void* d_out, int out_size, void* d_ws, size_t ws_size, hipStream_t stream) {
    static int grid = 0;
    if (grid == 0) {
        if (n_in != 21 || out_size != M * DM || ws_size < WS_END) { fprintf(stderr, "kernel_launch: unexpected shapes (n_in %d out %d ws %zu)\n", n_in, out_size, ws_size); grid = -1; return; }
        int dev = 0, cus = 0, per_cu = 0;
        hipGetDevice(&dev); hipDeviceGetAttribute(&cus, hipDeviceAttributeMultiprocessorCount, dev);
        hipFuncSetAttribute((const void*)hybrid_fwd, hipFuncAttributeMaxDynamicSharedMemorySize, LDS_BYTES + 64);
        hipOccupancyMaxActiveBlocksPerMultiprocessor(&per_cu, (const void*)hybrid_fwd, NTHR, LDS_BYTES + 64);
        (void)hipGetLastError();
        if (per_cu < 1) per_cu = 1;
        grid = cus;
        fprintf(stderr, "kernel_launch: cus %d per_cu %d grid %d ws %zu\n", cus, per_cu, grid, ws_size);
    }
    if (grid < 0) return;
    if (hipMemsetAsync((unsigned char*)d_ws + WS_MISC + 65536, 0, 16384, stream) != hipSuccess) { fprintf(stderr, "kernel_launch: memset failed\n"); return; }
    Args a{};
    for (int i = 0; i < 21; ++i) a.in[i] = d_in[i];
    a.out = (float*)d_out; a.ws = (unsigned char*)d_ws;
    void* kargs[] = {&a};
    hipError_t e = hipLaunchCooperativeKernel((const void*)hybrid_fwd, dim3(grid), dim3(NTHR), kargs, LDS_BYTES + 64, stream);
    if (e != hipSuccess) fprintf(stderr, "cooperative launch failed: %s (grid %d)\n", hipGetErrorString(e), grid);
}
```

```cpp
#include <hip/hip_runtime.h>
#include <hip/hip_cooperative_groups.h>
#include <cstdio>
#include <cstdint>
#include <cmath>
namespace pg8 {
#define PG8_LAS __attribute__((address_space(3)))
typedef unsigned short bf16_t;
typedef short bf16x8 __attribute__((ext_vector_type(8)));
typedef float f32x4 __attribute__((ext_vector_type(4)));
typedef unsigned u32x4 __attribute__((ext_vector_type(4)));
constexpr int BM = 256, BK = 64, HALF = 128, HTB = HALF * BK * 2  , STAGE_BYTES = 8 * HTB, NXCD = 8, WGM = 8;

__host__ __device__ __forceinline__ int lds_byte(int r, int c) { const int st = (r >> 4) * 2 + (c >> 5), rr = r & 15, cc = c & 31, ob = rr * 64 + cc * 2; return st * 1024 + (ob ^ (((ob >> 9) & 1) << 5)); }
__host__ __device__ __forceinline__ void stage_rc(int b, int& R, int& C) { const int st = b / 1024, sb = b % 1024, swz = sb ^ (((sb >> 9) & 1) << 5); R = (st >> 1) * 16 + swz / 64; C = (st & 1) * 32 + (swz % 64) / 2; }
__host__ __device__ __forceinline__ int perm32(int rho) { const int n = rho >> 4, i = rho & 15; return 8 * (i >> 2) + 4 * n + (i & 3); }

struct Unit { int pm, pn; };
struct Gemm { const bf16_t* A; const bf16_t* Bt; int M, N, K; };

struct StaticOrder {
    int nM, nN, nwg, G, c;
    __host__ __device__ void init(int M, int N, int G_, int c_) { nM = M / BM; nN = N / BM; nwg = nM * nN; G = G_; c = c_; }
    __host__ __device__ bool next(int i, Unit& u) const {
        const long L = (long)i * G + c; if (L >= nwg) return false;
        int wgid = (int)L; { const int q = nwg / NXCD, r = nwg % NXCD, xcd = wgid % NXCD, off = wgid / NXCD; wgid = (xcd < r ? xcd * (q + 1) : r * (q + 1) + (xcd - r) * q) + off; }
        const int nig = WGM * nN, gid = wgid / nig, fm = gid * WGM, gsz = (nM - fm) < WGM ? (nM - fm) : WGM;
        u.pm = fm + ((wgid % nig) % gsz); u.pn = (wgid % nig) / gsz; return true;
    }
    __device__ __forceinline__ void a_ready(const Unit&) const {}
    __device__ __forceinline__ void done(const Unit&) const {}
};


__device__ __forceinline__ unsigned cvt_pk_bf16(float lo, float hi) { unsigned r; asm volatile("v_cvt_pk_bf16_f32 %0, %1, %2" : "=v"(r) : "v"(lo), "v"(hi)); return r; }
typedef unsigned u32x2 __attribute__((ext_vector_type(2)));
constexpr float RMS_EPS = 1e-6f;
__device__ __forceinline__ float row_rstd(const float* ssq, int row) {
    const f32x4* p = (const f32x4*)(ssq + (size_t)row * 16);
    const f32x4 a = p[0], b = p[1], c = p[2], d = p[3];
    const float s = ((a[0] + a[1]) + (a[2] + a[3])) + ((b[0] + b[1]) + (b[2] + b[3])) + ((c[0] + c[1]) + (c[2] + c[3])) + ((d[0] + d[1]) + (d[2] + d[3]));
    return __builtin_amdgcn_rsqf(s * (1.0f / 1024.0f) + RMS_EPS);
}
struct EpiAny {
    static constexpr bool PERM = true, AFTER_DRAIN = false;
    int mode; const float* ssq_in; float* ssq_out; const float* base; float* xout; bf16_t* ob; const bf16_t* pp; float* gates;
    __device__ __forceinline__ void operator()(const f32x4 (&acc)[2][2][4][2], const Unit& u, int wr, int wc, int fr, int fq) const {
        const int row0 = u.pm * BM + wr * 64 + fr; const int col0 = u.pn * BM + wc * 32 + 8 * fq;
        if (mode <= 1) {
            const int ld = mode == 0 ? 2816 : 4096;
            if (mode == 1 || u.pn < 11) {
#pragma unroll
                for (int ai = 0; ai < 2; ++ai)
#pragma unroll
                    for (int m = 0; m < 4; ++m) { const int row = row0 + ai * HALF + m * 16; const float rs = row_rstd(ssq_in, row); bf16_t* rowp = ob + (size_t)row * ld + col0;
#pragma unroll
                        for (int bj = 0; bj < 2; ++bj) { f32x4 v0 = acc[ai][bj][m][0] * rs, v1 = acc[ai][bj][m][1] * rs;
                            if (mode == 1) {
#pragma unroll
                                for (int e = 0; e < 4; ++e) { const float a = fmaxf(v0[e], 0.f), b = fmaxf(v1[e], 0.f); v0[e] = a * a; v1[e] = b * b; } }
                            u32x4 w; w.x = cvt_pk_bf16(v0[0], v0[1]); w.y = cvt_pk_bf16(v0[2], v0[3]); w.z = cvt_pk_bf16(v1[0], v1[1]); w.w = cvt_pk_bf16(v1[2], v1[3]);
                            *(u32x4*)(rowp + bj * HALF) = w; }
                        asm volatile("" ::: "memory"); }
            } else if (wc == 0 && fq < 2) {
#pragma unroll
                for (int ai = 0; ai < 2; ++ai)
#pragma unroll
                    for (int m = 0; m < 4; ++m) { const int row = row0 + ai * HALF + m * 16; const float rs = row_rstd(ssq_in, row); float* gp = gates + (size_t)row * 16 + 8 * fq;
                        *(f32x4*)(gp) = acc[ai][0][m][0] * rs; *(f32x4*)(gp + 4) = acc[ai][0][m][1] * rs; asm volatile("" ::: "memory"); }
            }
        } else if (mode == 2) {
#pragma unroll
            for (int ai = 0; ai < 2; ++ai)
#pragma unroll
                for (int m = 0; m < 4; ++m) { bf16_t* rowp = ob + (size_t)(row0 + ai * HALF + m * 16) * 1024 + col0;
#pragma unroll
                    for (int bj = 0; bj < 2; ++bj) { const f32x4 v0 = acc[ai][bj][m][0], v1 = acc[ai][bj][m][1];
                        u32x4 w; w.x = cvt_pk_bf16(v0[0], v0[1]); w.y = cvt_pk_bf16(v0[2], v0[3]); w.z = cvt_pk_bf16(v1[0], v1[1]); w.w = cvt_pk_bf16(v1[2], v1[3]);
                        *(u32x4*)(rowp + bj * HALF) = w; }
                    asm volatile("" ::: "memory"); }
        } else {
#pragma unroll
            for (int ai = 0; ai < 2; ++ai)
#pragma unroll
                for (int m = 0; m < 4; ++m) { const int row = row0 + ai * HALF + m * 16; const size_t off = (size_t)row * 1024 + col0;
                    const float* bp = base + off; float* xp = xout + off; bf16_t* op = ob + off; const bf16_t* ppp = pp + off;
                    float rs = 1.f; if (mode == 4) rs = row_rstd(ssq_in, row);
                    float s = 0.f;
#pragma unroll
                    for (int bj = 0; bj < 2; ++bj) {
                        f32x4 a0 = acc[ai][bj][m][0], a1 = acc[ai][bj][m][1];
                        const f32x4 b0 = *(const f32x4*)(bp + bj * HALF), b1 = *(const f32x4*)(bp + bj * HALF + 4);
                        if (mode == 4) { const u32x4 pw = *(const u32x4*)(ppp + bj * HALF);
                            const f32x4 p0 = (f32x4){__uint_as_float(pw.x << 16), __uint_as_float(pw.x & 0xffff0000u), __uint_as_float(pw.y << 16), __uint_as_float(pw.y & 0xffff0000u)}, p1 = (f32x4){__uint_as_float(pw.z << 16), __uint_as_float(pw.z & 0xffff0000u), __uint_as_float(pw.w << 16), __uint_as_float(pw.w & 0xffff0000u)};
#pragma unroll
                            for (int e = 0; e < 4; ++e) { a0[e] = p0[e] * __builtin_amdgcn_rcpf(1.0f + __expf(-a0[e] * rs)); a1[e] = p1[e] * __builtin_amdgcn_rcpf(1.0f + __expf(-a1[e] * rs)); } }
                        const f32x4 o0 = b0 + a0, o1 = b1 + a1;
                        *(f32x4*)(xp + bj * HALF) = o0; *(f32x4*)(xp + bj * HALF + 4) = o1;
                        u32x4 w; w.x = cvt_pk_bf16(o0[0], o0[1]); w.y = cvt_pk_bf16(o0[2], o0[3]); w.z = cvt_pk_bf16(o1[0], o1[1]); w.w = cvt_pk_bf16(o1[2], o1[3]);
                        *(u32x4*)(op + bj * HALF) = w;
                        s += ((o0[0] * o0[0] + o0[1] * o0[1]) + (o0[2] * o0[2] + o0[3] * o0[3])) + ((o1[0] * o1[0] + o1[1] * o1[1]) + (o1[2] * o1[2] + o1[3] * o1[3])); }
                    s += __int_as_float(__builtin_amdgcn_ds_bpermute(((fq ^ 1) * 16 + fr) << 2, __float_as_int(s))); s += __int_as_float(__builtin_amdgcn_ds_bpermute(((fq ^ 2) * 16 + fr) << 2, __float_as_int(s)));
                    if (fq == 0) ssq_out[(size_t)row * 16 + u.pn * 4 + wc] = s;
                    asm volatile("" ::: "memory"); }
        }
    }
};

template <class Epi, class Sched, bool ALIGN_EPI = false, bool SP2 = false>
__device__ __forceinline__ void gemm_phase(PG8_LAS unsigned char* lds, const Gemm g, const Sched& S, const Epi& E, int wave_id) {
    int tid_; asm volatile("v_mbcnt_lo_u32_b32 %0, -1, 0\n\tv_mbcnt_hi_u32_b32 %0, -1, %0" : "=v"(tid_)); tid_ += wave_id * 64; const int tid = tid_, wid = __builtin_amdgcn_readfirstlane(tid >> 6), lane = tid & 63, wr = wid >> 2, wc = wid & 3, fr = lane & 15, fq = lane >> 4;
    const int K = g.K, nt = K / BK;
    unsigned voffA[2], voffB[2];
#pragma unroll
    for (int i = 0; i < 2; ++i) { int R, C; stage_rc(tid * 16 + i * 8192, R, C); const int Rb = Epi::PERM ? ((R & ~31) + perm32(R & 31)) : R;
        voffA[i] = (unsigned)(R * K + C) * 2u; voffB[i] = (unsigned)(Rb * K + C) * 2u; }
    const size_t kstep = (size_t)(BK * 2);
    const size_t hstep = (size_t)HALF * K * 2;
    const size_t tstep = 2 * hstep;
    const unsigned ldsw = (unsigned)wid * 1024u;
    const int aoff = lds_byte(wr * 64 + fr, fq * 8), boff = lds_byte(wc * 32 + fr, fq * 8);
#define PG8_SA(b, h) (((b) * 2 + (h)) * HTB)
#define PG8_SB(b, h) ((4 + (b) * 2 + (h)) * HTB)
#define PG8_STAGE(bufoff, gbase, voff) do { _Pragma("unroll") for (int _i = 0; _i < 2; ++_i) \
        __builtin_amdgcn_global_load_lds((const unsigned*)((const char*)(gbase) + (voff)[_i]), (PG8_LAS unsigned*)(lds + (bufoff) + ldsw + _i * 8192), 16, 0, 0); } while (0)
#define PG8_LDA(dst, b, h) do { _Pragma("unroll") for (int m = 0; m < 4; ++m) _Pragma("unroll") for (int k = 0; k < 2; ++k) dst[m][k] = *(const PG8_LAS bf16x8*)(lds + PG8_SA(b, h) + aoff + m * 2048 + k * 1024); } while (0)
#define PG8_LDB(dst, b, h) do { _Pragma("unroll") for (int n = 0; n < 2; ++n) _Pragma("unroll") for (int k = 0; k < 2; ++k) dst[n][k] = *(const PG8_LAS bf16x8*)(lds + PG8_SB(b, h) + boff + n * 2048 + k * 1024); } while (0)
#define PG8_MMA(ai, bj, At, Bt) do { __builtin_amdgcn_s_setprio(1); _Pragma("unroll") for (int m = 0; m < 4; ++m) _Pragma("unroll") for (int n = 0; n < 2; ++n) _Pragma("unroll") for (int k = 0; k < 2; ++k) \
        acc[ai][bj][m][n] = __builtin_amdgcn_mfma_f32_16x16x32_bf16(Bt[n][k], At[m][k], acc[ai][bj][m][n], 0, 0, 0); __builtin_amdgcn_s_setprio(0); } while (0)
#define PG8_WAIT_V(n) asm volatile("s_waitcnt vmcnt(" #n ")" ::: "memory")
#define PG8_WAIT_L(n) asm volatile("s_waitcnt lgkmcnt(" #n ")" ::: "memory")
#define PG8_BAR __builtin_amdgcn_s_barrier()
#define PG8_SCHED __builtin_amdgcn_sched_barrier(0)
    Unit cur, nxt; int ui = 0;
    if (!S.next(0, cur)) return;
    f32x4 acc[2][2][4][2];
#pragma unroll
    for (int a = 0; a < 2; ++a)
#pragma unroll
        for (int b = 0; b < 2; ++b)
#pragma unroll
            for (int m = 0; m < 4; ++m)
#pragma unroll
                for (int n = 0; n < 2; ++n) acc[a][b][m][n] = (f32x4){0.f, 0.f, 0.f, 0.f};
    bf16x8 At[4][2], B0[2][2], B1[2][2];
    const char* cA = (const char*)g.A + (size_t)cur.pm * tstep; const char* cB = (const char*)g.Bt + (size_t)cur.pn * tstep;
    S.a_ready(cur);
    if constexpr (SP2) {
        PG8_STAGE(PG8_SB(0, 0), cB, voffB); PG8_STAGE(PG8_SB(0, 1), cB + hstep, voffB); PG8_STAGE(PG8_SA(0, 0), cA, voffA); PG8_STAGE(PG8_SA(0, 1), cA + hstep, voffA);
        if (wr == 1) PG8_BAR;
        PG8_WAIT_V(2); PG8_BAR;
        PG8_STAGE(PG8_SB(1, 0), cB + kstep, voffB); PG8_STAGE(PG8_SA(1, 0), cA + kstep, voffA); PG8_STAGE(PG8_SB(1, 1), cB + hstep + kstep, voffB);
        PG8_WAIT_V(6); PG8_BAR;
    } else {
        PG8_STAGE(PG8_SB(0, 0), cB, voffB); PG8_STAGE(PG8_SA(0, 0), cA, voffA); PG8_STAGE(PG8_SB(0, 1), cB + hstep, voffB); PG8_STAGE(PG8_SA(0, 1), cA + hstep, voffA);
        if (wr == 1) PG8_BAR;
        PG8_WAIT_V(4); PG8_BAR;
        PG8_STAGE(PG8_SB(1, 0), cB + kstep, voffB); PG8_STAGE(PG8_SA(1, 0), cA + kstep, voffA); PG8_STAGE(PG8_SB(1, 1), cB + hstep + kstep, voffB);
        PG8_WAIT_V(6); PG8_BAR;
    }
    for (;;) {
        const bool has_next = S.next(ui + 1, nxt);
        const char* nA = has_next ? (const char*)g.A + (size_t)nxt.pm * tstep : cA; const char* nB = has_next ? (const char*)g.Bt + (size_t)nxt.pn * tstep : cB;
        for (int t = 0; t < nt; t += 2) {
            const bool last = (t == nt - 2);
            const char* a1 = cA + (size_t)(t + 1) * kstep;
            const char* a2 = last ? nA : cA + (size_t)(t + 2) * kstep; const char* b2 = last ? nB : cB + (size_t)(t + 2) * kstep;
            const char* a3 = a2 + kstep; const char* b3 = b2 + kstep;
            if (last && has_next) S.a_ready(nxt);
            if constexpr (SP2) {
            PG8_LDB(B0, 0, 0); PG8_LDB(B1, 0, 1); PG8_SCHED; PG8_LDA(At, 0, 0); PG8_STAGE(PG8_SA(1, 1), a1 + hstep, voffA);
            PG8_WAIT_V(8); PG8_WAIT_L(0); PG8_BAR; PG8_MMA(0, 0, At, B0); PG8_MMA(0, 1, At, B1); PG8_BAR; PG8_SCHED;
            PG8_LDA(At, 0, 1); PG8_STAGE(PG8_SB(0, 0), b2, voffB); PG8_STAGE(PG8_SB(0, 1), b2 + hstep, voffB); PG8_STAGE(PG8_SA(0, 0), a2, voffA);
            PG8_WAIT_V(8); PG8_WAIT_L(0); PG8_BAR; PG8_MMA(1, 0, At, B0); PG8_MMA(1, 1, At, B1); PG8_BAR; PG8_SCHED;
            PG8_LDB(B0, 1, 0); PG8_LDB(B1, 1, 1); PG8_SCHED; PG8_LDA(At, 1, 0); PG8_STAGE(PG8_SA(0, 1), a2 + hstep, voffA);
            PG8_WAIT_V(8); PG8_WAIT_L(0); PG8_BAR; PG8_MMA(0, 0, At, B0); PG8_MMA(0, 1, At, B1); PG8_BAR; PG8_SCHED;
            PG8_LDA(At, 1, 1); PG8_STAGE(PG8_SB(1, 0), b3, voffB); PG8_STAGE(PG8_SB(1, 1), b3 + hstep, voffB); PG8_STAGE(PG8_SA(1, 0), a3, voffA);
            PG8_WAIT_V(8); PG8_WAIT_L(0); PG8_BAR; PG8_MMA(1, 0, At, B0); PG8_MMA(1, 1, At, B1); PG8_BAR; PG8_SCHED;
            } else {
            PG8_LDB(B0, 0, 0); PG8_SCHED; PG8_LDA(At, 0, 0); PG8_STAGE(PG8_SA(1, 1), a1 + hstep, voffA);
            PG8_WAIT_L(8); PG8_BAR; PG8_WAIT_L(0); PG8_MMA(0, 0, At, B0); PG8_BAR; PG8_SCHED;
            PG8_LDB(B1, 0, 1); PG8_STAGE(PG8_SB(0, 0), b2, voffB);
            PG8_BAR; PG8_WAIT_L(0); PG8_MMA(0, 1, At, B1); PG8_BAR;
            PG8_LDA(At, 0, 1); PG8_STAGE(PG8_SA(0, 0), a2, voffA);
            PG8_BAR; PG8_WAIT_L(0); PG8_MMA(1, 0, At, B0); PG8_BAR; PG8_SCHED;
            PG8_STAGE(PG8_SB(0, 1), b2 + hstep, voffB);
            PG8_WAIT_V(6); PG8_BAR; PG8_MMA(1, 1, At, B1); PG8_BAR;
            PG8_LDB(B0, 1, 0); PG8_SCHED; PG8_LDA(At, 1, 0); PG8_STAGE(PG8_SA(0, 1), a2 + hstep, voffA);
            PG8_WAIT_L(8); PG8_BAR; PG8_WAIT_L(0); PG8_MMA(0, 0, At, B0); PG8_BAR; PG8_SCHED;
            PG8_LDB(B1, 1, 1); PG8_STAGE(PG8_SB(1, 0), b3, voffB);
            PG8_BAR; PG8_WAIT_L(0); PG8_MMA(0, 1, At, B1); PG8_BAR;
            PG8_LDA(At, 1, 1); PG8_STAGE(PG8_SA(1, 0), a3, voffA);
            PG8_BAR; PG8_WAIT_L(0); PG8_MMA(1, 0, At, B0); PG8_BAR; PG8_SCHED;
            PG8_STAGE(PG8_SB(1, 1), b3 + hstep, voffB);
            PG8_WAIT_V(6); PG8_BAR; PG8_MMA(1, 1, At, B1); PG8_BAR;
            }
        }
        if constexpr (ALIGN_EPI) { if (wr == 0) PG8_BAR; }
        if constexpr (!Epi::AFTER_DRAIN) { E(acc, cur, wr, wc, fr, fq); S.done(cur); }
        if (!has_next) break;
#pragma unroll
        for (int a = 0; a < 2; ++a)
#pragma unroll
            for (int b = 0; b < 2; ++b)
#pragma unroll
                for (int m = 0; m < 4; ++m)
#pragma unroll
                    for (int n = 0; n < 2; ++n) acc[a][b][m][n] = (f32x4){0.f, 0.f, 0.f, 0.f};
        cur = nxt; cA = nA; cB = nB; ++ui;
        if constexpr (ALIGN_EPI) { if (wr == 1) PG8_BAR; }
    }
    PG8_WAIT_V(0);
    if constexpr (!ALIGN_EPI) { if (wr == 0) PG8_BAR; }
    PG8_BAR;
    if constexpr (Epi::AFTER_DRAIN) { E.fused(acc, cur, wr, wc, fr, fq, lds, wid, lane); S.done(cur); }
#undef PG8_SA
#undef PG8_SB
#undef PG8_STAGE
#undef PG8_LDA
#undef PG8_LDB
#undef PG8_MMA
#undef PG8_WAIT_V
#undef PG8_WAIT_L
#undef PG8_BAR
#undef PG8_SCHED
}
}

namespace cg = cooperative_groups;
#define LAS __attribute__((address_space(3)))
typedef unsigned short bf16;
typedef float f32x4 __attribute__((ext_vector_type(4)));
typedef float f32x16 __attribute__((ext_vector_type(16)));
typedef short bf16x8 __attribute__((ext_vector_type(8)));
typedef short s16x4 __attribute__((ext_vector_type(4)));
typedef unsigned u32x4 __attribute__((ext_vector_type(4)));
typedef unsigned u32x2 __attribute__((ext_vector_type(2)));

constexpr int NWAVES = 8, NTHR = 512;
constexpr int BATCH = 8, SEQ = 4096, DM = 1024, M = BATCH * SEQ, NL = 4, FF = 4096, PLE = 256;
constexpr int NPROJ = 2816, NPAD = 3072, INC = 2832;
constexpr float EPS = 1e-6f;
constexpr int LDS_BYTES = 147456;
constexpr int PF_D = 4;
constexpr int REP_MIX = 1, REP_G = 1, REP_BAR = 1, REP_P1 = 1, REP_P2 = 2, REP_P3 = 1;

constexpr size_t MiB = 1u << 20;
constexpr size_t W_LAYER = 27 * MiB;
constexpr size_t WO_IN = 0, WO_OUT = 6 * MiB, WO_UP = 8 * MiB, WO_DOWN = 16 * MiB, WO_G = 24 * MiB, WO_P = 26 * MiB;
constexpr size_t WS_W = 0;
constexpr size_t WS_XB = 108 * MiB;
constexpr size_t WS_SSQ = 172 * MiB;
constexpr size_t WS_ROPE = 178 * MiB;
constexpr size_t WS_GATES = 180 * MiB;
constexpr size_t WS_PB = 182 * MiB;
constexpr size_t WS_QKVC = 198 * MiB;
constexpr size_t WS_BIG = 246 * MiB;
constexpr size_t WS_MISC = 502 * MiB;
constexpr size_t WS_END = 503 * MiB;
constexpr size_t WS_MLB = WS_XB;
constexpr int GU_W = 0, GU_QD = 4096, GU_KD = 8192, GU_U = 12288, GU_QK = 16384, GU_STRIDE = 19456;
constexpr int GDN_NA = 1724;
constexpr int WAVE_LDS = 18432;
constexpr int MU_QB = 0, MU_PT = 4096, MU_KW = 8192, MU_VB = 12288, MU_STRIDE = 16384;

struct Args { const void* in[21]; float* out; unsigned char* ws; };

struct Frame {
    LAS unsigned char* lds;
    int tid, lane, wave, G, gw, ngw;
};
typedef const __attribute__((address_space(4))) void* kptr_t;
__device__ __forceinline__ const void* karg(int i) {
    kptr_t kp = (kptr_t)__builtin_amdgcn_kernarg_segment_ptr();
    asm volatile("" : "+s"(kp));
    return ((const void* const __attribute__((address_space(4)))*)kp)[i];
}
__device__ __forceinline__ int lane_id_asm();
__device__ __forceinline__ Frame relaunder(const Frame& f) {
    Frame r = f;
    r.lane = lane_id_asm(); r.tid = r.wave * 64 + r.lane;
    asm volatile("" : "+v"(r.tid), "+v"(r.lane));
    asm volatile("" : "+s"(r.wave), "+s"(r.gw), "+s"(r.ngw), "+s"(r.G));
    return r;
}
#define IN_F(i) ((const float*)karg(i))
#define OUTP ((float*)karg(21))
#define WSP ((unsigned char*)karg(22))

__device__ __forceinline__ float bf2f(unsigned short b) { return __uint_as_float((unsigned)b << 16); }
typedef float f32x2_t __attribute__((ext_vector_type(2))); typedef __bf16 bf16x2_t __attribute__((ext_vector_type(2)));
__device__ __forceinline__ unsigned pk2(float lo, float hi) { f32x2_t v = {lo, hi}; bf16x2_t b = __builtin_convertvector(v, bf16x2_t); return __builtin_bit_cast(unsigned, b); }
__device__ __forceinline__ unsigned f2bf(float f) { return pk2(f, 0.f) & 0xffffu; }
__device__ __forceinline__ float lo_bf(unsigned w) { return __uint_as_float(w << 16); }
__device__ __forceinline__ float hi_bf(unsigned w) { return __uint_as_float(w & 0xffff0000u); }
__device__ __forceinline__ int lane_id_asm() { int l; asm volatile("v_mbcnt_lo_u32_b32 %0, -1, 0\n\tv_mbcnt_hi_u32_b32 %0, -1, %0" : "=v"(l)); return l; }
__device__ __forceinline__ float xshfl(float v, int src_lane) { return __int_as_float(__builtin_amdgcn_ds_bpermute(src_lane << 2, __float_as_int(v))); }
__device__ __forceinline__ unsigned xshflu(unsigned v, int src_lane) { return (unsigned)__builtin_amdgcn_ds_bpermute(src_lane << 2, (int)v); }
__device__ __forceinline__ float wave_sum(float v, int lane) {
#pragma unroll
    for (int o = 1; o < 64; o <<= 1) v += xshfl(v, lane ^ o);
    return v;
}
#define LDS_WAIT() asm volatile("s_waitcnt lgkmcnt(0)" ::: "memory")
__device__ __forceinline__ float sigmoidf_(float x) { return __builtin_amdgcn_rcpf(1.0f + __expf(-x)); }
__device__ __forceinline__ float softplusf_(float x) { return fmaxf(x, 0.f) + log1pf(__expf(-fabsf(x))); }
__device__ __forceinline__ float sum8(float v) {
    v += __int_as_float(__builtin_amdgcn_update_dpp(0, __float_as_int(v), 0xB1, 0xF, 0xF, true));
    v += __int_as_float(__builtin_amdgcn_update_dpp(0, __float_as_int(v), 0x4E, 0xF, 0xF, true));
    v += __int_as_float(__builtin_amdgcn_update_dpp(0, __float_as_int(v), 0x141, 0xF, 0xF, true));
    return v;
}

__device__ __forceinline__ int win_src_col(int n) {
    if (n < 1024) return n;
    if (n < 2048) return n + 8;
    if (n < 2816) return n + 16;
    if (n < 2824) return 1024 + (n - 2816);
    if (n < 2832) return 2056 + (n - 2824);
    return -1;
}
template <int MAP>
__device__ __forceinline__ void transpose_item(const float* W, int K, int N, bf16* WT, const float* gain, LAS float* scr, int kb, int nb, int lane) {
    const int k0 = 64 * kb, n0 = 32 * nb;
    const int nd = n0 + (lane & 31);
    const int ns = MAP ? win_src_col(nd) : nd;
#pragma unroll 8
    for (int i = 0; i < 32; ++i) { const int kk = 2 * i + (lane >> 5); float v = 0.f; if (ns >= 0) v = W[(size_t)(k0 + kk) * N + ns]; if (gain) v *= gain[k0 + kk]; scr[kk * 33 + (lane & 31)] = v; }
    LDS_WAIT(); asm volatile("" ::: "memory");
    const int c = lane & 7;
#pragma unroll
    for (int j = 0; j < 4; ++j) { const int n = (lane >> 3) + 8 * j; const LAS float* s = scr + (8 * c) * 33 + n;
        u32x4 o; o.x = pk2(s[0 * 33], s[1 * 33]); o.y = pk2(s[2 * 33], s[3 * 33]); o.z = pk2(s[4 * 33], s[5 * 33]); o.w = pk2(s[6 * 33], s[7 * 33]);
        *(u32x4*)(WT + (size_t)(n0 + n) * K + k0 + 8 * c) = o; }
    LDS_WAIT(); asm volatile("" ::: "memory");
}
__device__ __forceinline__ void convert_weights(const Frame& F_in, int l, int idx, int nidx) {
    const Frame F = relaunder(F_in);
    unsigned char* const L_ws = WSP; const float* const L_w_in = IN_F(3); const float* const L_w_out = IN_F(12); const float* const L_w_up = IN_F(15); const float* const L_w_down = IN_F(16); const float* const L_w_g = IN_F(18); const float* const L_w_p = IN_F(19);
    const float* const L_norm_mix = IN_F(13); const float* const L_norm_mlp = IN_F(14); const float* const L_norm_ple = IN_F(17);
    LAS float* scr = (LAS float*)(F.lds + F.wave * 16384);
    constexpr int I_IN = 16 * 96, I_OUT = 16 * 32, I_UP = 16 * 128, I_DOWN = 64 * 32, I_G = 16 * 32, I_P = 4 * 32;
    constexpr int I_LAYER = I_IN + I_OUT + I_UP + I_DOWN + I_G + I_P;
    unsigned char* wb = L_ws + WS_W + (size_t)(l & 1) * W_LAYER;
    for (int it = idx; it < I_LAYER; it += nidx) {
        int r = it;
        if (r < I_IN) { transpose_item<1>(L_w_in + (size_t)l * DM * INC, DM, INC, (bf16*)(wb + WO_IN), L_norm_mix + l * DM, scr, r / 96, r % 96, F.lane); continue; } r -= I_IN;
        if (r < I_OUT) { transpose_item<0>(L_w_out + (size_t)l * DM * DM, DM, DM, (bf16*)(wb + WO_OUT), nullptr, scr, r / 32, r % 32, F.lane); continue; } r -= I_OUT;
        if (r < I_UP) { transpose_item<0>(L_w_up + (size_t)l * DM * FF, DM, FF, (bf16*)(wb + WO_UP), L_norm_mlp + l * DM, scr, r / 128, r % 128, F.lane); continue; } r -= I_UP;
        if (r < I_DOWN) { transpose_item<0>(L_w_down + (size_t)l * FF * DM, FF, DM, (bf16*)(wb + WO_DOWN), nullptr, scr, r / 32, r % 32, F.lane); continue; } r -= I_DOWN;
        if (r < I_G) { transpose_item<0>(L_w_g + (size_t)l * DM * DM, DM, DM, (bf16*)(wb + WO_G), L_norm_ple + l * DM, scr, r / 32, r % 32, F.lane); continue; } r -= I_G;
        transpose_item<0>(L_w_p + (size_t)l * PLE * DM, PLE, DM, (bf16*)(wb + WO_P), nullptr, scr, r / 32, r % 32, F.lane);
    }
}
__device__ __forceinline__ void p0_prologue(const Frame& F_in) {
    const Frame F = relaunder(F_in);
    unsigned char* const L_ws = WSP; const float* const L_in_x = IN_F(0); const int* const L_in_pos = (const int*)karg(2);
    bf16* const L_XB = (bf16*)(L_ws + WS_XB); float* const L_SSQ = (float*)(L_ws + WS_SSQ); float* const L_ROPE = (float*)(L_ws + WS_ROPE);
    for (int m = F.gw; m < M; m += F.ngw) {
        const f32x4* xr = (const f32x4*)(L_in_x + (size_t)m * DM) + F.lane; float s = 0.f;
        unsigned long long* o8 = (unsigned long long*)(L_XB + (size_t)m * DM) + F.lane;
#pragma unroll
        for (int j = 0; j < 4; ++j) { const f32x4 v = xr[64 * j]; s += (v[0] * v[0] + v[1] * v[1]) + (v[2] * v[2] + v[3] * v[3]);
            o8[64 * j] = (unsigned long long)pk2(v[0], v[1]) | ((unsigned long long)pk2(v[2], v[3]) << 32); }
        s = wave_sum(s, F.lane);
        if (F.lane < 16) L_SSQ[(size_t)m * 16 + F.lane] = (F.lane == 0) ? s : 0.f;
    }
    for (int i = F.gw * 64 + F.lane; i < M * 8; i += F.ngw * 64) {
        const int t = i >> 3, j = i & 7;
        const float inv = (float)exp(-(double)(2 * j) / 16.0 * 13.122363377404328);
        const float ang = (float)L_in_pos[t] * inv;
        const double a = (double)ang; const double rev = a * 0.15915494309189535; const double fr = rev - floor(rev + 0.5);
        const float rad = (float)(fr * 6.283185307179586);
        L_ROPE[i] = cosf(rad); L_ROPE[(size_t)M * 8 + i] = sinf(rad);
    }
}

#define MFMA16(a, b, c) __builtin_amdgcn_mfma_f32_16x16x32_bf16((a), (b), (c), 0, 0, 0)
__device__ __forceinline__ int kperm(int ks, int g, int j) { return 32 * ks + 16 * (j >> 2) + 4 * g + (j & 3); }
__device__ __forceinline__ bf16x8 pack_tiles(const f32x4& a, const f32x4& b) { u32x4 w; w.x = pk2(a[0], a[1]); w.y = pk2(a[2], a[3]); w.z = pk2(b[0], b[1]); w.w = pk2(b[2], b[3]); return __builtin_bit_cast(bf16x8, w); }

__device__ __forceinline__ bf16* gdn_ubuf(unsigned char* ws, int unit) {
    return unit < GDN_NA ? (bf16*)(ws + WS_PB) + (size_t)unit * GU_STRIDE : (bf16*)(ws + WS_BIG + 240 * MiB) + (size_t)(unit - GDN_NA) * GU_STRIDE;
}
__device__ __forceinline__ int qk_idx(int tt, int ks) { return tt < 2 ? tt : 2 + (tt - 2) * 2 + ks; }
__device__ __forceinline__ bf16x8 conv8(const bf16* PROJ, size_t tok, int sp, int ch0, const f32x4 (&w)[4][2]) {
    float a[8];
#pragma unroll
    for (int j = 0; j < 8; ++j) a[j] = 0.f;
#pragma unroll
    for (int tap = 0; tap < 4; ++tap) if (sp - 3 + tap >= 0) {
        const u32x4 raw = *(const u32x4*)(PROJ + (tok - 3 + tap) * NPROJ + ch0);
#pragma unroll
        for (int i = 0; i < 4; ++i) { a[2 * i] += w[tap][i >> 1][(2 * i) & 3] * lo_bf(raw[i]); a[2 * i + 1] += w[tap][i >> 1][(2 * i + 1) & 3] * hi_bf(raw[i]); }
    }
    u32x4 o;
#pragma unroll
    for (int i = 0; i < 4; ++i) o[i] = pk2(a[2 * i] * sigmoidf_(a[2 * i]), a[2 * i + 1] * sigmoidf_(a[2 * i + 1]));
    return __builtin_bit_cast(bf16x8, o);
}
__device__ __forceinline__ void solve64(float (&x)[64], const LAS float* Lm) {
#pragma unroll
    for (int c = 1; c < 64; ++c) {
        int one = 1; asm volatile("" : "+s"(one));
        if (one) {
            float a = x[c];
#pragma unroll
            for (int s4 = 0; s4 < (c + 3) / 4; ++s4) { const f32x4 lv = *(const LAS f32x4*)(Lm + c * 64 + 4 * s4);
#pragma unroll
                for (int i = 0; i < 4; ++i) if (4 * s4 + i < c) a -= lv[i] * x[4 * s4 + i]; }
            x[c] = a;
        }
    }
}
__device__ __forceinline__ void gdn_prep(const Frame& F_in, int l) {
    const Frame F = relaunder(F_in);
    unsigned char* const L_ws = WSP; const float* const cw = IN_F(4) + (size_t)l * 4 * 768; const float* const L_a_log = IN_F(5); const float* const L_dt_bias = IN_F(6);
    const bf16* const PROJ = (const bf16*)(L_ws + WS_BIG); const float* const GATES = (const float*)(L_ws + WS_GATES); float* const GL = (float*)(L_ws + WS_MISC) + 2048;
    LAS float* Lm = (LAS float*)(F.lds + F.wave * WAVE_LDS);
    LAS bf16* T = (LAS bf16*)Lm;
    LAS float* gcv = Lm + 4096; LAS float* bkv = gcv + 64; LAS float* rkv = gcv + 128; LAS float* qdf = gcv + 192; LAS float* wfv = gcv + 256; LAS float* kdf = gcv + 320; LAS float* btv = gcv + 384;
    int g, m, lane;
#define RELANE() do { int ln_ = F.lane; asm volatile("" : "+v"(ln_)); lane = ln_; g = ln_ >> 4; m = ln_ & 15; } while (0)
    for (int unit = F.gw; unit < 2048; unit += F.ngw) {
        RELANE();
        const int h = (unit >> 6) & 3, n = unit & 63; const size_t t0 = (size_t)(unit >> 8) * SEQ + (size_t)n * 64;
        bf16* const ub = gdn_ubuf(L_ws, unit);
        float gl, gc_own, beta_own;
        {
            const float* gr = GATES + (t0 + lane) * 16;
            beta_own = sigmoidf_(gr[h]);
            float gs = -__expf(L_a_log[l * 4 + h]) * softplusf_(gr[4 + h] + L_dt_bias[l * 4 + h]);
#pragma unroll
            for (int o = 1; o < 64; o <<= 1) { const float t = xshfl(gs, lane >= o ? lane - o : lane); if (lane >= o) gs += t; }
            gc_own = gs; gl = __int_as_float(__builtin_amdgcn_readlane(__float_as_int(gs), 63));
            gcv[lane] = gs; btv[lane] = beta_own;
        }
        RELANE();
        bf16x8 FQ[4][2], FK[4][2];
#pragma unroll
        for (int ks = 0; ks < 2; ++ks) {
            f32x4 wq[4][2], wk[4][2];
#pragma unroll
            for (int tap = 0; tap < 4; ++tap) { const float* wp = cw + tap * 768 + h * 64 + 32 * ks + 8 * g; wq[tap][0] = *(const f32x4*)wp; wq[tap][1] = *(const f32x4*)(wp + 4); wk[tap][0] = *(const f32x4*)(wp + 256); wk[tap][1] = *(const f32x4*)(wp + 260); }
#pragma unroll
            for (int mt = 0; mt < 4; ++mt) { int one_ = 1; asm volatile("" : "+s"(one_)); if (one_) {
                FQ[mt][ks] = conv8(PROJ, t0 + 16 * mt + m, 64 * n + 16 * mt + m, h * 64 + 32 * ks + 8 * g, wq);
                FK[mt][ks] = conv8(PROJ, t0 + 16 * mt + m, 64 * n + 16 * mt + m, 256 + h * 64 + 32 * ks + 8 * g, wk);
            } }
        }
        RELANE();
#pragma unroll
        for (int tt = 0; tt < 4; ++tt) {
            f32x4 ak = (f32x4){0.f, 0.f, 0.f, 0.f}, aq = ak;
            ak = MFMA16(FK[tt][0], FK[tt][0], ak); ak = MFMA16(FK[tt][1], FK[tt][1], ak);
            aq = MFMA16(FQ[tt][0], FQ[tt][0], aq); aq = MFMA16(FQ[tt][1], FQ[tt][1], aq);
            const int r = m & 3;
            const float dk_ = r == 0 ? ak[0] : r == 1 ? ak[1] : r == 2 ? ak[2] : ak[3];
            const float dq_ = r == 0 ? aq[0] : r == 1 ? aq[1] : r == 2 ? aq[2] : aq[3];
            if ((m >> 2) == g) { rkv[16 * tt + m] = __builtin_amdgcn_rsqf(dk_ + EPS); qdf[16 * tt + m] = 0.125f * __builtin_amdgcn_rsqf(dq_ + EPS); }
        }
        LDS_WAIT(); asm volatile("" ::: "memory");
        RELANE();
        {
            const float rk = rkv[lane], rq = qdf[lane];
            LDS_WAIT(); asm volatile("" ::: "memory");
            bkv[lane] = beta_own * rk; wfv[lane] = beta_own * rk * __expf(gc_own); kdf[lane] = rk * __expf(gl - gc_own); qdf[lane] = rq;
        }
        LDS_WAIT(); asm volatile("" ::: "memory");
        RELANE();
#pragma unroll
        for (int tt = 0; tt < 4; ++tt) { int one_ = 1; asm volatile("" : "+s"(one_)); if (one_) {
            const float gct = gcv[16 * tt + m], rqt = qdf[16 * tt + m];
#pragma unroll
            for (int ks = 0; ks < 2; ++ks) if (2 * ks <= tt) {
                u32x4 ow = (u32x4){0u, 0u, 0u, 0u};
#pragma unroll
                for (int hf = 0; hf < 2; ++hf) { const int st = 2 * ks + hf;
                    if (st <= tt) {
                        f32x4 acc = (f32x4){0.f, 0.f, 0.f, 0.f};
                        acc = MFMA16(FK[st][0], FQ[tt][0], acc); acc = MFMA16(FK[st][1], FQ[tt][1], acc);
                        const f32x4 gcs = *(const LAS f32x4*)(gcv + 16 * st + 4 * g), rks = *(const LAS f32x4*)(rkv + 16 * st + 4 * g);
                        float v[4];
#pragma unroll
                        for (int r = 0; r < 4; ++r) { const int sI = 16 * st + 4 * g + r, tI = 16 * tt + m; v[r] = (sI <= tI) ? acc[r] * rqt * rks[r] * __expf(gct - gcs[r]) : 0.f; }
                        ow[2 * hf] = pk2(v[0], v[1]); ow[2 * hf + 1] = pk2(v[2], v[3]);
                    } }
                *(u32x4*)(ub + GU_QK + (qk_idx(tt, ks) * 64 + lane) * 8) = ow;
            }
        } }
        RELANE();
#pragma unroll
        for (int mt = 0; mt < 4; ++mt)
#pragma unroll
            for (int ks = 0; ks < 2; ++ks) *(LAS bf16x8*)(T + (16 * mt + m) * 72 + 32 * ks + 8 * g) = FQ[mt][ks];
        LDS_WAIT(); asm volatile("" ::: "memory");
#pragma unroll
        for (int mt = 0; mt < 4; ++mt) {
            const float f = qdf[16 * mt + m] * __expf(gcv[16 * mt + m]);
#pragma unroll
            for (int ks = 0; ks < 2; ++ks) {
                const u32x2 lo = *(const LAS u32x2*)(T + (16 * mt + m) * 72 + 32 * ks + 4 * g), hi = *(const LAS u32x2*)(T + (16 * mt + m) * 72 + 32 * ks + 16 + 4 * g);
                u32x4 ow; ow.x = pk2(lo_bf(lo.x) * f, hi_bf(lo.x) * f); ow.y = pk2(lo_bf(lo.y) * f, hi_bf(lo.y) * f); ow.z = pk2(lo_bf(hi.x) * f, hi_bf(hi.x) * f); ow.w = pk2(lo_bf(hi.y) * f, hi_bf(hi.y) * f);
                *(u32x4*)(ub + GU_QD + ((mt * 2 + ks) * 64 + lane) * 8) = ow;
            }
        }
        LDS_WAIT(); asm volatile("" ::: "memory");
        RELANE();
        float xw[64];
        {
            const int chk = 256 + h * 64 + lane;
            const float k0 = cw[chk], k1 = cw[768 + chk], k2 = cw[1536 + chk], k3 = cw[2304 + chk];
            float ka = 0.f, kb = 0.f, kc = 0.f;
            if (n > 0) { ka = bf2f(PROJ[(t0 - 3) * NPROJ + chk]); kb = bf2f(PROJ[(t0 - 2) * NPROJ + chk]); kc = bf2f(PROJ[(t0 - 1) * NPROJ + chk]); }
            unsigned short kr[64];
#pragma unroll
            for (int c = 0; c < 64; ++c) kr[c] = PROJ[(t0 + c) * NPROJ + chk];
            asm volatile("" ::: "memory");
#pragma unroll
            for (int c4 = 0; c4 < 16; ++c4) {
                const f32x4 wf4 = *(const LAS f32x4*)(wfv + 4 * c4), kd4 = *(const LAS f32x4*)(kdf + 4 * c4);
                float kt[4];
#pragma unroll
                for (int i = 0; i < 4; ++i) { const int c = 4 * c4 + i; const float kd_ = bf2f(kr[c]);
                    float ak = k0 * ka + k1 * kb + k2 * kc + k3 * kd_; ak = ak * sigmoidf_(ak); ka = kb; kb = kc; kc = kd_;
                    xw[c] = ak * wf4[i]; kt[i] = ak * kd4[i]; }
                u32x2 w2; w2.x = pk2(kt[0], kt[1]); w2.y = pk2(kt[2], kt[3]);
                *(LAS u32x2*)(T + lane * 72 + 4 * c4) = w2;
            }
        }
        LDS_WAIT(); asm volatile("" ::: "memory");
        RELANE();
#pragma unroll
        for (int dt = 0; dt < 4; ++dt)
#pragma unroll
            for (int ks = 0; ks < 2; ++ks) {
                const u32x2 lo = *(const LAS u32x2*)(T + (16 * dt + m) * 72 + 32 * ks + 4 * g), hi = *(const LAS u32x2*)(T + (16 * dt + m) * 72 + 32 * ks + 16 + 4 * g);
                u32x4 ow; ow.x = lo.x; ow.y = lo.y; ow.z = hi.x; ow.w = hi.y;
                *(u32x4*)(ub + GU_KD + ((dt * 2 + ks) * 64 + lane) * 8) = ow;
            }
        LDS_WAIT(); asm volatile("" ::: "memory");
        RELANE();
#pragma unroll
        for (int ct = 0; ct < 4; ++ct) { int one_ = 1; asm volatile("" : "+s"(one_)); if (one_) {
            const f32x4 gcc = *(const LAS f32x4*)(gcv + 16 * ct + 4 * g), bkc = *(const LAS f32x4*)(bkv + 16 * ct + 4 * g);
#pragma unroll
            for (int st = 0; st <= ct; ++st) {
                f32x4 acc = (f32x4){0.f, 0.f, 0.f, 0.f};
                acc = MFMA16(FK[ct][0], FK[st][0], acc); acc = MFMA16(FK[ct][1], FK[st][1], acc);
                const float gcs = gcv[16 * st + m], rks = rkv[16 * st + m];
#pragma unroll
                for (int r = 0; r < 4; ++r) { const int cI = 16 * ct + 4 * g + r, sI = 16 * st + m; Lm[cI * 64 + sI] = (sI < cI) ? acc[r] * bkc[r] * rks * __expf(gcc[r] - gcs) : 0.f; }
            }
        } }
        LDS_WAIT(); asm volatile("" ::: "memory");
        __builtin_amdgcn_sched_barrier(0);
        solve64(xw, Lm);
        __builtin_amdgcn_sched_barrier(0);
        {
            RELANE();
            const int l5 = lane & 31, gp = (l5 >> 2) & 3, jj = ((l5 >> 4) << 2) | (l5 & 3);
            bf16* wp = ub + GU_W + (lane >> 5) * 512 + gp * 128 + jj;
#pragma unroll
            for (int c = 0; c < 64; ++c) wp[(c >> 4) * 1024 + (c & 15) * 8] = (bf16)f2bf(xw[c]);
        }
        __builtin_amdgcn_sched_barrier(0);
        RELANE();
        float xu[64];
        {
            const int chv = 512 + h * 64 + lane;
            const float v0 = cw[chv], v1 = cw[768 + chv], v2 = cw[1536 + chv], v3 = cw[2304 + chv];
            float va = 0.f, vb = 0.f, vc = 0.f;
            if (n > 0) { va = bf2f(PROJ[(t0 - 3) * NPROJ + chv]); vb = bf2f(PROJ[(t0 - 2) * NPROJ + chv]); vc = bf2f(PROJ[(t0 - 1) * NPROJ + chv]); }
            unsigned short vr[64];
#pragma unroll
            for (int c = 0; c < 64; ++c) vr[c] = PROJ[(t0 + c) * NPROJ + chv];
            asm volatile("" ::: "memory");
#pragma unroll
            for (int c4 = 0; c4 < 16; ++c4) {
                const f32x4 bt4 = *(const LAS f32x4*)(btv + 4 * c4);
#pragma unroll
                for (int i = 0; i < 4; ++i) { const int c = 4 * c4 + i; const float vd_ = bf2f(vr[c]);
                    float av = v0 * va + v1 * vb + v2 * vc + v3 * vd_; av = av * sigmoidf_(av); va = vb; vb = vc; vc = vd_;
                    xu[c] = av * bt4[i]; }
            }
        }
        __builtin_amdgcn_sched_barrier(0);
        solve64(xu, Lm);
        __builtin_amdgcn_sched_barrier(0);
        LDS_WAIT(); asm volatile("" ::: "memory");
        RELANE();
        {
            const int sl = lane >> 4, e = lane & 15;
#pragma unroll
            for (int mt = 0; mt < 4; ++mt)
#pragma unroll
                for (int gp = 0; gp < 4; ++gp) { const int c = 16 * mt + 4 * gp; u32x2 w2; w2.x = pk2(xu[c], xu[c + 1]); w2.y = pk2(xu[c + 2], xu[c + 3]);
                    *(u32x2*)(ub + GU_U + ((sl * 4 + mt) * 64 + gp * 16 + e) * 4) = w2; }
        }
        if (lane == 0) GL[unit] = __expf(gl);
        LDS_WAIT(); asm volatile("" ::: "memory");
    }
#undef RELANE
}
__device__ __forceinline__ void gdn_scan(const Frame& F_in, int task) {
    const Frame F = relaunder(F_in);
    unsigned char* const L_ws = WSP; bf16* const PROJ = (bf16*)(L_ws + WS_BIG); const float* const GL = (const float*)(L_ws + WS_MISC) + 2048;
    const int bh = task >> 2, sl = task & 3;
    const int b = bh >> 2, h = bh & 3, unit0 = b * 256 + h * 64;
    f32x4 St[4];
#pragma unroll
    for (int i = 0; i < 4; ++i) St[i] = (f32x4){0.f, 0.f, 0.f, 0.f};
    bf16x8 W[8], QD[8], KD[8], QK[6]; u32x2 U[4], UN[4]; float gl; int vz = 0; asm volatile("" : "+v"(vz)); unsigned pA = 0, pB = 0;
    {
        const bf16* u0 = gdn_ubuf(L_ws, unit0) + F.lane * 8;
#pragma unroll
        for (int f = 0; f < 8; ++f) { W[f] = *(const bf16x8*)(u0 + GU_W + f * 512); QD[f] = *(const bf16x8*)(u0 + GU_QD + f * 512); KD[f] = *(const bf16x8*)(u0 + GU_KD + f * 512); }
#pragma unroll
        for (int f = 0; f < 6; ++f) QK[f] = *(const bf16x8*)(u0 + GU_QK + f * 512);
#pragma unroll
        for (int mt = 0; mt < 4; ++mt) U[mt] = *(const u32x2*)(u0 - F.lane * 8 + GU_U + ((sl * 4 + mt) * 64 + F.lane) * 4);
        gl = GL[unit0 + vz];
    }
#pragma unroll 1
    for (int n = 0; n < 64; ++n) {
        const int nn = n < 63 ? n + 1 : 63;
        int ln_ = F.lane; asm volatile("" : "+v"(ln_)); const int g = ln_ >> 4, e = ln_ & 15;
        const bf16* un = gdn_ubuf(L_ws, unit0 + nn) + ln_ * 8;
        const float cgl = gl; gl = GL[unit0 + nn + vz];
        const bf16x8 SB0 = pack_tiles(St[0], St[1]), SB1 = pack_tiles(St[2], St[3]);
        const size_t t0 = (size_t)b * SEQ + (size_t)n * 64;
        f32x4 vn[4];
#pragma unroll
        for (int tt = 0; tt < 4; ++tt) {
            f32x4 ws_ = (f32x4){0.f, 0.f, 0.f, 0.f};
            ws_ = MFMA16(W[tt * 2], SB0, ws_); ws_ = MFMA16(W[tt * 2 + 1], SB1, ws_);
            W[tt * 2] = *(const bf16x8*)(un + GU_W + (tt * 2) * 512); W[tt * 2 + 1] = *(const bf16x8*)(un + GU_W + (tt * 2 + 1) * 512);
            vn[tt] = (f32x4){lo_bf(U[tt].x), hi_bf(U[tt].x), lo_bf(U[tt].y), hi_bf(U[tt].y)} - ws_;
            U[tt] = *(const u32x2*)(un - ln_ * 8 + GU_U + ((sl * 4 + tt) * 64 + ln_) * 4);
        }
        const bf16x8 VB0 = pack_tiles(vn[0], vn[1]), VB1 = pack_tiles(vn[2], vn[3]);
#pragma unroll
        for (int tt = 0; tt < 4; ++tt) {
            f32x4 o = (f32x4){0.f, 0.f, 0.f, 0.f};
            o = MFMA16(QD[tt * 2], SB0, o); o = MFMA16(QD[tt * 2 + 1], SB1, o);
            QD[tt * 2] = *(const bf16x8*)(un + GU_QD + (tt * 2) * 512); QD[tt * 2 + 1] = *(const bf16x8*)(un + GU_QD + (tt * 2 + 1) * 512);
            o = MFMA16(QK[qk_idx(tt, 0)], VB0, o); QK[qk_idx(tt, 0)] = *(const bf16x8*)(un + GU_QK + qk_idx(tt, 0) * 512);
            if (tt >= 2) { o = MFMA16(QK[qk_idx(tt, 1)], VB1, o); QK[qk_idx(tt, 1)] = *(const bf16x8*)(un + GU_QK + qk_idx(tt, 1) * 512); }
#pragma unroll
            for (int r = 0; r < 4; ++r) PROJ[(t0 + 16 * tt + 4 * g + r) * NPROJ + 512 + h * 64 + 16 * sl + e] = (bf16)f2bf(o[r]);
        }
#pragma unroll
        for (int dt = 0; dt < 4; ++dt) { f32x4 c = St[dt] * cgl; c = MFMA16(KD[dt * 2], VB0, c); c = MFMA16(KD[dt * 2 + 1], VB1, c); St[dt] = c;
            KD[dt * 2] = *(const bf16x8*)(un + GU_KD + (dt * 2) * 512); KD[dt * 2 + 1] = *(const bf16x8*)(un + GU_KD + (dt * 2 + 1) * 512); }
    }
}

__device__ __forceinline__ void mlstm_prep(const Frame& F_in, int l) {
    const Frame F = relaunder(F_in);
    unsigned char* const L_ws = WSP; const float* const L_i_bias = IN_F(8); const float* const L_f_bias = IN_F(9);
    const bf16* const PROJ = (const bf16*)(L_ws + WS_BIG); const float* const GATES = (const float*)(L_ws + WS_GATES); float* const FL = (float*)(L_ws + WS_MISC);
    LAS float* bvec = (LAS float*)(F.lds + F.wave * WAVE_LDS); LAS float* avec = bvec + 64;
    const int g = F.lane >> 4, m = F.lane & 15;
    for (int unit = F.gw; unit < 2048; unit += F.ngw) {
        const int h = (unit >> 6) & 3; const size_t t0 = (size_t)(unit >> 8) * SEQ + (size_t)(unit & 63) * 64;
        bf16* const ub = (bf16*)(L_ws + WS_MLB) + (size_t)unit * MU_STRIDE;
        float bl;
        {
            const float* gr = GATES + (t0 + F.lane) * 16;
            const float iv = 15.0f * tanhf((gr[8 + h] + L_i_bias[l * 4 + h]) * (1.0f / 15.0f));
            const float c = 15.0f * tanhf((gr[12 + h] + L_f_bias[l * 4 + h]) * (1.0f / 15.0f));
            float bs = -softplusf_(-c);
#pragma unroll
            for (int o = 1; o < 64; o <<= 1) { const float t = xshfl(bs, F.lane >= o ? F.lane - o : F.lane); if (F.lane >= o) bs += t; }
            bl = __int_as_float(__builtin_amdgcn_readlane(__float_as_int(bs), 63));
            bvec[F.lane] = bs; avec[F.lane] = iv - bs;
        }
        LDS_WAIT(); asm volatile("" ::: "memory");
        const bf16* qrow = PROJ + (t0 + m) * NPROJ + 1024 + h * 64;
        bf16x8 FQ[4][2], FK[4][2];
#pragma unroll
        for (int mt = 0; mt < 4; ++mt)
#pragma unroll
            for (int ks = 0; ks < 2; ++ks) { FQ[mt][ks] = *(const bf16x8*)(qrow + (size_t)(16 * mt) * NPROJ + 32 * ks + 8 * g); FK[mt][ks] = *(const bf16x8*)(qrow + (size_t)(16 * mt) * NPROJ + 256 + 32 * ks + 8 * g); }
#pragma unroll
        for (int tt = 0; tt < 4; ++tt) {
            const float bt = bvec[16 * tt + m];
#pragma unroll
            for (int ks = 0; ks < 2; ++ks) {
                u32x4 ow = (u32x4){0u, 0u, 0u, 0u};
#pragma unroll
                for (int hf = 0; hf < 2; ++hf) { const int st = 2 * ks + hf;
                    if (st <= tt) {
                        f32x4 acc = (f32x4){0.f, 0.f, 0.f, 0.f};
                        acc = MFMA16(FK[st][0], FQ[tt][0], acc); acc = MFMA16(FK[st][1], FQ[tt][1], acc);
                        const f32x4 av = *(const LAS f32x4*)(avec + 16 * st + 4 * g);
                        float v[4];
#pragma unroll
                        for (int r = 0; r < 4; ++r) { const int sI = 16 * st + 4 * g + r, tI = 16 * tt + m; v[r] = (sI <= tI) ? acc[r] * 0.125f * __expf(bt + av[r]) : 0.f; }
                        ow[2 * hf] = pk2(v[0], v[1]); ow[2 * hf + 1] = pk2(v[2], v[3]);
                    } }
                *(u32x4*)(ub + MU_PT + ((tt * 2 + ks) * 64 + F.lane) * 8) = ow;
            }
        }
#pragma unroll
        for (int mt = 0; mt < 4; ++mt) {
            const float f = __expf(bvec[16 * mt + m]);
#pragma unroll
            for (int ks = 0; ks < 2; ++ks) {
                const u32x2 lo = *(const u32x2*)(qrow + (size_t)(16 * mt) * NPROJ + 32 * ks + 4 * g), hi = *(const u32x2*)(qrow + (size_t)(16 * mt) * NPROJ + 32 * ks + 16 + 4 * g);
                u32x4 ow; ow.x = pk2(lo_bf(lo.x) * f, hi_bf(lo.x) * f); ow.y = pk2(lo_bf(lo.y) * f, hi_bf(lo.y) * f); ow.z = pk2(lo_bf(hi.x) * f, hi_bf(hi.x) * f); ow.w = pk2(lo_bf(hi.y) * f, hi_bf(hi.y) * f);
                *(u32x4*)(ub + MU_QB + ((mt * 2 + ks) * 64 + F.lane) * 8) = ow;
            }
        }
#pragma unroll
        for (int ks = 0; ks < 2; ++ks) {
            const f32x4 a0 = *(const LAS f32x4*)(avec + 32 * ks + 4 * g), a1 = *(const LAS f32x4*)(avec + 32 * ks + 16 + 4 * g);
            float fac[8];
#pragma unroll
            for (int j = 0; j < 4; ++j) { fac[j] = 0.125f * __expf(bl + a0[j]); fac[4 + j] = 0.125f * __expf(bl + a1[j]); }
            const bf16* kcol = PROJ + (t0 + 32 * ks + 4 * g) * NPROJ + 1280 + h * 64 + m;
#pragma unroll
            for (int dt = 0; dt < 4; ++dt) {
                float kv[8];
#pragma unroll
                for (int j = 0; j < 8; ++j) kv[j] = bf2f(kcol[(size_t)(16 * (j >> 2) + (j & 3)) * NPROJ + 16 * dt]) * fac[j];
                u32x4 ow; ow.x = pk2(kv[0], kv[1]); ow.y = pk2(kv[2], kv[3]); ow.z = pk2(kv[4], kv[5]); ow.w = pk2(kv[6], kv[7]);
                *(u32x4*)(ub + MU_KW + ((dt * 2 + ks) * 64 + F.lane) * 8) = ow;
            }
#pragma unroll
            for (int sl = 0; sl < 4; ++sl) {
                unsigned short vv[8];
#pragma unroll
                for (int j = 0; j < 8; ++j) vv[j] = kcol[(size_t)(16 * (j >> 2) + (j & 3)) * NPROJ + 256 + 16 * sl];
                u32x4 ow; ow.x = vv[0] | ((unsigned)vv[1] << 16); ow.y = vv[2] | ((unsigned)vv[3] << 16); ow.z = vv[4] | ((unsigned)vv[5] << 16); ow.w = vv[6] | ((unsigned)vv[7] << 16);
                *(u32x4*)(ub + MU_VB + ((sl * 2 + ks) * 64 + F.lane) * 8) = ow;
            }
        }
        if (F.lane == 0) FL[unit] = __expf(bl);
        LDS_WAIT(); asm volatile("" ::: "memory");
    }
}
__device__ __forceinline__ void mlstm_scan(const Frame& F_in, int task) {
    const Frame F = relaunder(F_in);
    unsigned char* const L_ws = WSP; bf16* const PROJ = (bf16*)(L_ws + WS_BIG); float* const GATES = (float*)(L_ws + WS_GATES); const float* const FL = (const float*)(L_ws + WS_MISC);
    const int bh = task / 5, sl = task % 5;
    const int b = bh >> 2, h = bh & 3;
    const bf16* ub0 = (const bf16*)(L_ws + WS_MLB) + (size_t)(b * 256 + h * 64) * MU_STRIDE; const bf16* ub = ub0 + F.lane * 8;
    const u32x4 ones = (u32x4){0x3f803f80u, 0x3f803f80u, 0x3f803f80u, 0x3f803f80u};
    f32x4 Ct[4];
#pragma unroll
    for (int i = 0; i < 4; ++i) Ct[i] = (f32x4){0.f, 0.f, 0.f, 0.f};
    bf16x8 QB[8], PT[8], KW[8], VB[2], VN[2]; float fl; unsigned pA = 0, pB = 0, pC = 0, pD = 0;
#define ML_VB(dst, n_) do { const bf16* u_ = ub + (size_t)(n_) * MU_STRIDE; if (sl < 4) { dst[0] = *(const bf16x8*)(u_ + MU_VB + (sl * 2) * 512); dst[1] = *(const bf16x8*)(u_ + MU_VB + (sl * 2 + 1) * 512); } else { dst[0] = __builtin_bit_cast(bf16x8, ones); dst[1] = dst[0]; } } while (0)
#pragma unroll
    for (int f = 0; f < 8; ++f) { QB[f] = *(const bf16x8*)(ub + MU_QB + f * 512); PT[f] = *(const bf16x8*)(ub + MU_PT + f * 512); KW[f] = *(const bf16x8*)(ub + MU_KW + f * 512); }
    int vz = 0; asm volatile("" : "+v"(vz)); ML_VB(VB, 0); fl = FL[b * 256 + h * 64 + vz];
#pragma unroll 1
    for (int n = 0; n < 64; ++n) {
        const int nn = n < 63 ? n + 1 : 63;
        int ln_ = F.lane; asm volatile("" : "+v"(ln_)); const int g = ln_ >> 4, e = ln_ & 15;
        const bf16* un = ub0 + ln_ * 8 + (size_t)nn * MU_STRIDE;
        const float cfl = fl; fl = FL[b * 256 + h * 64 + nn + vz];
        ML_VB(VN, nn);
        const bf16x8 CB0 = pack_tiles(Ct[0], Ct[1]), CB1 = pack_tiles(Ct[2], Ct[3]);
        const size_t t0 = (size_t)b * SEQ + (size_t)n * 64;
#pragma unroll
        for (int tt = 0; tt < 4; ++tt) {
            f32x4 o = (f32x4){0.f, 0.f, 0.f, 0.f};
            o = MFMA16(QB[tt * 2], CB0, o); o = MFMA16(QB[tt * 2 + 1], CB1, o); o = MFMA16(PT[tt * 2], VB[0], o); o = MFMA16(PT[tt * 2 + 1], VB[1], o);
            QB[tt * 2] = *(const bf16x8*)(un + MU_QB + (tt * 2) * 512); QB[tt * 2 + 1] = *(const bf16x8*)(un + MU_QB + (tt * 2 + 1) * 512);
            PT[tt * 2] = *(const bf16x8*)(un + MU_PT + (tt * 2) * 512); PT[tt * 2 + 1] = *(const bf16x8*)(un + MU_PT + (tt * 2 + 1) * 512);
            if (sl < 4) {
#pragma unroll
                for (int r = 0; r < 4; ++r) PROJ[(t0 + 16 * tt + 4 * g + r) * NPROJ + 1536 + h * 64 + 16 * sl + e] = (bf16)f2bf(o[r]);
            } else if (e == 0) {
#pragma unroll
                for (int r = 0; r < 4; ++r) GATES[(t0 + 16 * tt + 4 * g + r) * 16 + 8 + h] = o[r];
            }
        }
#pragma unroll
        for (int dt = 0; dt < 4; ++dt) { f32x4 c = Ct[dt] * cfl; c = MFMA16(KW[dt * 2], VB[0], c); c = MFMA16(KW[dt * 2 + 1], VB[1], c); Ct[dt] = c;
            KW[dt * 2] = *(const bf16x8*)(un + MU_KW + (dt * 2) * 512); KW[dt * 2 + 1] = *(const bf16x8*)(un + MU_KW + (dt * 2 + 1) * 512); }
        VB[0] = VN[0]; VB[1] = VN[1];
    }
#undef ML_VB
}

__device__ __forceinline__ float sum16(float v) {
    v += __int_as_float(__builtin_amdgcn_update_dpp(0, __float_as_int(v), 0xB1, 0xF, 0xF, true));
    v += __int_as_float(__builtin_amdgcn_update_dpp(0, __float_as_int(v), 0x4E, 0xF, 0xF, true));
    v += __int_as_float(__builtin_amdgcn_update_dpp(0, __float_as_int(v), 0x141, 0xF, 0xF, true));
    v += __int_as_float(__builtin_amdgcn_update_dpp(0, __float_as_int(v), 0x140, 0xF, 0xF, true));
    return v;
}
__device__ __forceinline__ void m2_post(const Frame& F_in, int l) {
    const Frame F = relaunder(F_in);
    unsigned char* const L_ws = WSP;
    {
        const f32x4* ps = (const f32x4*)(IN_F(1) + (size_t)l * M * PLE); u32x2* pb = (u32x2*)(L_ws + WS_PB);
        const int stride = F.ngw * 64;
        for (int i = F.gw * 64 + F.lane; i < M * PLE / 4; i += 4 * stride) {
            f32x4 v[4];
#pragma unroll
            for (int u = 0; u < 4; ++u) v[u] = ps[i + u * stride];
#pragma unroll
            for (int u = 0; u < 4; ++u) { u32x2 w; w.x = pk2(v[u][0], v[u][1]); w.y = pk2(v[u][2], v[u][3]); pb[i + u * stride] = w; }
        }
    }
    const bf16* const PROJ = (const bf16*)(L_ws + WS_BIG); bf16* const Y = (bf16*)(L_ws + WS_BIG + 176 * MiB); const float* const GATES = (const float*)(L_ws + WS_GATES);
    const f32x4 gn = *(const f32x4*)(IN_F(7) + l * 64 + ((4 * F.lane) & 63)), mn = *(const f32x4*)(IN_F(10) + l * 256 + 4 * F.lane);
    for (int t = F.gw * 4; t < M; t += F.ngw * 4) {
        u32x2 og[4], zg[4], om[4], pm[4]; float dn[4];
#pragma unroll
        for (int u = 0; u < 4; ++u) { const bf16* row = PROJ + (size_t)(t + u) * NPROJ + 4 * F.lane;
            og[u] = *(const u32x2*)(row + 512); zg[u] = *(const u32x2*)(row + 768); om[u] = *(const u32x2*)(row + 1536); pm[u] = *(const u32x2*)(row + 1792);
            dn[u] = GATES[(size_t)(t + u) * 16 + 8 + (F.lane >> 4)]; }
#pragma unroll
        for (int u = 0; u < 4; ++u) {
            float o[4] = {lo_bf(og[u].x), hi_bf(og[u].x), lo_bf(og[u].y), hi_bf(og[u].y)}, z[4] = {lo_bf(zg[u].x), hi_bf(zg[u].x), lo_bf(zg[u].y), hi_bf(zg[u].y)};
            float rs = __builtin_amdgcn_rsqf(sum16((o[0] * o[0] + o[1] * o[1]) + (o[2] * o[2] + o[3] * o[3])) * (1.0f / 64.0f) + EPS);
            float y[4];
#pragma unroll
            for (int i = 0; i < 4; ++i) y[i] = o[i] * rs * gn[i] * (z[i] * sigmoidf_(z[i]));
            u32x2 w; w.x = pk2(y[0], y[1]); w.y = pk2(y[2], y[3]);
            *(u32x2*)(Y + (size_t)(t + u) * DM + 4 * F.lane) = w;
            const float inv = __builtin_amdgcn_rcpf(fmaxf(fabsf(dn[u]), 1.0f));
            float hm[4] = {lo_bf(om[u].x) * inv, hi_bf(om[u].x) * inv, lo_bf(om[u].y) * inv, hi_bf(om[u].y) * inv}, p[4] = {lo_bf(pm[u].x), hi_bf(pm[u].x), lo_bf(pm[u].y), hi_bf(pm[u].y)};
            rs = __builtin_amdgcn_rsqf(sum16((hm[0] * hm[0] + hm[1] * hm[1]) + (hm[2] * hm[2] + hm[3] * hm[3])) * (1.0f / 64.0f) + EPS);
#pragma unroll
            for (int i = 0; i < 4; ++i) y[i] = hm[i] * rs * mn[i] * sigmoidf_(p[i]);
            w.x = pk2(y[0], y[1]); w.y = pk2(y[2], y[3]);
            *(u32x2*)(Y + (size_t)(t + u) * DM + 256 + 4 * F.lane) = w;
        }
    }
}

__device__ __forceinline__ int crow(int reg, int h) { return (reg & 3) + 8 * (reg >> 2) + 4 * h; }
__device__ __forceinline__ void swa_phase(const Frame& F_in, int l, int blk0) {
    const Frame F = relaunder(F_in);
    unsigned char* const L_ws = WSP; const float* const L_sinks = IN_F(11); const bf16* const L_PROJ = (const bf16*)(L_ws + WS_BIG); bf16* const L_Y = (bf16*)(L_ws + WS_BIG + 176 * MiB); const float* const L_ROPE = (const float*)(L_ws + WS_ROPE);
    LAS bf16* Ks = (LAS bf16*)F.lds;
    LAS bf16* Vt = (LAS bf16*)(F.lds + 36864);
    const float* COS = L_ROPE; const float* SIN = L_ROPE + (size_t)M * 8;
    const int r = F.lane & 31, h = F.lane >> 5;
    for (int unit = (int)blockIdx.x - blk0; unit < 512; unit += F.G - blk0) {
        const int b = unit >> 6, kvh = (unit >> 5) & 1, nb = unit & 31;
        const int tok0 = b * SEQ + nb * 128;
        __syncthreads();
        {
            const int key = F.tid >> 1, half = F.tid & 1; const int tok = tok0 - 128 + key; const bool valid = (nb > 0) || (key >= 128);
            u32x4 kq[4], vq[4];
#pragma unroll
            for (int i = 0; i < 4; ++i) { kq[i] = (u32x4){0u, 0u, 0u, 0u}; vq[i] = (u32x4){0u, 0u, 0u, 0u}; }
            if (valid) {
                const bf16* ksrc = L_PROJ + (size_t)tok * NPROJ + 2560 + kvh * 64 + half * 32;
                const bf16* vsrc = L_PROJ + (size_t)tok * NPROJ + 2688 + kvh * 64 + half * 32;
#pragma unroll
                for (int i = 0; i < 4; ++i) { kq[i] = *(const u32x4*)(ksrc + 8 * i); vq[i] = *(const u32x4*)(vsrc + 8 * i); }
                if (half == 0) {
                    const f32x4 c0 = *(const f32x4*)(COS + (size_t)tok * 8), c1 = *(const f32x4*)(COS + (size_t)tok * 8 + 4);
                    const f32x4 s0 = *(const f32x4*)(SIN + (size_t)tok * 8), s1 = *(const f32x4*)(SIN + (size_t)tok * 8 + 4);
                    float x1[8], x2[8], cs[8], sn[8];
#pragma unroll
                    for (int i = 0; i < 4; ++i) { x1[2 * i] = lo_bf(kq[0][i]); x1[2 * i + 1] = hi_bf(kq[0][i]); x2[2 * i] = lo_bf(kq[1][i]); x2[2 * i + 1] = hi_bf(kq[1][i]); cs[i] = c0[i]; cs[4 + i] = c1[i]; sn[i] = s0[i]; sn[4 + i] = s1[i]; }
#pragma unroll
                    for (int i = 0; i < 4; ++i) {
                        kq[0][i] = pk2(x1[2 * i] * cs[2 * i] - x2[2 * i] * sn[2 * i], x1[2 * i + 1] * cs[2 * i + 1] - x2[2 * i + 1] * sn[2 * i + 1]);
                        kq[1][i] = pk2(x2[2 * i] * cs[2 * i] + x1[2 * i] * sn[2 * i], x2[2 * i + 1] * cs[2 * i + 1] + x1[2 * i + 1] * sn[2 * i + 1]); }
                }
            }
#pragma unroll
            for (int i = 0; i < 4; ++i) *(LAS u32x4*)(Ks + key * 72 + half * 32 + 8 * i) = kq[i];
#pragma unroll
            for (int i = 0; i < 4; ++i)
#pragma unroll
                for (int e = 0; e < 4; ++e) { const int d = half * 32 + 8 * i + 2 * e; Vt[d * 264 + key] = (bf16)(vq[i][e] & 0xffffu); Vt[(d + 1) * 264 + key] = (bf16)(vq[i][e] >> 16); }
        }
        __syncthreads();
        const int g = F.wave >> 1, qhalf = F.wave & 1, qh = kvh * 4 + g;
        const float sink = L_sinks[l * 8 + qh];
#pragma unroll 1
        for (int sub = 0; sub < 2; ++sub) {
            const int q0 = qhalf * 64 + sub * 32;
            const int qtok = tok0 + q0 + r;
            bf16x8 qf[4];
            {
                const bf16* qsrc = L_PROJ + (size_t)qtok * NPROJ + 2048 + qh * 64 + 8 * h;
                u32x4 qw[4];
#pragma unroll
                for (int ks = 0; ks < 4; ++ks) qw[ks] = *(const u32x4*)(qsrc + 16 * ks);
                const f32x4 c0 = *(const f32x4*)(COS + (size_t)qtok * 8), c1 = *(const f32x4*)(COS + (size_t)qtok * 8 + 4);
                const f32x4 s0 = *(const f32x4*)(SIN + (size_t)qtok * 8), s1 = *(const f32x4*)(SIN + (size_t)qtok * 8 + 4);
                float cs[8], sn[8];
#pragma unroll
                for (int i = 0; i < 4; ++i) { cs[i] = c0[i]; cs[4 + i] = c1[i]; sn[i] = s0[i]; sn[4 + i] = s1[i]; }
                u32x4 ow;
#pragma unroll
                for (int i = 0; i < 4; ++i) ow[i] = xshflu(qw[0][i], F.lane ^ 32);
                const float sg = h ? 1.0f : -1.0f;
#pragma unroll
                for (int i = 0; i < 4; ++i) {
                    const float a0 = lo_bf(qw[0][i]), a1 = hi_bf(qw[0][i]), b0 = lo_bf(ow[i]), b1 = hi_bf(ow[i]);
                    qw[0][i] = pk2((a0 * cs[2 * i] + sg * b0 * sn[2 * i]) * 0.125f, (a1 * cs[2 * i + 1] + sg * b1 * sn[2 * i + 1]) * 0.125f); }
#pragma unroll
                for (int ks = 1; ks < 4; ++ks)
#pragma unroll
                    for (int i = 0; i < 4; ++i) qw[ks][i] = pk2(lo_bf(qw[ks][i]) * 0.125f, hi_bf(qw[ks][i]) * 0.125f);
#pragma unroll
                for (int ks = 0; ks < 4; ++ks) qf[ks] = __builtin_bit_cast(bf16x8, qw[ks]);
            }
            f32x16 sc[5];
#pragma unroll
            for (int kb = 0; kb < 5; ++kb) {
                f32x16 a;
#pragma unroll
                for (int i = 0; i < 16; ++i) a[i] = 0.f;
#pragma unroll
                for (int ks = 0; ks < 4; ++ks) { const bf16x8 kf = *(const LAS bf16x8*)(Ks + (q0 + 32 * kb + r) * 72 + 16 * ks + 8 * h); a = __builtin_amdgcn_mfma_f32_32x32x16_bf16(kf, qf[ks], a, 0, 0, 0); }
                sc[kb] = a;
            }
            float mx = sink;
#pragma unroll
            for (int kb = 0; kb < 5; ++kb)
#pragma unroll
                for (int i = 0; i < 16; ++i) { const int kr = 32 * kb + crow(i, h); const bool ok = (kr > r) && (kr <= r + 128) && ((nb > 0) || (q0 + kr >= 128));
                    const float s = ok ? sc[kb][i] : -INFINITY; sc[kb][i] = s; mx = fmaxf(mx, s); }
            mx = fmaxf(mx, xshfl(mx, F.lane ^ 32));
            float ls = 0.f;
#pragma unroll
            for (int kb = 0; kb < 5; ++kb)
#pragma unroll
                for (int i = 0; i < 16; ++i) { const float p = __expf(sc[kb][i] - mx); sc[kb][i] = p; ls += p; }
            ls += xshfl(ls, F.lane ^ 32);
            ls += __expf(sink - mx);
            const float inv = __builtin_amdgcn_rcpf(ls);
            f32x16 o[2];
#pragma unroll
            for (int db = 0; db < 2; ++db) {
                f32x16 a;
#pragma unroll
                for (int i = 0; i < 16; ++i) a[i] = 0.f;
#pragma unroll
                for (int kb = 0; kb < 5; ++kb)
#pragma unroll
                    for (int s = 0; s < 2; ++s) {
                        u32x4 pw;
#pragma unroll
                        for (int i = 0; i < 4; ++i) pw[i] = pk2(sc[kb][8 * s + 2 * i], sc[kb][8 * s + 2 * i + 1]);
                        const LAS bf16* vb = Vt + (db * 32 + r) * 264 + q0 + 32 * kb + 16 * s + 4 * h;
                        const s16x4 lo = *(const LAS s16x4*)vb, hi = *(const LAS s16x4*)(vb + 8);
                        const bf16x8 vf = __builtin_shufflevector(lo, hi, 0, 1, 2, 3, 4, 5, 6, 7);
                        a = __builtin_amdgcn_mfma_f32_32x32x16_bf16(vf, __builtin_bit_cast(bf16x8, pw), a, 0, 0, 0);
                    }
                o[db] = a;
            }
            bf16* yp = L_Y + (size_t)qtok * DM + 512 + qh * 64;
#pragma unroll
            for (int db = 0; db < 2; ++db)
#pragma unroll
                for (int gg = 0; gg < 4; ++gg) { u32x2 w; w.x = pk2(o[db][4 * gg] * inv, o[db][4 * gg + 1] * inv); w.y = pk2(o[db][4 * gg + 2] * inv, o[db][4 * gg + 3] * inv);
                    *(u32x2*)(yp + db * 32 + 8 * gg + 4 * h) = w; }
        }
    }
    __syncthreads();
}

__device__ __forceinline__ void final_norm(const Frame& F_in) {
    const Frame F = relaunder(F_in);
    float* const L_out = OUTP; const float* const L_norm_final = IN_F(20);
    for (int m = F.gw; m < M; m += F.ngw) {
        f32x4* xr = (f32x4*)(L_out + (size_t)m * DM) + F.lane; const f32x4* gr = (const f32x4*)L_norm_final + F.lane;
        f32x4 v[4]; float s = 0.f;
#pragma unroll
        for (int j = 0; j < 4; ++j) { v[j] = xr[64 * j]; s += (v[j][0] * v[j][0] + v[j][1] * v[j][1]) + (v[j][2] * v[j][2] + v[j][3] * v[j][3]); }
        const float rs = 1.0f / sqrtf(wave_sum(s, F.lane) * (1.0f / DM) + EPS);
#pragma unroll
        for (int j = 0; j < 4; ++j) xr[64 * j] = v[j] * rs * gr[64 * j];
    }
}

#define RLX_AGENT __ATOMIC_RELAXED, __HIP_MEMORY_SCOPE_AGENT
#define XB_TMO      128
#define XB_XCNT(j)  (256  + 64 * (j))
#define XB_XSUB(j)  (1280 + 64 * (j))
#define XB_XGEN(j)  (2304 + 64 * (j))
#define XB_TOP      3328
#define XB_TOPGEN   3392
#define XCD_BAR_WORDS 3456
#define XB_SPIN_CAP (1u << 18)

__device__ __forceinline__ unsigned xb_ld(unsigned* p)              { return __hip_atomic_load(p, __ATOMIC_RELAXED, __HIP_MEMORY_SCOPE_AGENT); }
__device__ __forceinline__ unsigned xb_add(unsigned* p, unsigned v) { return __hip_atomic_fetch_add(p, v, __ATOMIC_RELAXED, __HIP_MEMORY_SCOPE_AGENT); }
__device__ __forceinline__ unsigned xb_xcc_id() { return (unsigned)__builtin_amdgcn_s_getreg((3 << 11) | 20) & 0xFu; }
#define XB_SPIN(cond, bar) do { unsigned _sp = 0; while (cond) { __builtin_amdgcn_s_sleep(1); \
    if ((++_sp & 255u) == 0u) { if (xb_ld(&(bar)[XB_TMO])) break; if (_sp > XB_SPIN_CAP) { atomicAdd(&(bar)[XB_TMO], 1u); break; } } } } while (0)

struct XcdBarrier {
    unsigned* bar; unsigned x;
    volatile LAS unsigned* st;
};

__device__ __forceinline__ XcdBarrier xcd_barrier_post(unsigned* bar, volatile LAS unsigned* st, bool leader) {
    XcdBarrier b; b.bar = bar; b.x = xb_xcc_id(); b.st = st;
    if (leader) (void)xb_add(&bar[XB_XCNT(b.x)], 1u);
    return b;
}
__device__ __forceinline__ void xcd_barrier_complete(unsigned* bar, unsigned x, unsigned& nloc, unsigned& nx) {
    const unsigned G = gridDim.x * gridDim.y * gridDim.z;
    unsigned sum, cnt, mine, sp = 0u;
    for (;;) {
        sum = 0u; cnt = 0u; mine = 0u;
#pragma unroll
        for (unsigned j = 0; j < 16; ++j) { const unsigned c = xb_ld(&bar[XB_XCNT(j)]); sum += c; cnt += (c > 0u) ? 1u : 0u; mine = (j == x) ? c : mine; }
        if (sum == G) break;
        __builtin_amdgcn_s_sleep(1);
        if ((++sp & 255u) == 0u) { if (xb_ld(&bar[XB_TMO])) break; if (sp > XB_SPIN_CAP) { atomicAdd(&bar[XB_TMO], 1u); break; } }
    }
    nloc = mine > 0u ? mine : 1u; nx = cnt > 0u ? cnt : 1u;
}

__device__ __forceinline__ void xcd_barrier(const XcdBarrier& b, bool leader) {
    asm volatile("s_waitcnt vmcnt(0)" ::: "memory");
    __syncthreads();
    if (leader) {
        unsigned* bar = b.bar;
        __builtin_amdgcn_s_waitcnt(0);
        unsigned nloc = b.st[0], nx = b.st[1];
        if (nloc == 0u) { xcd_barrier_complete(bar, b.x, nloc, nx); b.st[0] = nloc; b.st[1] = nx; }
        const unsigned old = xb_add(&bar[XB_XSUB(b.x)], 1u);
        const unsigned gen = old / nloc;
        if (old + 1u == (gen + 1u) * nloc) {
            __builtin_amdgcn_fence(__ATOMIC_RELEASE, "agent");
            asm volatile("s_waitcnt vmcnt(0)" ::: "memory");
            const unsigned og = xb_add(&bar[XB_TOP], 1u);
            const unsigned tg = og / nx;
            if (og + 1u == (tg + 1u) * nx) xb_add(&bar[XB_TOPGEN], 1u);
            else XB_SPIN(xb_ld(&bar[XB_TOPGEN]) == tg, bar);
            __builtin_amdgcn_fence(__ATOMIC_ACQUIRE, "agent");
            xb_add(&bar[XB_XGEN(b.x)], 1u);
            asm volatile("s_waitcnt vmcnt(0)" ::: "memory");
        } else {
            XB_SPIN(xb_ld(&bar[XB_XGEN(b.x)]) == gen, bar);
            __builtin_amdgcn_fence(__ATOMIC_ACQUIRE, "agent");
            asm volatile("s_waitcnt vmcnt(0)" ::: "memory");
        }
    }
    __syncthreads();
}

__device__ __forceinline__ void gbar(const Frame& F_in, int) {
    XcdBarrier b; b.bar = (unsigned*)(WSP + WS_MISC + 65536); b.x = xb_xcc_id(); b.st = (volatile LAS unsigned*)(F_in.lds + LDS_BYTES);
    int w_ = F_in.wave; asm volatile("" : "+s"(w_));
    xcd_barrier(b, w_ == 0 && lane_id_asm() == 0);
}

__global__ void __launch_bounds__(NTHR, 2) hybrid_fwd(Args args) {
    extern __shared__ __attribute__((aligned(16))) unsigned char lds[];
    cg::grid_group grid = cg::this_grid();
    Frame F;
    F.lds = (LAS unsigned char*)lds;
    F.wave = __builtin_amdgcn_readfirstlane((int)threadIdx.x >> 6); F.tid = 0; F.lane = 0;
    F.G = gridDim.x; F.gw = blockIdx.x * NWAVES + F.wave; F.ngw = F.G * NWAVES;

    volatile LAS unsigned* xst = (volatile LAS unsigned*)(F.lds + LDS_BYTES);
    if (threadIdx.x < 16) xst[threadIdx.x] = 0u;
    __syncthreads();
    const int xb = 0; (void)xcd_barrier_post((unsigned*)(WSP + WS_MISC + 65536), xst, F.wave == 0 && lane_id_asm() == 0);
    convert_weights(F, 0, F.gw, F.ngw);
    p0_prologue(F);
    grid.sync();
#pragma unroll 1
    for (int l = 0; l < NL; ++l) {
#pragma unroll 1
        for (int op = 0; op < 6; ++op) {
            if (op == 1) {
                gbar(F, xb);
                gdn_prep(F, l);
                mlstm_prep(F, l);
                swa_phase(F, l, 0);
                gbar(F, xb);
                {
                    int c = (int)blockIdx.x; asm volatile("" : "+s"(c));
                    if (F.wave == 0) {
                        if (c < 128) gdn_scan(F, ((c & 7) + 8 * (c >> 5)) * 4 + ((c >> 3) & 3));
                        else { const int q = c - 128, j = q >> 3; mlstm_scan(F, ((q & 7) + 8 * (j / 5)) * 5 + (j % 5)); }
                    } else if (F.wave == 2 && c < 32) { const int q = 128 + c, j = q >> 3; mlstm_scan(F, ((q & 7) + 8 * (j / 5)) * 5 + (j % 5)); }
                    else if (F.wave >= 4 && l + 1 < NL) convert_weights(F, l + 1, c * 4 + (F.wave - 4), F.G * 4);
                }
                gbar(F, xb);
                m2_post(F, l);
            }
            if (op != 5 && (l | op) != 0) gbar(F, xb);
            unsigned char* const ws = WSP; unsigned char* const wb = ws + WS_W + (size_t)(l & 1) * W_LAYER; float* const outp = OUTP;
            float* const ssq0 = (float*)(ws + WS_SSQ); float* const ssq1 = ssq0 + (size_t)M * 16; float* const ssq2 = ssq0 + (size_t)2 * M * 16;
            bf16* const xb = (bf16*)(ws + WS_XB); unsigned char* const big = ws + WS_BIG;
            pg8::Gemm g; pg8::EpiAny E; g.M = M;
            bf16* const xalt = (bf16*)(big + 192 * MiB);
            E.ssq_in = ssq0; E.ssq_out = ssq0; E.base = outp; E.xout = outp; E.ob = xb; E.pp = (const bf16*)big; E.gates = (float*)(ws + WS_GATES);
            if (op == 0)      { g.A = l == 0 ? xb : xalt; g.Bt = (const bf16*)(wb + WO_IN); g.N = NPAD; g.K = DM; E.mode = 0; E.ssq_in = ssq0; E.ob = (bf16*)big; }
            else if (op == 1) { g.A = (const bf16*)(big + 176 * MiB); g.Bt = (const bf16*)(wb + WO_OUT); g.N = DM; g.K = DM; E.mode = 3; E.ssq_out = ssq1; if (l == 0) E.base = IN_F(0); }
            else if (op == 2) { g.A = xb; g.Bt = (const bf16*)(wb + WO_UP); g.N = FF; g.K = DM; E.mode = 1; E.ssq_in = ssq1; E.ob = (bf16*)big; }
            else if (op == 3) { g.A = (const bf16*)big; g.Bt = (const bf16*)(wb + WO_DOWN); g.N = DM; g.K = FF; E.mode = 3; E.ssq_out = ssq2; }
            else if (op == 4) { g.A = (const bf16*)(ws + WS_PB); g.Bt = (const bf16*)(wb + WO_P); g.N = DM; g.K = PLE; E.mode = 2; E.ob = (bf16*)big; }
            else              { g.A = xb; g.Bt = (const bf16*)(wb + WO_G); g.N = DM; g.K = DM; E.mode = 4; E.ssq_in = ssq2; E.ssq_out = ssq0; E.ob = xalt; }
            pg8::StaticOrder S; S.init(M, g.N, F.G, (int)blockIdx.x);
#pragma unroll 1
            for (int rep = 0; rep < ((op == 0 || op == 2) ? REP_G : 1); ++rep)
            pg8::gemm_phase<pg8::EpiAny, pg8::StaticOrder, true, true>(F.lds, g, S, E, F.wave);
        }
    }
    gbar(F, xb);
    final_norm(F);
}

extern "C" void kernel_launch(void* const* d_in, const int* in_sizes, int n_in, void* d_out, int out_size, void* d_ws, size_t ws_size, hipStream_t stream) {
    static int grid = 0;
    if (grid == 0) {
        if (n_in != 21 || out_size != M * DM || ws_size < WS_END) { fprintf(stderr, "kernel_launch: unexpected shapes (n_in %d out %d ws %zu)\n", n_in, out_size, ws_size); grid = -1; return; }
        int dev = 0, cus = 0, per_cu = 0;
        hipGetDevice(&dev); hipDeviceGetAttribute(&cus, hipDeviceAttributeMultiprocessorCount, dev);
        hipFuncSetAttribute((const void*)hybrid_fwd, hipFuncAttributeMaxDynamicSharedMemorySize, LDS_BYTES + 64);
        hipOccupancyMaxActiveBlocksPerMultiprocessor(&per_cu, (const void*)hybrid_fwd, NTHR, LDS_BYTES + 64);
        (void)hipGetLastError();
        if (per_cu < 1) per_cu = 1;
        grid = cus;
        fprintf(stderr, "kernel_launch: cus %d per_cu %d grid %d ws %zu\n", cus, per_cu, grid, ws_size);
    }
    if (grid < 0) return;
    if (hipMemsetAsync((unsigned char*)d_ws + WS_MISC + 65536, 0, 16384, stream) != hipSuccess) { fprintf(stderr, "kernel_launch: memset failed\n"); return; }
    Args a{};
    for (int i = 0; i < 21; ++i) a.in[i] = d_in[i];
    a.out = (float*)d_out; a.ws = (unsigned char*)d_ws;
    void* kargs[] = {&a};
    hipError_t e = hipLaunchCooperativeKernel((const void*)hybrid_fwd, dim3(grid), dim3(NTHR), kargs, LDS_BYTES + 64, stream);
    if (e != hipSuccess) fprintf(stderr, "cooperative launch failed: %s (grid %d)\n", hipGetErrorString(e), grid);
}
```

```cpp
#include <hip/hip_runtime.h>
#include <hip/hip_cooperative_groups.h>
#include <cstdio>
#include <cstdint>
#include <cmath>
namespace pg8 {
#define PG8_LAS __attribute__((address_space(3)))
typedef unsigned short bf16_t;
typedef short bf16x8 __attribute__((ext_vector_type(8)));
typedef float f32x4 __attribute__((ext_vector_type(4)));
typedef unsigned u32x4 __attribute__((ext_vector_type(4)));
constexpr int BM = 256, BK = 64, HALF = 128, HTB = HALF * BK * 2  , STAGE_BYTES = 8 * HTB, NXCD = 8, WGM = 8;

__host__ __device__ __forceinline__ int lds_byte(int r, int c) { const int st = (r >> 4) * 2 + (c >> 5), rr = r & 15, cc = c & 31, ob = rr * 64 + cc * 2; return st * 1024 + (ob ^ (((ob >> 9) & 1) << 5)); }
__host__ __device__ __forceinline__ void stage_rc(int b, int& R, int& C) { const int st = b / 1024, sb = b % 1024, swz = sb ^ (((sb >> 9) & 1) << 5); R = (st >> 1) * 16 + swz / 64; C = (st & 1) * 32 + (swz % 64) / 2; }
__host__ __device__ __forceinline__ int perm32(int rho) { const int n = rho >> 4, i = rho & 15; return 8 * (i >> 2) + 4 * n + (i & 3); }

struct Unit { int pm, pn; };
struct Gemm { const bf16_t* A; const bf16_t* Bt; int M, N, K; };

struct StaticOrder {
    int nM, nN, nwg, G, c;
    __host__ __device__ void init(int M, int N, int G_, int c_) { nM = M / BM; nN = N / BM; nwg = nM * nN; G = G_; c = c_; }
    __host__ __device__ bool next(int i, Unit& u) const {
        const long L = (long)i * G + c; if (L >= nwg) return false;
        int wgid = (int)L; { const int q = nwg / NXCD, r = nwg % NXCD, xcd = wgid % NXCD, off = wgid / NXCD; wgid = (xcd < r ? xcd * (q + 1) : r * (q + 1) + (xcd - r) * q) + off; }
        const int nig = WGM * nN, gid = wgid / nig, fm = gid * WGM, gsz = (nM - fm) < WGM ? (nM - fm) : WGM;
        u.pm = fm + ((wgid % nig) % gsz); u.pn = (wgid % nig) / gsz; return true;
    }
    __device__ __forceinline__ void a_ready(const Unit&) const {}
    __device__ __forceinline__ void done(const Unit&) const {}
};


__device__ __forceinline__ unsigned cvt_pk_bf16(float lo, float hi) { unsigned r; asm volatile("v_cvt_pk_bf16_f32 %0, %1, %2" : "=v"(r) : "v"(lo), "v"(hi)); return r; }
typedef unsigned u32x2 __attribute__((ext_vector_type(2)));
constexpr float RMS_EPS = 1e-6f;
__device__ __forceinline__ float row_rstd(const float* ssq, int row) {
    const f32x4* p = (const f32x4*)(ssq + (size_t)row * 16);
    const f32x4 a = p[0], b = p[1], c = p[2], d = p[3];
    const float s = ((a[0] + a[1]) + (a[2] + a[3])) + ((b[0] + b[1]) + (b[2] + b[3])) + ((c[0] + c[1]) + (c[2] + c[3])) + ((d[0] + d[1]) + (d[2] + d[3]));
    return __builtin_amdgcn_rsqf(s * (1.0f / 1024.0f) + RMS_EPS);
}
struct EpiAny {
    static constexpr bool PERM = true, AFTER_DRAIN = false;
    int mode; const float* ssq_in; float* ssq_out; const float* base; float* xout; bf16_t* ob; const bf16_t* pp; float* gates;
    __device__ __forceinline__ void operator()(const f32x4 (&acc)[2][2][4][2], const Unit& u, int wr, int wc, int fr, int fq) const {
        const int row0 = u.pm * BM + wr * 64 + fr; const int col0 = u.pn * BM + wc * 32 + 8 * fq;
        if (mode <= 1) {
            const int ld = mode == 0 ? 2816 : 4096;
            if (mode == 1 || u.pn < 11) {
#pragma unroll
                for (int ai = 0; ai < 2; ++ai)
#pragma unroll
                    for (int m = 0; m < 4; ++m) { const int row = row0 + ai * HALF + m * 16; const float rs = row_rstd(ssq_in, row); bf16_t* rowp = ob + (size_t)row * ld + col0;
#pragma unroll
                        for (int bj = 0; bj < 2; ++bj) { f32x4 v0 = acc[ai][bj][m][0] * rs, v1 = acc[ai][bj][m][1] * rs;
                            if (mode == 1) {
#pragma unroll
                                for (int e = 0; e < 4; ++e) { const float a = fmaxf(v0[e], 0.f), b = fmaxf(v1[e], 0.f); v0[e] = a * a; v1[e] = b * b; } }
                            u32x4 w; w.x = cvt_pk_bf16(v0[0], v0[1]); w.y = cvt_pk_bf16(v0[2], v0[3]); w.z = cvt_pk_bf16(v1[0], v1[1]); w.w = cvt_pk_bf16(v1[2], v1[3]);
                            *(u32x4*)(rowp + bj * HALF) = w; }
                        asm volatile("" ::: "memory"); }
            } else if (wc == 0 && fq < 2) {
#pragma unroll
                for (int ai = 0; ai < 2; ++ai)
#pragma unroll
                    for (int m = 0; m < 4; ++m) { const int row = row0 + ai * HALF + m * 16; const float rs = row_rstd(ssq_in, row); float* gp = gates + (size_t)row * 16 + 8 * fq;
                        *(f32x4*)(gp) = acc[ai][0][m][0] * rs; *(f32x4*)(gp + 4) = acc[ai][0][m][1] * rs; asm volatile("" ::: "memory"); }
            }
        } else if (mode == 2) {
#pragma unroll
            for (int ai = 0; ai < 2; ++ai)
#pragma unroll
                for (int m = 0; m < 4; ++m) { bf16_t* rowp = ob + (size_t)(row0 + ai * HALF + m * 16) * 1024 + col0;
#pragma unroll
                    for (int bj = 0; bj < 2; ++bj) { const f32x4 v0 = acc[ai][bj][m][0], v1 = acc[ai][bj][m][1];
                        u32x4 w; w.x = cvt_pk_bf16(v0[0], v0[1]); w.y = cvt_pk_bf16(v0[2], v0[3]); w.z = cvt_pk_bf16(v1[0], v1[1]); w.w = cvt_pk_bf16(v1[2], v1[3]);
                        *(u32x4*)(rowp + bj * HALF) = w; }
                    asm volatile("" ::: "memory"); }
        } else {
#pragma unroll
            for (int ai = 0; ai < 2; ++ai)
#pragma unroll
                for (int m = 0; m < 4; ++m) { const int row = row0 + ai * HALF + m * 16; const size_t off = (size_t)row * 1024 + col0;
                    const float* bp = base + off; float* xp = xout + off; bf16_t* op = ob + off; const bf16_t* ppp = pp + off;
                    float rs = 1.f; if (mode == 4) rs = row_rstd(ssq_in, row);
                    float s = 0.f;
#pragma unroll
                    for (int bj = 0; bj < 2; ++bj) {
                        f32x4 a0 = acc[ai][bj][m][0], a1 = acc[ai][bj][m][1];
                        const f32x4 b0 = *(const f32x4*)(bp + bj * HALF), b1 = *(const f32x4*)(bp + bj * HALF + 4);
                        if (mode == 4) { const u32x4 pw = *(const u32x4*)(ppp + bj * HALF);
                            const f32x4 p0 = (f32x4){__uint_as_float(pw.x << 16), __uint_as_float(pw.x & 0xffff0000u), __uint_as_float(pw.y << 16), __uint_as_float(pw.y & 0xffff0000u)}, p1 = (f32x4){__uint_as_float(pw.z << 16), __uint_as_float(pw.z & 0xffff0000u), __uint_as_float(pw.w << 16), __uint_as_float(pw.w & 0xffff0000u)};
#pragma unroll
                            for (int e = 0; e < 4; ++e) { a0[e] = p0[e] * __builtin_amdgcn_rcpf(1.0f + __expf(-a0[e] * rs)); a1[e] = p1[e] * __builtin_amdgcn_rcpf(1.0f + __expf(-a1[e] * rs)); } }
                        const f32x4 o0 = b0 + a0, o1 = b1 + a1;
                        *(f32x4*)(xp + bj * HALF) = o0; *(f32x4*)(xp + bj * HALF + 4) = o1;
                        u32x4 w; w.x = cvt_pk_bf16(o0[0], o0[1]); w.y = cvt_pk_bf16(o0[2], o0[3]); w.z = cvt_pk_bf16(o1[0], o1[1]); w.w = cvt_pk_bf16(o1[2], o1[3]);
                        *(u32x4*)(op + bj * HALF) = w;
                        s += ((o0[0] * o0[0] + o0[1] * o0[1]) + (o0[2] * o0[2] + o0[3] * o0[3])) + ((o1[0] * o1[0] + o1[1] * o1[1]) + (o1[2] * o1[2] + o1[3] * o1[3])); }
                    s += __int_as_float(__builtin_amdgcn_ds_bpermute(((fq ^ 1) * 16 + fr) << 2, __float_as_int(s))); s += __int_as_float(__builtin_amdgcn_ds_bpermute(((fq ^ 2) * 16 + fr) << 2, __float_as_int(s)));
                    if (fq == 0) ssq_out[(size_t)row * 16 + u.pn * 4 + wc] = s;
                    asm volatile("" ::: "memory"); }
        }
    }
};

template <class Epi, class Sched, bool ALIGN_EPI = false, bool SP2 = false>
__device__ __forceinline__ void gemm_phase(PG8_LAS unsigned char* lds, const Gemm g, const Sched& S, const Epi& E, int wave_id) {
    int tid_; asm volatile("v_mbcnt_lo_u32_b32 %0, -1, 0\n\tv_mbcnt_hi_u32_b32 %0, -1, %0" : "=v"(tid_)); tid_ += wave_id * 64; const int tid = tid_, wid = __builtin_amdgcn_readfirstlane(tid >> 6), lane = tid & 63, wr = wid >> 2, wc = wid & 3, fr = lane & 15, fq = lane >> 4;
    const int K = g.K, nt = K / BK;
    unsigned voffA[2], voffB[2];
#pragma unroll
    for (int i = 0; i < 2; ++i) { int R, C; stage_rc(tid * 16 + i * 8192, R, C); const int Rb = Epi::PERM ? ((R & ~31) + perm32(R & 31)) : R;
        voffA[i] = (unsigned)(R * K + C) * 2u; voffB[i] = (unsigned)(Rb * K + C) * 2u; }
    const size_t kstep = (size_t)(BK * 2);
    const size_t hstep = (size_t)HALF * K * 2;
    const size_t tstep = 2 * hstep;
    const unsigned ldsw = (unsigned)wid * 1024u;
    const int aoff = lds_byte(wr * 64 + fr, fq * 8), boff = lds_byte(wc * 32 + fr, fq * 8);
#define PG8_SA(b, h) (((b) * 2 + (h)) * HTB)
#define PG8_SB(b, h) ((4 + (b) * 2 + (h)) * HTB)
#define PG8_STAGE(bufoff, gbase, voff) do { _Pragma("unroll") for (int _i = 0; _i < 2; ++_i) \
        __builtin_amdgcn_global_load_lds((const unsigned*)((const char*)(gbase) + (voff)[_i]), (PG8_LAS unsigned*)(lds + (bufoff) + ldsw + _i * 8192), 16, 0, 0); } while (0)
#define PG8_LDA(dst, b, h) do { _Pragma("unroll") for (int m = 0; m < 4; ++m) _Pragma("unroll") for (int k = 0; k < 2; ++k) dst[m][k] = *(const PG8_LAS bf16x8*)(lds + PG8_SA(b, h) + aoff + m * 2048 + k * 1024); } while (0)
#define PG8_LDB(dst, b, h) do { _Pragma("unroll") for (int n = 0; n < 2; ++n) _Pragma("unroll") for (int k = 0; k < 2; ++k) dst[n][k] = *(const PG8_LAS bf16x8*)(lds + PG8_SB(b, h) + boff + n * 2048 + k * 1024); } while (0)
#define PG8_MMA(ai, bj, At, Bt) do { __builtin_amdgcn_s_setprio(1); _Pragma("unroll") for (int m = 0; m < 4; ++m) _Pragma("unroll") for (int n = 0; n < 2; ++n) _Pragma("unroll") for (int k = 0; k < 2; ++k) \
        acc[ai][bj][m][n] = __builtin_amdgcn_mfma_f32_16x16x32_bf16(Bt[n][k], At[m][k], acc[ai][bj][m][n], 0, 0, 0); __builtin_amdgcn_s_setprio(0); } while (0)
#define PG8_WAIT_V(n) asm volatile("s_waitcnt vmcnt(" #n ")" ::: "memory")
#define PG8_WAIT_L(n) asm volatile("s_waitcnt lgkmcnt(" #n ")" ::: "memory")
#define PG8_BAR __builtin_amdgcn_s_barrier()
#define PG8_SCHED __builtin_amdgcn_sched_barrier(0)
    Unit cur, nxt; int ui = 0;
    if (!S.next(0, cur)) return;
    f32x4 acc[2][2][4][2];
#pragma unroll
    for (int a = 0; a < 2; ++a)
#pragma unroll
        for (int b = 0; b < 2; ++b)
#pragma unroll
            for (int m = 0; m < 4; ++m)
#pragma unroll
                for (int n = 0; n < 2; ++n) acc[a][b][m][n] = (f32x4){0.f, 0.f, 0.f, 0.f};
    bf16x8 At[4][2], B0[2][2], B1[2][2];
    const char* cA = (const char*)g.A + (size_t)cur.pm * tstep; const char* cB = (const char*)g.Bt + (size_t)cur.pn * tstep;
    S.a_ready(cur);
    if constexpr (SP2) {
        PG8_STAGE(PG8_SB(0, 0), cB, voffB); PG8_STAGE(PG8_SB(0, 1), cB + hstep, voffB); PG8_STAGE(PG8_SA(0, 0), cA, voffA); PG8_STAGE(PG8_SA(0, 1), cA + hstep, voffA);
        if (wr == 1) PG8_BAR;
        PG8_WAIT_V(2); PG8_BAR;
        PG8_STAGE(PG8_SB(1, 0), cB + kstep, voffB); PG8_STAGE(PG8_SA(1, 0), cA + kstep, voffA); PG8_STAGE(PG8_SB(1, 1), cB + hstep + kstep, voffB);
        PG8_WAIT_V(6); PG8_BAR;
    } else {
        PG8_STAGE(PG8_SB(0, 0), cB, voffB); PG8_STAGE(PG8_SA(0, 0), cA, voffA); PG8_STAGE(PG8_SB(0, 1), cB + hstep, voffB); PG8_STAGE(PG8_SA(0, 1), cA + hstep, voffA);
        if (wr == 1) PG8_BAR;
        PG8_WAIT_V(4); PG8_BAR;
        PG8_STAGE(PG8_SB(1, 0), cB + kstep, voffB); PG8_STAGE(PG8_SA(1, 0), cA + kstep, voffA); PG8_STAGE(PG8_SB(1, 1), cB + hstep + kstep, voffB);
        PG8_WAIT_V(6); PG8_BAR;
    }
    for (;;) {
        const bool has_next = S.next(ui + 1, nxt);
        const char* nA = has_next ? (const char*)g.A + (size_t)nxt.pm * tstep : cA; const char* nB = has_next ? (const char*)g.Bt + (size_t)nxt.pn * tstep : cB;
        for (int t = 0; t < nt; t += 2) {
            const bool last = (t == nt - 2);
            const char* a1 = cA + (size_t)(t + 1) * kstep;
            const char* a2 = last ? nA : cA + (size_t)(t + 2) * kstep; const char* b2 = last ? nB : cB + (size_t)(t + 2) * kstep;
            const char* a3 = a2 + kstep; const char* b3 = b2 + kstep;
            if (last && has_next) S.a_ready(nxt);
            if constexpr (SP2) {
            PG8_LDB(B0, 0, 0); PG8_LDB(B1, 0, 1); PG8_SCHED; PG8_LDA(At, 0, 0); PG8_STAGE(PG8_SA(1, 1), a1 + hstep, voffA);
            PG8_WAIT_V(8); PG8_WAIT_L(0); PG8_BAR; PG8_MMA(0, 0, At, B0); PG8_MMA(0, 1, At, B1); PG8_BAR; PG8_SCHED;
            PG8_LDA(At, 0, 1); PG8_STAGE(PG8_SB(0, 0), b2, voffB); PG8_STAGE(PG8_SB(0, 1), b2 + hstep, voffB); PG8_STAGE(PG8_SA(0, 0), a2, voffA);
            PG8_WAIT_V(8); PG8_WAIT_L(0); PG8_BAR; PG8_MMA(1, 0, At, B0); PG8_MMA(1, 1, At, B1); PG8_BAR; PG8_SCHED;
            PG8_LDB(B0, 1, 0); PG8_LDB(B1, 1, 1); PG8_SCHED; PG8_LDA(At, 1, 0); PG8_STAGE(PG8_SA(0, 1), a2 + hstep, voffA);
            PG8_WAIT_V(8); PG8_WAIT_L(0); PG8_BAR; PG8_MMA(0, 0, At, B0); PG8_MMA(0, 1, At, B1); PG8_BAR; PG8_SCHED;
            PG8_LDA(At, 1, 1); PG8_STAGE(PG8_SB(1, 0), b3, voffB); PG8_STAGE(PG8_SB(1, 1), b3 + hstep, voffB); PG8_STAGE(PG8_SA(1, 0), a3, voffA);
            PG8_WAIT_V(8); PG8_WAIT_L(0); PG8_BAR; PG8_MMA(1, 0, At, B0); PG8_MMA(1, 1, At, B1); PG8_BAR; PG8_SCHED;
            } else {
            PG8_LDB(B0, 0, 0); PG8_SCHED; PG8_LDA(At, 0, 0); PG8_STAGE(PG8_SA(1, 1), a1 + hstep, voffA);
            PG8_WAIT_L(8); PG8_BAR; PG8_WAIT_L(0); PG8_MMA(0, 0, At, B0); PG8_BAR; PG8_SCHED;
            PG8_LDB(B1, 0, 1); PG8_STAGE(PG8_SB(0, 0), b2, voffB);
            PG8_BAR; PG8_WAIT_L(0); PG8_MMA(0, 1, At, B1); PG8_BAR;
            PG8_LDA(At, 0, 1); PG8_STAGE(PG8_SA(0, 0), a2, voffA);
            PG8_BAR; PG8_WAIT_L(0); PG8_MMA(1, 0, At, B0); PG8_BAR; PG8_SCHED;
            PG8_STAGE(PG8_SB(0, 1), b2 + hstep, voffB);
            PG8_WAIT_V(6); PG8_BAR; PG8_MMA(1, 1, At, B1); PG8_BAR;
            PG8_LDB(B0, 1, 0); PG8_SCHED; PG8_LDA(At, 1, 0); PG8_STAGE(PG8_SA(0, 1), a2 + hstep, voffA);
            PG8_WAIT_L(8); PG8_BAR; PG8_WAIT_L(0); PG8_MMA(0, 0, At, B0); PG8_BAR; PG8_SCHED;
            PG8_LDB(B1, 1, 1); PG8_STAGE(PG8_SB(1, 0), b3, voffB);
            PG8_BAR; PG8_WAIT_L(0); PG8_MMA(0, 1, At, B1); PG8_BAR;
            PG8_LDA(At, 1, 1); PG8_STAGE(PG8_SA(1, 0), a3, voffA);
            PG8_BAR; PG8_WAIT_L(0); PG8_MMA(1, 0, At, B0); PG8_BAR; PG8_SCHED;
            PG8_STAGE(PG8_SB(1, 1), b3 + hstep, voffB);
            PG8_WAIT_V(6); PG8_BAR; PG8_MMA(1, 1, At, B1); PG8_BAR;
            }
        }
        if constexpr (ALIGN_EPI) { if (wr == 0) PG8_BAR; }
        if constexpr (!Epi::AFTER_DRAIN) { E(acc, cur, wr, wc, fr, fq); S.done(cur); }
        if (!has_next) break;
#pragma unroll
        for (int a = 0; a < 2; ++a)
#pragma unroll
            for (int b = 0; b < 2; ++b)
#pragma unroll
                for (int m = 0; m < 4; ++m)
#pragma unroll
                    for (int n = 0; n < 2; ++n) acc[a][b][m][n] = (f32x4){0.f, 0.f, 0.f, 0.f};
        cur = nxt; cA = nA; cB = nB; ++ui;
        if constexpr (ALIGN_EPI) { if (wr == 1) PG8_BAR; }
    }
    PG8_WAIT_V(0);
    if constexpr (!ALIGN_EPI) { if (wr == 0) PG8_BAR; }
    PG8_BAR;
    if constexpr (Epi::AFTER_DRAIN) { E.fused(acc, cur, wr, wc, fr, fq, lds, wid, lane); S.done(cur); }
#undef PG8_SA
#undef PG8_SB
#undef PG8_STAGE
#undef PG8_LDA
#undef PG8_LDB
#undef PG8_MMA
#undef PG8_WAIT_V
#undef PG8_WAIT_L
#undef PG8_BAR
#undef PG8_SCHED
}
}

namespace cg = cooperative_groups;
#define LAS __attribute__((address_space(3)))
typedef unsigned short bf16;
typedef float f32x4 __attribute__((ext_vector_type(4)));
typedef float f32x16 __attribute__((ext_vector_type(16)));
typedef short bf16x8 __attribute__((ext_vector_type(8)));
typedef short s16x4 __attribute__((ext_vector_type(4)));
typedef unsigned u32x4 __attribute__((ext_vector_type(4)));
typedef unsigned u32x2 __attribute__((ext_vector_type(2)));

constexpr int NWAVES = 8, NTHR = 512;
constexpr int BATCH = 8, SEQ = 4096, DM = 1024, M = BATCH * SEQ, NL = 4, FF = 4096, PLE = 256;
constexpr int NPROJ = 2816, NPAD = 3072, INC = 2832;
constexpr float EPS = 1e-6f;
constexpr int LDS_BYTES = 147456;
constexpr int PF_D = 4;
constexpr int REP_MIX = 1, REP_G = 1, REP_BAR = 1, REP_P1 = 1, REP_P2 = 2, REP_P3 = 1;

constexpr size_t MiB = 1u << 20;
constexpr size_t W_LAYER = 27 * MiB;
constexpr size_t WO_IN = 0, WO_OUT = 6 * MiB, WO_UP = 8 * MiB, WO_DOWN = 16 * MiB, WO_G = 24 * MiB, WO_P = 26 * MiB;
constexpr size_t WS_W = 0;
constexpr size_t WS_XB = 108 * MiB;
constexpr size_t WS_SSQ = 172 * MiB;
constexpr size_t WS_ROPE = 178 * MiB;
constexpr size_t WS_GATES = 180 * MiB;
constexpr size_t WS_PB = 182 * MiB;
constexpr size_t WS_QKVC = 198 * MiB;
constexpr size_t WS_BIG = 246 * MiB;
constexpr size_t WS_MISC = 502 * MiB;
constexpr size_t WS_END = 503 * MiB;
constexpr size_t WS_MLB = WS_XB;
constexpr int GU_W = 0, GU_QD = 4096, GU_KD = 8192, GU_U = 12288, GU_QK = 16384, GU_STRIDE = 19456;
constexpr int GDN_NA = 1724;
constexpr int WAVE_LDS = 18432;
constexpr int MU_QB = 0, MU_PT = 4096, MU_KW = 8192, MU_VB = 12288, MU_STRIDE = 16384;

struct Args { const void* in[21]; float* out; unsigned char* ws; };

struct Frame {
    LAS unsigned char* lds;
    int tid, lane, wave, G, gw, ngw;
};
typedef const __attribute__((address_space(4))) void* kptr_t;
__device__ __forceinline__ const void* karg(int i) {
    kptr_t kp = (kptr_t)__builtin_amdgcn_kernarg_segment_ptr();
    asm volatile("" : "+s"(kp));
    return ((const void* const __attribute__((address_space(4)))*)kp)[i];
}
__device__ __forceinline__ int lane_id_asm();
__device__ __forceinline__ Frame relaunder(const Frame& f) {
    Frame r = f;
    r.lane = lane_id_asm(); r.tid = r.wave * 64 + r.lane;
    asm volatile("" : "+v"(r.tid), "+v"(r.lane));
    asm volatile("" : "+s"(r.wave), "+s"(r.gw), "+s"(r.ngw), "+s"(r.G));
    return r;
}
#define IN_F(i) ((const float*)karg(i))
#define OUTP ((float*)karg(21))
#define WSP ((unsigned char*)karg(22))

__device__ __forceinline__ float bf2f(unsigned short b) { return __uint_as_float((unsigned)b << 16); }
typedef float f32x2_t __attribute__((ext_vector_type(2))); typedef __bf16 bf16x2_t __attribute__((ext_vector_type(2)));
__device__ __forceinline__ unsigned pk2(float lo, float hi) { f32x2_t v = {lo, hi}; bf16x2_t b = __builtin_convertvector(v, bf16x2_t); return __builtin_bit_cast(unsigned, b); }
__device__ __forceinline__ unsigned f2bf(float f) { return pk2(f, 0.f) & 0xffffu; }
__device__ __forceinline__ float lo_bf(unsigned w) { return __uint_as_float(w << 16); }
__device__ __forceinline__ float hi_bf(unsigned w) { return __uint_as_float(w & 0xffff0000u); }
__device__ __forceinline__ int lane_id_asm() { int l; asm volatile("v_mbcnt_lo_u32_b32 %0, -1, 0\n\tv_mbcnt_hi_u32_b32 %0, -1, %0" : "=v"(l)); return l; }
__device__ __forceinline__ float xshfl(float v, int src_lane) { return __int_as_float(__builtin_amdgcn_ds_bpermute(src_lane << 2, __float_as_int(v))); }
__device__ __forceinline__ unsigned xshflu(unsigned v, int src_lane) { return (unsigned)__builtin_amdgcn_ds_bpermute(src_lane << 2, (int)v); }
__device__ __forceinline__ float wave_sum(float v, int lane) {
#pragma unroll
    for (int o = 1; o < 64; o <<= 1) v += xshfl(v, lane ^ o);
    return v;
}
#define LDS_WAIT() asm volatile("s_waitcnt lgkmcnt(0)" ::: "memory")
__device__ __forceinline__ float sigmoidf_(float x) { return __builtin_amdgcn_rcpf(1.0f + __expf(-x)); }
__device__ __forceinline__ float softplusf_(float x) { return fmaxf(x, 0.f) + log1pf(__expf(-fabsf(x))); }
__device__ __forceinline__ float sum8(float v) {
    v += __int_as_float(__builtin_amdgcn_update_dpp(0, __float_as_int(v), 0xB1, 0xF, 0xF, true));
    v += __int_as_float(__builtin_amdgcn_update_dpp(0, __float_as_int(v), 0x4E, 0xF, 0xF, true));
    v += __int_as_float(__builtin_amdgcn_update_dpp(0, __float_as_int(v), 0x141, 0xF, 0xF, true));
    return v;
}

__device__ __forceinline__ int win_src_col(int n) {
    if (n < 1024) return n;
    if (n < 2048) return n + 8;
    if (n < 2816) return n + 16;
    if (n < 2824) return 1024 + (n - 2816);
    if (n < 2832) return 2056 + (n - 2824);
    return -1;
}
template <int MAP>
__device__ __forceinline__ void transpose_item(const float* W, int K, int N, bf16* WT, const float* gain, LAS float* scr, int kb, int nb, int lane) {
    const int k0 = 64 * kb, n0 = 32 * nb;
    const int nd = n0 + (lane & 31);
    const int ns = MAP ? win_src_col(nd) : nd;
#pragma unroll 8
    for (int i = 0; i < 32; ++i) { const int kk = 2 * i + (lane >> 5); float v = 0.f; if (ns >= 0) v = W[(size_t)(k0 + kk) * N + ns]; if (gain) v *= gain[k0 + kk]; scr[kk * 33 + (lane & 31)] = v; }
    LDS_WAIT(); asm volatile("" ::: "memory");
    const int c = lane & 7;
#pragma unroll
    for (int j = 0; j < 4; ++j) { const int n = (lane >> 3) + 8 * j; const LAS float* s = scr + (8 * c) * 33 + n;
        u32x4 o; o.x = pk2(s[0 * 33], s[1 * 33]); o.y = pk2(s[2 * 33], s[3 * 33]); o.z = pk2(s[4 * 33], s[5 * 33]); o.w = pk2(s[6 * 33], s[7 * 33]);
        *(u32x4*)(WT + (size_t)(n0 + n) * K + k0 + 8 * c) = o; }
    LDS_WAIT(); asm volatile("" ::: "memory");
}
__device__ __forceinline__ void convert_weights(const Frame& F_in, int l, int idx, int nidx) {
    const Frame F = relaunder(F_in);
    unsigned char* const L_ws = WSP; const float* const L_w_in = IN_F(3); const float* const L_w_out = IN_F(12); const float* const L_w_up = IN_F(15); const float* const L_w_down = IN_F(16); const float* const L_w_g = IN_F(18); const float* const L_w_p = IN_F(19);
    const float* const L_norm_mix = IN_F(13); const float* const L_norm_mlp = IN_F(14); const float* const L_norm_ple = IN_F(17);
    LAS float* scr = (LAS float*)(F.lds + F.wave * 16384);
    constexpr int I_IN = 16 * 96, I_OUT = 16 * 32, I_UP = 16 * 128, I_DOWN = 64 * 32, I_G = 16 * 32, I_P = 4 * 32;
    constexpr int I_LAYER = I_IN + I_OUT + I_UP + I_DOWN + I_G + I_P;
    unsigned char* wb = L_ws + WS_W + (size_t)(l & 1) * W_LAYER;
    for (int it = idx; it < I_LAYER; it += nidx) {
        int r = it;
        if (r < I_IN) { transpose_item<1>(L_w_in + (size_t)l * DM * INC, DM, INC, (bf16*)(wb + WO_IN), L_norm_mix + l * DM, scr, r / 96, r % 96, F.lane); continue; } r -= I_IN;
        if (r < I_OUT) { transpose_item<0>(L_w_out + (size_t)l * DM * DM, DM, DM, (bf16*)(wb + WO_OUT), nullptr, scr, r / 32, r % 32, F.lane); continue; } r -= I_OUT;
        if (r < I_UP) { transpose_item<0>(L_w_up + (size_t)l * DM * FF, DM, FF, (bf16*)(wb + WO_UP), L_norm_mlp + l * DM, scr, r / 128, r % 128, F.lane); continue; } r -= I_UP;
        if (r < I_DOWN) { transpose_item<0>(L_w_down + (size_t)l * FF * DM, FF, DM, (bf16*)(wb + WO_DOWN), nullptr, scr, r / 32, r % 32, F.lane); continue; } r -= I_DOWN;
        if (r < I_G) { transpose_item<0>(L_w_g + (size_t)l * DM * DM, DM, DM, (bf16*)(wb + WO_G), L_norm_ple + l * DM, scr, r / 32, r % 32, F.lane); continue; } r -= I_G;
        transpose_item<0>(L_w_p + (size_t)l * PLE * DM, PLE, DM, (bf16*)(wb + WO_P), nullptr, scr, r / 32, r % 32, F.lane);
    }
}
__device__ __forceinline__ void p0_prologue(const Frame& F_in) {
    const Frame F = relaunder(F_in);
    unsigned char* const L_ws = WSP; const float* const L_in_x = IN_F(0); const int* const L_in_pos = (const int*)karg(2);
    bf16* const L_XB = (bf16*)(L_ws + WS_XB); float* const L_SSQ = (float*)(L_ws + WS_SSQ); float* const L_ROPE = (float*)(L_ws + WS_ROPE);
    for (int m0 = F.gw; m0 < M; m0 += 2 * F.ngw) {
        f32x4 v[2][4];
#pragma unroll
        for (int q = 0; q < 2; ++q) { const f32x4* xr = (const f32x4*)(L_in_x + (size_t)(m0 + q * F.ngw) * DM) + F.lane;
#pragma unroll
            for (int j = 0; j < 4; ++j) v[q][j] = xr[64 * j]; }
#pragma unroll
        for (int q = 0; q < 2; ++q) { const int m = m0 + q * F.ngw; float s = 0.f;
            unsigned long long* o8 = (unsigned long long*)(L_XB + (size_t)m * DM) + F.lane;
#pragma unroll
            for (int j = 0; j < 4; ++j) { const f32x4 w = v[q][j]; s += (w[0] * w[0] + w[1] * w[1]) + (w[2] * w[2] + w[3] * w[3]);
                o8[64 * j] = (unsigned long long)pk2(w[0], w[1]) | ((unsigned long long)pk2(w[2], w[3]) << 32); }
            s = wave_sum(s, F.lane);
            if (F.lane < 16) L_SSQ[(size_t)m * 16 + F.lane] = (F.lane == 0) ? s : 0.f; }
    }
    for (int i = F.gw * 64 + F.lane; i < M * 8; i += F.ngw * 64) {
        const int t = i >> 3, j = i & 7;
        const float inv = (float)exp(-(double)(2 * j) / 16.0 * 13.122363377404328);
        const float ang = (float)L_in_pos[t] * inv;
        const double a = (double)ang; const double rev = a * 0.15915494309189535; const double fr = rev - floor(rev + 0.5);
        const float rad = (float)(fr * 6.283185307179586);
        L_ROPE[i] = cosf(rad); L_ROPE[(size_t)M * 8 + i] = sinf(rad);
    }
}

#define MFMA16(a, b, c) __builtin_amdgcn_mfma_f32_16x16x32_bf16((a), (b), (c), 0, 0, 0)
__device__ __forceinline__ int kperm(int ks, int g, int j) { return 32 * ks + 16 * (j >> 2) + 4 * g + (j & 3); }
__device__ __forceinline__ bf16x8 pack_tiles(const f32x4& a, const f32x4& b) { u32x4 w; w.x = pk2(a[0], a[1]); w.y = pk2(a[2], a[3]); w.z = pk2(b[0], b[1]); w.w = pk2(b[2], b[3]); return __builtin_bit_cast(bf16x8, w); }

__device__ __forceinline__ bf16* gdn_ubuf(unsigned char* ws, int unit) {
    return unit < GDN_NA ? (bf16*)(ws + WS_PB) + (size_t)unit * GU_STRIDE : (bf16*)(ws + WS_BIG + 240 * MiB) + (size_t)(unit - GDN_NA) * GU_STRIDE;
}
__device__ __forceinline__ int qk_idx(int tt, int ks) { return tt < 2 ? tt : 2 + (tt - 2) * 2 + ks; }
__device__ __forceinline__ bf16x8 conv8(const bf16* PROJ, size_t tok, int sp, int ch0, const f32x4 (&w)[4][2]) {
    float a[8];
#pragma unroll
    for (int j = 0; j < 8; ++j) a[j] = 0.f;
#pragma unroll
    for (int tap = 0; tap < 4; ++tap) if (sp - 3 + tap >= 0) {
        const u32x4 raw = *(const u32x4*)(PROJ + (tok - 3 + tap) * NPROJ + ch0);
#pragma unroll
        for (int i = 0; i < 4; ++i) { a[2 * i] += w[tap][i >> 1][(2 * i) & 3] * lo_bf(raw[i]); a[2 * i + 1] += w[tap][i >> 1][(2 * i + 1) & 3] * hi_bf(raw[i]); }
    }
    u32x4 o;
#pragma unroll
    for (int i = 0; i < 4; ++i) o[i] = pk2(a[2 * i] * sigmoidf_(a[2 * i]), a[2 * i + 1] * sigmoidf_(a[2 * i + 1]));
    return __builtin_bit_cast(bf16x8, o);
}
__device__ __forceinline__ void solve64(float (&x)[64], const LAS float* Lm) {
#pragma unroll
    for (int c = 1; c < 64; ++c) {
        int one = 1; asm volatile("" : "+s"(one));
        if (one) {
            float a = x[c];
#pragma unroll
            for (int s4 = 0; s4 < (c + 3) / 4; ++s4) { const f32x4 lv = *(const LAS f32x4*)(Lm + c * 64 + 4 * s4);
#pragma unroll
                for (int i = 0; i < 4; ++i) if (4 * s4 + i < c) a -= lv[i] * x[4 * s4 + i]; }
            x[c] = a;
        }
    }
}
__device__ __forceinline__ void gdn_prep(const Frame& F_in, int l) {
    const Frame F = relaunder(F_in);
    unsigned char* const L_ws = WSP; const float* const cw = IN_F(4) + (size_t)l * 4 * 768; const float* const L_a_log = IN_F(5); const float* const L_dt_bias = IN_F(6);
    const bf16* const PROJ = (const bf16*)(L_ws + WS_BIG); const float* const GATES = (const float*)(L_ws + WS_GATES); float* const GL = (float*)(L_ws + WS_MISC) + 2048;
    LAS float* Lm = (LAS float*)(F.lds + F.wave * WAVE_LDS);
    LAS bf16* T = (LAS bf16*)Lm;
    LAS float* gcv = Lm + 4096; LAS float* bkv = gcv + 64; LAS float* rkv = gcv + 128; LAS float* qdf = gcv + 192; LAS float* wfv = gcv + 256; LAS float* kdf = gcv + 320; LAS float* btv = gcv + 384;
    int g, m, lane;
#define RELANE() do { int ln_ = F.lane; asm volatile("" : "+v"(ln_)); lane = ln_; g = ln_ >> 4; m = ln_ & 15; } while (0)
    for (int unit = F.gw; unit < 2048; unit += F.ngw) {
        RELANE();
        const int h = (unit >> 6) & 3, n = unit & 63; const size_t t0 = (size_t)(unit >> 8) * SEQ + (size_t)n * 64;
        bf16* const ub = gdn_ubuf(L_ws, unit);
        float gl, gc_own, beta_own;
        {
            const float* gr = GATES + (t0 + lane) * 16;
            beta_own = sigmoidf_(gr[h]);
            float gs = -__expf(L_a_log[l * 4 + h]) * softplusf_(gr[4 + h] + L_dt_bias[l * 4 + h]);
#pragma unroll
            for (int o = 1; o < 64; o <<= 1) { const float t = xshfl(gs, lane >= o ? lane - o : lane); if (lane >= o) gs += t; }
            gc_own = gs; gl = __int_as_float(__builtin_amdgcn_readlane(__float_as_int(gs), 63));
            gcv[lane] = gs; btv[lane] = beta_own;
        }
        RELANE();
        bf16x8 FQ[4][2], FK[4][2];
#pragma unroll
        for (int ks = 0; ks < 2; ++ks) {
            f32x4 wq[4][2], wk[4][2];
#pragma unroll
            for (int tap = 0; tap < 4; ++tap) { const float* wp = cw + tap * 768 + h * 64 + 32 * ks + 8 * g; wq[tap][0] = *(const f32x4*)wp; wq[tap][1] = *(const f32x4*)(wp + 4); wk[tap][0] = *(const f32x4*)(wp + 256); wk[tap][1] = *(const f32x4*)(wp + 260); }
#pragma unroll
            for (int mp = 0; mp < 2; ++mp) { int one_ = 1; asm volatile("" : "+s"(one_)); if (one_) {
#pragma unroll
                for (int mq = 0; mq < 2; ++mq) { const int mt = 2 * mp + mq;
                FQ[mt][ks] = conv8(PROJ, t0 + 16 * mt + m, 64 * n + 16 * mt + m, h * 64 + 32 * ks + 8 * g, wq);
                FK[mt][ks] = conv8(PROJ, t0 + 16 * mt + m, 64 * n + 16 * mt + m, 256 + h * 64 + 32 * ks + 8 * g, wk); }
            } }
        }
        RELANE();
#pragma unroll
        for (int tt = 0; tt < 4; ++tt) {
            f32x4 ak = (f32x4){0.f, 0.f, 0.f, 0.f}, aq = ak;
            ak = MFMA16(FK[tt][0], FK[tt][0], ak); ak = MFMA16(FK[tt][1], FK[tt][1], ak);
            aq = MFMA16(FQ[tt][0], FQ[tt][0], aq); aq = MFMA16(FQ[tt][1], FQ[tt][1], aq);
            const int r = m & 3;
            const float dk_ = r == 0 ? ak[0] : r == 1 ? ak[1] : r == 2 ? ak[2] : ak[3];
            const float dq_ = r == 0 ? aq[0] : r == 1 ? aq[1] : r == 2 ? aq[2] : aq[3];
            if ((m >> 2) == g) { rkv[16 * tt + m] = __builtin_amdgcn_rsqf(dk_ + EPS); qdf[16 * tt + m] = 0.125f * __builtin_amdgcn_rsqf(dq_ + EPS); }
        }
        LDS_WAIT(); asm volatile("" ::: "memory");
        RELANE();
        {
            const float rk = rkv[lane], rq = qdf[lane];
            LDS_WAIT(); asm volatile("" ::: "memory");
            bkv[lane] = beta_own * rk; wfv[lane] = beta_own * rk * __expf(gc_own); kdf[lane] = rk * __expf(gl - gc_own); qdf[lane] = rq;
        }
        LDS_WAIT(); asm volatile("" ::: "memory");
        RELANE();
#pragma unroll
        for (int tt = 0; tt < 4; ++tt) { int one_ = 1; asm volatile("" : "+s"(one_)); if (one_) {
            const float gct = gcv[16 * tt + m], rqt = qdf[16 * tt + m];
#pragma unroll
            for (int ks = 0; ks < 2; ++ks) if (2 * ks <= tt) {
                u32x4 ow = (u32x4){0u, 0u, 0u, 0u};
#pragma unroll
                for (int hf = 0; hf < 2; ++hf) { const int st = 2 * ks + hf;
                    if (st <= tt) {
                        f32x4 acc = (f32x4){0.f, 0.f, 0.f, 0.f};
                        acc = MFMA16(FK[st][0], FQ[tt][0], acc); acc = MFMA16(FK[st][1], FQ[tt][1], acc);
                        const f32x4 gcs = *(const LAS f32x4*)(gcv + 16 * st + 4 * g), rks = *(const LAS f32x4*)(rkv + 16 * st + 4 * g);
                        float v[4];
#pragma unroll
                        for (int r = 0; r < 4; ++r) { const int sI = 16 * st + 4 * g + r, tI = 16 * tt + m; v[r] = (sI <= tI) ? acc[r] * rqt * rks[r] * __expf(gct - gcs[r]) : 0.f; }
                        ow[2 * hf] = pk2(v[0], v[1]); ow[2 * hf + 1] = pk2(v[2], v[3]);
                    } }
                *(u32x4*)(ub + GU_QK + (qk_idx(tt, ks) * 64 + lane) * 8) = ow;
            }
        } }
        RELANE();
#pragma unroll
        for (int mt = 0; mt < 4; ++mt)
#pragma unroll
            for (int ks = 0; ks < 2; ++ks) *(LAS bf16x8*)(T + (16 * mt + m) * 72 + 32 * ks + 8 * g) = FQ[mt][ks];
        LDS_WAIT(); asm volatile("" ::: "memory");
#pragma unroll
        for (int mt = 0; mt < 4; ++mt) {
            const float f = qdf[16 * mt + m] * __expf(gcv[16 * mt + m]);
#pragma unroll
            for (int ks = 0; ks < 2; ++ks) {
                const u32x2 lo = *(const LAS u32x2*)(T + (16 * mt + m) * 72 + 32 * ks + 4 * g), hi = *(const LAS u32x2*)(T + (16 * mt + m) * 72 + 32 * ks + 16 + 4 * g);
                u32x4 ow; ow.x = pk2(lo_bf(lo.x) * f, hi_bf(lo.x) * f); ow.y = pk2(lo_bf(lo.y) * f, hi_bf(lo.y) * f); ow.z = pk2(lo_bf(hi.x) * f, hi_bf(hi.x) * f); ow.w = pk2(lo_bf(hi.y) * f, hi_bf(hi.y) * f);
                *(u32x4*)(ub + GU_QD + ((mt * 2 + ks) * 64 + lane) * 8) = ow;
            }
        }
        LDS_WAIT(); asm volatile("" ::: "memory");
        RELANE();
        float xw[64];
        {
            const int chk = 256 + h * 64 + lane;
            const float k0 = cw[chk], k1 = cw[768 + chk], k2 = cw[1536 + chk], k3 = cw[2304 + chk];
            float ka = 0.f, kb = 0.f, kc = 0.f;
            if (n > 0) { ka = bf2f(PROJ[(t0 - 3) * NPROJ + chk]); kb = bf2f(PROJ[(t0 - 2) * NPROJ + chk]); kc = bf2f(PROJ[(t0 - 1) * NPROJ + chk]); }
            unsigned short kr[64];
#pragma unroll
            for (int c = 0; c < 64; ++c) kr[c] = PROJ[(t0 + c) * NPROJ + chk];
            asm volatile("" ::: "memory");
#pragma unroll
            for (int c4 = 0; c4 < 16; ++c4) {
                const f32x4 wf4 = *(const LAS f32x4*)(wfv + 4 * c4), kd4 = *(const LAS f32x4*)(kdf + 4 * c4);
                float kt[4];
#pragma unroll
                for (int i = 0; i < 4; ++i) { const int c = 4 * c4 + i; const float kd_ = bf2f(kr[c]);
                    float ak = k0 * ka + k1 * kb + k2 * kc + k3 * kd_; ak = ak * sigmoidf_(ak); ka = kb; kb = kc; kc = kd_;
                    xw[c] = ak * wf4[i]; kt[i] = ak * kd4[i]; }
                u32x2 w2; w2.x = pk2(kt[0], kt[1]); w2.y = pk2(kt[2], kt[3]);
                *(LAS u32x2*)(T + lane * 72 + 4 * c4) = w2;
            }
        }
        LDS_WAIT(); asm volatile("" ::: "memory");
        RELANE();
#pragma unroll
        for (int dt = 0; dt < 4; ++dt)
#pragma unroll
            for (int ks = 0; ks < 2; ++ks) {
                const u32x2 lo = *(const LAS u32x2*)(T + (16 * dt + m) * 72 + 32 * ks + 4 * g), hi = *(const LAS u32x2*)(T + (16 * dt + m) * 72 + 32 * ks + 16 + 4 * g);
                u32x4 ow; ow.x = lo.x; ow.y = lo.y; ow.z = hi.x; ow.w = hi.y;
                *(u32x4*)(ub + GU_KD + ((dt * 2 + ks) * 64 + lane) * 8) = ow;
            }
        LDS_WAIT(); asm volatile("" ::: "memory");
        RELANE();
#pragma unroll
        for (int ct = 0; ct < 4; ++ct) { int one_ = 1; asm volatile("" : "+s"(one_)); if (one_) {
            const f32x4 gcc = *(const LAS f32x4*)(gcv + 16 * ct + 4 * g), bkc = *(const LAS f32x4*)(bkv + 16 * ct + 4 * g);
#pragma unroll
            for (int st = 0; st <= ct; ++st) {
                f32x4 acc = (f32x4){0.f, 0.f, 0.f, 0.f};
                acc = MFMA16(FK[ct][0], FK[st][0], acc); acc = MFMA16(FK[ct][1], FK[st][1], acc);
                const float gcs = gcv[16 * st + m], rks = rkv[16 * st + m];
#pragma unroll
                for (int r = 0; r < 4; ++r) { const int cI = 16 * ct + 4 * g + r, sI = 16 * st + m; Lm[cI * 64 + sI] = (sI < cI) ? acc[r] * bkc[r] * rks * __expf(gcc[r] - gcs) : 0.f; }
            }
        } }
        LDS_WAIT(); asm volatile("" ::: "memory");
        __builtin_amdgcn_sched_barrier(0);
        solve64(xw, Lm);
        __builtin_amdgcn_sched_barrier(0);
        {
            RELANE();
            const int l5 = lane & 31, gp = (l5 >> 2) & 3, jj = ((l5 >> 4) << 2) | (l5 & 3);
            bf16* wp = ub + GU_W + (lane >> 5) * 512 + gp * 128 + jj;
#pragma unroll
            for (int c = 0; c < 64; ++c) wp[(c >> 4) * 1024 + (c & 15) * 8] = (bf16)f2bf(xw[c]);
        }
        __builtin_amdgcn_sched_barrier(0);
        RELANE();
        float xu[64];
        {
            const int chv = 512 + h * 64 + lane;
            const float v0 = cw[chv], v1 = cw[768 + chv], v2 = cw[1536 + chv], v3 = cw[2304 + chv];
            float va = 0.f, vb = 0.f, vc = 0.f;
            if (n > 0) { va = bf2f(PROJ[(t0 - 3) * NPROJ + chv]); vb = bf2f(PROJ[(t0 - 2) * NPROJ + chv]); vc = bf2f(PROJ[(t0 - 1) * NPROJ + chv]); }
            unsigned short vr[64];
#pragma unroll
            for (int c = 0; c < 64; ++c) vr[c] = PROJ[(t0 + c) * NPROJ + chv];
            asm volatile("" ::: "memory");
#pragma unroll
            for (int c4 = 0; c4 < 16; ++c4) {
                const f32x4 bt4 = *(const LAS f32x4*)(btv + 4 * c4);
#pragma unroll
                for (int i = 0; i < 4; ++i) { const int c = 4 * c4 + i; const float vd_ = bf2f(vr[c]);
                    float av = v0 * va + v1 * vb + v2 * vc + v3 * vd_; av = av * sigmoidf_(av); va = vb; vb = vc; vc = vd_;
                    xu[c] = av * bt4[i]; }
            }
        }
        __builtin_amdgcn_sched_barrier(0);
        solve64(xu, Lm);
        __builtin_amdgcn_sched_barrier(0);
        LDS_WAIT(); asm volatile("" ::: "memory");
        RELANE();
        {
            const int sl = lane >> 4, e = lane & 15;
#pragma unroll
            for (int mt = 0; mt < 4; ++mt)
#pragma unroll
                for (int gp = 0; gp < 4; ++gp) { const int c = 16 * mt + 4 * gp; u32x2 w2; w2.x = pk2(xu[c], xu[c + 1]); w2.y = pk2(xu[c + 2], xu[c + 3]);
                    *(u32x2*)(ub + GU_U + ((sl * 4 + mt) * 64 + gp * 16 + e) * 4) = w2; }
        }
        if (lane == 0) GL[unit] = __expf(gl);
        LDS_WAIT(); asm volatile("" ::: "memory");
    }
#undef RELANE
}
__device__ __forceinline__ void gdn_scan(const Frame& F_in, int task) {
    const Frame F = relaunder(F_in);
    unsigned char* const L_ws = WSP; bf16* const PROJ = (bf16*)(L_ws + WS_BIG); const float* const GL = (const float*)(L_ws + WS_MISC) + 2048;
    const int bh = task >> 2, sl = task & 3;
    const int b = bh >> 2, h = bh & 3, unit0 = b * 256 + h * 64;
    f32x4 St[4];
#pragma unroll
    for (int i = 0; i < 4; ++i) St[i] = (f32x4){0.f, 0.f, 0.f, 0.f};
    bf16x8 W[8], QD[8], KD[8], QK[6]; u32x2 U[4], UN[4]; float gl; int vz = 0; asm volatile("" : "+v"(vz)); unsigned pA = 0, pB = 0;
    {
        const bf16* u0 = gdn_ubuf(L_ws, unit0) + F.lane * 8;
#pragma unroll
        for (int f = 0; f < 8; ++f) { W[f] = *(const bf16x8*)(u0 + GU_W + f * 512); QD[f] = *(const bf16x8*)(u0 + GU_QD + f * 512); KD[f] = *(const bf16x8*)(u0 + GU_KD + f * 512); }
#pragma unroll
        for (int f = 0; f < 6; ++f) QK[f] = *(const bf16x8*)(u0 + GU_QK + f * 512);
#pragma unroll
        for (int mt = 0; mt < 4; ++mt) U[mt] = *(const u32x2*)(u0 - F.lane * 8 + GU_U + ((sl * 4 + mt) * 64 + F.lane) * 4);
        gl = GL[unit0 + vz];
    }
#pragma unroll 1
    for (int n = 0; n < 64; ++n) {
        const int nn = n < 63 ? n + 1 : 63;
        int ln_ = F.lane; asm volatile("" : "+v"(ln_)); const int g = ln_ >> 4, e = ln_ & 15;
        const bf16* un = gdn_ubuf(L_ws, unit0 + nn) + ln_ * 8;
        const float cgl = gl; gl = GL[unit0 + nn + vz];
        const bf16x8 SB0 = pack_tiles(St[0], St[1]), SB1 = pack_tiles(St[2], St[3]);
        const size_t t0 = (size_t)b * SEQ + (size_t)n * 64;
        f32x4 vn[4];
#pragma unroll
        for (int tt = 0; tt < 4; ++tt) {
            f32x4 ws_ = (f32x4){0.f, 0.f, 0.f, 0.f};
            ws_ = MFMA16(W[tt * 2], SB0, ws_); ws_ = MFMA16(W[tt * 2 + 1], SB1, ws_);
            W[tt * 2] = *(const bf16x8*)(un + GU_W + (tt * 2) * 512); W[tt * 2 + 1] = *(const bf16x8*)(un + GU_W + (tt * 2 + 1) * 512);
            vn[tt] = (f32x4){lo_bf(U[tt].x), hi_bf(U[tt].x), lo_bf(U[tt].y), hi_bf(U[tt].y)} - ws_;
            U[tt] = *(const u32x2*)(un - ln_ * 8 + GU_U + ((sl * 4 + tt) * 64 + ln_) * 4);
        }
        const bf16x8 VB0 = pack_tiles(vn[0], vn[1]), VB1 = pack_tiles(vn[2], vn[3]);
#pragma unroll
        for (int tt = 0; tt < 4; ++tt) {
            f32x4 o = (f32x4){0.f, 0.f, 0.f, 0.f};
            o = MFMA16(QD[tt * 2], SB0, o); o = MFMA16(QD[tt * 2 + 1], SB1, o);
            QD[tt * 2] = *(const bf16x8*)(un + GU_QD + (tt * 2) * 512); QD[tt * 2 + 1] = *(const bf16x8*)(un + GU_QD + (tt * 2 + 1) * 512);
            o = MFMA16(QK[qk_idx(tt, 0)], VB0, o); QK[qk_idx(tt, 0)] = *(const bf16x8*)(un + GU_QK + qk_idx(tt, 0) * 512);
            if (tt >= 2) { o = MFMA16(QK[qk_idx(tt, 1)], VB1, o); QK[qk_idx(tt, 1)] = *(const bf16x8*)(un + GU_QK + qk_idx(tt, 1) * 512); }
#pragma unroll
            for (int r = 0; r < 4; ++r) PROJ[(t0 + 16 * tt + 4 * g + r) * NPROJ + 512 + h * 64 + 16 * sl + e] = (bf16)f2bf(o[r]);
        }
#pragma unroll
        for (int dt = 0; dt < 4; ++dt) { f32x4 c = St[dt] * cgl; c = MFMA16(KD[dt * 2], VB0, c); c = MFMA16(KD[dt * 2 + 1], VB1, c); St[dt] = c;
            KD[dt * 2] = *(const bf16x8*)(un + GU_KD + (dt * 2) * 512); KD[dt * 2 + 1] = *(const bf16x8*)(un + GU_KD + (dt * 2 + 1) * 512); }
    }
}

__device__ __forceinline__ void mlstm_prep(const Frame& F_in, int l) {
    const Frame F = relaunder(F_in);
    unsigned char* const L_ws = WSP; const float* const L_i_bias = IN_F(8); const float* const L_f_bias = IN_F(9);
    const bf16* const PROJ = (const bf16*)(L_ws + WS_BIG); const float* const GATES = (const float*)(L_ws + WS_GATES); float* const FL = (float*)(L_ws + WS_MISC);
    LAS float* bvec = (LAS float*)(F.lds + F.wave * WAVE_LDS); LAS float* avec = bvec + 64;
    const int g = F.lane >> 4, m = F.lane & 15;
    for (int unit = F.gw; unit < 2048; unit += F.ngw) {
        const int h = (unit >> 6) & 3; const size_t t0 = (size_t)(unit >> 8) * SEQ + (size_t)(unit & 63) * 64;
        bf16* const ub = (bf16*)(L_ws + WS_MLB) + (size_t)unit * MU_STRIDE;
        float bl;
        {
            const float* gr = GATES + (t0 + F.lane) * 16;
            const float iv = 15.0f * tanhf((gr[8 + h] + L_i_bias[l * 4 + h]) * (1.0f / 15.0f));
            const float c = 15.0f * tanhf((gr[12 + h] + L_f_bias[l * 4 + h]) * (1.0f / 15.0f));
            float bs = -softplusf_(-c);
#pragma unroll
            for (int o = 1; o < 64; o <<= 1) { const float t = xshfl(bs, F.lane >= o ? F.lane - o : F.lane); if (F.lane >= o) bs += t; }
            bl = __int_as_float(__builtin_amdgcn_readlane(__float_as_int(bs), 63));
            bvec[F.lane] = bs; avec[F.lane] = iv - bs;
        }
        LDS_WAIT(); asm volatile("" ::: "memory");
        const bf16* qrow = PROJ + (t0 + m) * NPROJ + 1024 + h * 64;
        bf16x8 FQ[4][2], FK[4][2];
#pragma unroll
        for (int mt = 0; mt < 4; ++mt)
#pragma unroll
            for (int ks = 0; ks < 2; ++ks) { FQ[mt][ks] = *(const bf16x8*)(qrow + (size_t)(16 * mt) * NPROJ + 32 * ks + 8 * g); FK[mt][ks] = *(const bf16x8*)(qrow + (size_t)(16 * mt) * NPROJ + 256 + 32 * ks + 8 * g); }
#pragma unroll
        for (int tt = 0; tt < 4; ++tt) {
            const float bt = bvec[16 * tt + m];
#pragma unroll
            for (int ks = 0; ks < 2; ++ks) {
                u32x4 ow = (u32x4){0u, 0u, 0u, 0u};
#pragma unroll
                for (int hf = 0; hf < 2; ++hf) { const int st = 2 * ks + hf;
                    if (st <= tt) {
                        f32x4 acc = (f32x4){0.f, 0.f, 0.f, 0.f};
                        acc = MFMA16(FK[st][0], FQ[tt][0], acc); acc = MFMA16(FK[st][1], FQ[tt][1], acc);
                        const f32x4 av = *(const LAS f32x4*)(avec + 16 * st + 4 * g);
                        float v[4];
#pragma unroll
                        for (int r = 0; r < 4; ++r) { const int sI = 16 * st + 4 * g + r, tI = 16 * tt + m; v[r] = (sI <= tI) ? acc[r] * 0.125f * __expf(bt + av[r]) : 0.f; }
                        ow[2 * hf] = pk2(v[0], v[1]); ow[2 * hf + 1] = pk2(v[2], v[3]);
                    } }
                *(u32x4*)(ub + MU_PT + ((tt * 2 + ks) * 64 + F.lane) * 8) = ow;
            }
        }
#pragma unroll
        for (int mt = 0; mt < 4; ++mt) {
            const float f = __expf(bvec[16 * mt + m]);
#pragma unroll
            for (int ks = 0; ks < 2; ++ks) {
                const u32x2 lo = *(const u32x2*)(qrow + (size_t)(16 * mt) * NPROJ + 32 * ks + 4 * g), hi = *(const u32x2*)(qrow + (size_t)(16 * mt) * NPROJ + 32 * ks + 16 + 4 * g);
                u32x4 ow; ow.x = pk2(lo_bf(lo.x) * f, hi_bf(lo.x) * f); ow.y = pk2(lo_bf(lo.y) * f, hi_bf(lo.y) * f); ow.z = pk2(lo_bf(hi.x) * f, hi_bf(hi.x) * f); ow.w = pk2(lo_bf(hi.y) * f, hi_bf(hi.y) * f);
                *(u32x4*)(ub + MU_QB + ((mt * 2 + ks) * 64 + F.lane) * 8) = ow;
            }
        }
#pragma unroll
        for (int ks = 0; ks < 2; ++ks) {
            const f32x4 a0 = *(const LAS f32x4*)(avec + 32 * ks + 4 * g), a1 = *(const LAS f32x4*)(avec + 32 * ks + 16 + 4 * g);
            float fac[8];
#pragma unroll
            for (int j = 0; j < 4; ++j) { fac[j] = 0.125f * __expf(bl + a0[j]); fac[4 + j] = 0.125f * __expf(bl + a1[j]); }
            const bf16* kcol = PROJ + (t0 + 32 * ks + 4 * g) * NPROJ + 1280 + h * 64 + m;
#pragma unroll
            for (int dt = 0; dt < 4; ++dt) {
                float kv[8];
#pragma unroll
                for (int j = 0; j < 8; ++j) kv[j] = bf2f(kcol[(size_t)(16 * (j >> 2) + (j & 3)) * NPROJ + 16 * dt]) * fac[j];
                u32x4 ow; ow.x = pk2(kv[0], kv[1]); ow.y = pk2(kv[2], kv[3]); ow.z = pk2(kv[4], kv[5]); ow.w = pk2(kv[6], kv[7]);
                *(u32x4*)(ub + MU_KW + ((dt * 2 + ks) * 64 + F.lane) * 8) = ow;
            }
#pragma unroll
            for (int sl = 0; sl < 4; ++sl) {
                unsigned short vv[8];
#pragma unroll
                for (int j = 0; j < 8; ++j) vv[j] = kcol[(size_t)(16 * (j >> 2) + (j & 3)) * NPROJ + 256 + 16 * sl];
                u32x4 ow; ow.x = vv[0] | ((unsigned)vv[1] << 16); ow.y = vv[2] | ((unsigned)vv[3] << 16); ow.z = vv[4] | ((unsigned)vv[5] << 16); ow.w = vv[6] | ((unsigned)vv[7] << 16);
                *(u32x4*)(ub + MU_VB + ((sl * 2 + ks) * 64 + F.lane) * 8) = ow;
            }
        }
        if (F.lane == 0) FL[unit] = __expf(bl);
        LDS_WAIT(); asm volatile("" ::: "memory");
    }
}
__device__ __forceinline__ void mlstm_scan(const Frame& F_in, int task) {
    const Frame F = relaunder(F_in);
    unsigned char* const L_ws = WSP; bf16* const PROJ = (bf16*)(L_ws + WS_BIG); float* const GATES = (float*)(L_ws + WS_GATES); const float* const FL = (const float*)(L_ws + WS_MISC);
    const int bh = task / 5, sl = task % 5;
    const int b = bh >> 2, h = bh & 3;
    const bf16* ub0 = (const bf16*)(L_ws + WS_MLB) + (size_t)(b * 256 + h * 64) * MU_STRIDE; const bf16* ub = ub0 + F.lane * 8;
    const u32x4 ones = (u32x4){0x3f803f80u, 0x3f803f80u, 0x3f803f80u, 0x3f803f80u};
    f32x4 Ct[4];
#pragma unroll
    for (int i = 0; i < 4; ++i) Ct[i] = (f32x4){0.f, 0.f, 0.f, 0.f};
    bf16x8 QB[8], PT[8], KW[8], VB[2], VN[2]; float fl; unsigned pA = 0, pB = 0, pC = 0, pD = 0;
#define ML_VB(dst, n_) do { const bf16* u_ = ub + (size_t)(n_) * MU_STRIDE; if (sl < 4) { dst[0] = *(const bf16x8*)(u_ + MU_VB + (sl * 2) * 512); dst[1] = *(const bf16x8*)(u_ + MU_VB + (sl * 2 + 1) * 512); } else { dst[0] = __builtin_bit_cast(bf16x8, ones); dst[1] = dst[0]; } } while (0)
#pragma unroll
    for (int f = 0; f < 8; ++f) { QB[f] = *(const bf16x8*)(ub + MU_QB + f * 512); PT[f] = *(const bf16x8*)(ub + MU_PT + f * 512); KW[f] = *(const bf16x8*)(ub + MU_KW + f * 512); }
    int vz = 0; asm volatile("" : "+v"(vz)); ML_VB(VB, 0); fl = FL[b * 256 + h * 64 + vz];
#pragma unroll 1
    for (int n = 0; n < 64; ++n) {
        const int nn = n < 63 ? n + 1 : 63;
        int ln_ = F.lane; asm volatile("" : "+v"(ln_)); const int g = ln_ >> 4, e = ln_ & 15;
        const bf16* un = ub0 + ln_ * 8 + (size_t)nn * MU_STRIDE;
        const float cfl = fl; fl = FL[b * 256 + h * 64 + nn + vz];
        ML_VB(VN, nn);
        const bf16x8 CB0 = pack_tiles(Ct[0], Ct[1]), CB1 = pack_tiles(Ct[2], Ct[3]);
        const size_t t0 = (size_t)b * SEQ + (size_t)n * 64;
#pragma unroll
        for (int tt = 0; tt < 4; ++tt) {
            f32x4 o = (f32x4){0.f, 0.f, 0.f, 0.f};
            o = MFMA16(QB[tt * 2], CB0, o); o = MFMA16(QB[tt * 2 + 1], CB1, o); o = MFMA16(PT[tt * 2], VB[0], o); o = MFMA16(PT[tt * 2 + 1], VB[1], o);
            QB[tt * 2] = *(const bf16x8*)(un + MU_QB + (tt * 2) * 512); QB[tt * 2 + 1] = *(const bf16x8*)(un + MU_QB + (tt * 2 + 1) * 512);
            PT[tt * 2] = *(const bf16x8*)(un + MU_PT + (tt * 2) * 512); PT[tt * 2 + 1] = *(const bf16x8*)(un + MU_PT + (tt * 2 + 1) * 512);
            if (sl < 4) {
#pragma unroll
                for (int r = 0; r < 4; ++r) PROJ[(t0 + 16 * tt + 4 * g + r) * NPROJ + 1536 + h * 64 + 16 * sl + e] = (bf16)f2bf(o[r]);
            } else if (e == 0) {
#pragma unroll
                for (int r = 0; r < 4; ++r) GATES[(t0 + 16 * tt + 4 * g + r) * 16 + 8 + h] = o[r];
            }
        }
#pragma unroll
        for (int dt = 0; dt < 4; ++dt) { f32x4 c = Ct[dt] * cfl; c = MFMA16(KW[dt * 2], VB[0], c); c = MFMA16(KW[dt * 2 + 1], VB[1], c); Ct[dt] = c;
            KW[dt * 2] = *(const bf16x8*)(un + MU_KW + (dt * 2) * 512); KW[dt * 2 + 1] = *(const bf16x8*)(un + MU_KW + (dt * 2 + 1) * 512); }
        VB[0] = VN[0]; VB[1] = VN[1];
    }
#undef ML_VB
}

__device__ __forceinline__ float sum16(float v) {
    v += __int_as_float(__builtin_amdgcn_update_dpp(0, __float_as_int(v), 0xB1, 0xF, 0xF, true));
    v += __int_as_float(__builtin_amdgcn_update_dpp(0, __float_as_int(v), 0x4E, 0xF, 0xF, true));
    v += __int_as_float(__builtin_amdgcn_update_dpp(0, __float_as_int(v), 0x141, 0xF, 0xF, true));
    v += __int_as_float(__builtin_amdgcn_update_dpp(0, __float_as_int(v), 0x140, 0xF, 0xF, true));
    return v;
}
__device__ __forceinline__ void m2_post(const Frame& F_in, int l) {
    const Frame F = relaunder(F_in);
    unsigned char* const L_ws = WSP;
    {
        const f32x4* ps = (const f32x4*)(IN_F(1) + (size_t)l * M * PLE); u32x2* pb = (u32x2*)(L_ws + WS_PB);
        const int stride = F.ngw * 64;
        for (int i = F.gw * 64 + F.lane; i < M * PLE / 4; i += 4 * stride) {
            f32x4 v[4];
#pragma unroll
            for (int u = 0; u < 4; ++u) v[u] = ps[i + u * stride];
#pragma unroll
            for (int u = 0; u < 4; ++u) { u32x2 w; w.x = pk2(v[u][0], v[u][1]); w.y = pk2(v[u][2], v[u][3]); pb[i + u * stride] = w; }
        }
    }
    const bf16* const PROJ = (const bf16*)(L_ws + WS_BIG); bf16* const Y = (bf16*)(L_ws + WS_BIG + 176 * MiB); const float* const GATES = (const float*)(L_ws + WS_GATES);
    const f32x4 gn = *(const f32x4*)(IN_F(7) + l * 64 + ((4 * F.lane) & 63)), mn = *(const f32x4*)(IN_F(10) + l * 256 + 4 * F.lane);
    for (int t = F.gw * 4; t < M; t += F.ngw * 4) {
        u32x2 og[4], zg[4], om[4], pm[4]; float dn[4];
#pragma unroll
        for (int u = 0; u < 4; ++u) { const bf16* row = PROJ + (size_t)(t + u) * NPROJ + 4 * F.lane;
            og[u] = *(const u32x2*)(row + 512); zg[u] = *(const u32x2*)(row + 768); om[u] = *(const u32x2*)(row + 1536); pm[u] = *(const u32x2*)(row + 1792);
            dn[u] = GATES[(size_t)(t + u) * 16 + 8 + (F.lane >> 4)]; }
#pragma unroll
        for (int u = 0; u < 4; ++u) {
            float o[4] = {lo_bf(og[u].x), hi_bf(og[u].x), lo_bf(og[u].y), hi_bf(og[u].y)}, z[4] = {lo_bf(zg[u].x), hi_bf(zg[u].x), lo_bf(zg[u].y), hi_bf(zg[u].y)};
            float rs = __builtin_amdgcn_rsqf(sum16((o[0] * o[0] + o[1] * o[1]) + (o[2] * o[2] + o[3] * o[3])) * (1.0f / 64.0f) + EPS);
            float y[4];
#pragma unroll
            for (int i = 0; i < 4; ++i) y[i] = o[i] * rs * gn[i] * (z[i] * sigmoidf_(z[i]));
            u32x2 w; w.x = pk2(y[0], y[1]); w.y = pk2(y[2], y[3]);
            *(u32x2*)(Y + (size_t)(t + u) * DM + 4 * F.lane) = w;
            const float inv = __builtin_amdgcn_rcpf(fmaxf(fabsf(dn[u]), 1.0f));
            float hm[4] = {lo_bf(om[u].x) * inv, hi_bf(om[u].x) * inv, lo_bf(om[u].y) * inv, hi_bf(om[u].y) * inv}, p[4] = {lo_bf(pm[u].x), hi_bf(pm[u].x), lo_bf(pm[u].y), hi_bf(pm[u].y)};
            rs = __builtin_amdgcn_rsqf(sum16((hm[0] * hm[0] + hm[1] * hm[1]) + (hm[2] * hm[2] + hm[3] * hm[3])) * (1.0f / 64.0f) + EPS);
#pragma unroll
            for (int i = 0; i < 4; ++i) y[i] = hm[i] * rs * mn[i] * sigmoidf_(p[i]);
            w.x = pk2(y[0], y[1]); w.y = pk2(y[2], y[3]);
            *(u32x2*)(Y + (size_t)(t + u) * DM + 256 + 4 * F.lane) = w;
        }
    }
}

__device__ __forceinline__ int crow(int reg, int h) { return (reg & 3) + 8 * (reg >> 2) + 4 * h; }
__device__ __forceinline__ void swa_phase(const Frame& F_in, int l, int blk0) {
    const Frame F = relaunder(F_in);
    unsigned char* const L_ws = WSP; const float* const L_sinks = IN_F(11); const bf16* const L_PROJ = (const bf16*)(L_ws + WS_BIG); bf16* const L_Y = (bf16*)(L_ws + WS_BIG + 176 * MiB); const float* const L_ROPE = (const float*)(L_ws + WS_ROPE);
    LAS bf16* Ks = (LAS bf16*)F.lds;
    LAS bf16* Vt = (LAS bf16*)(F.lds + 36864);
    const float* COS = L_ROPE; const float* SIN = L_ROPE + (size_t)M * 8;
    const int r = F.lane & 31, h = F.lane >> 5;
    for (int unit = (int)blockIdx.x - blk0; unit < 512; unit += F.G - blk0) {
        const int b = unit >> 6, kvh = (unit >> 5) & 1, nb = unit & 31;
        const int tok0 = b * SEQ + nb * 128;
        __syncthreads();
        {
            const int key = F.tid >> 1, half = F.tid & 1; const int tok = tok0 - 128 + key; const bool valid = (nb > 0) || (key >= 128);
            u32x4 kq[4], vq[4];
#pragma unroll
            for (int i = 0; i < 4; ++i) { kq[i] = (u32x4){0u, 0u, 0u, 0u}; vq[i] = (u32x4){0u, 0u, 0u, 0u}; }
            if (valid) {
                const bf16* ksrc = L_PROJ + (size_t)tok * NPROJ + 2560 + kvh * 64 + half * 32;
                const bf16* vsrc = L_PROJ + (size_t)tok * NPROJ + 2688 + kvh * 64 + half * 32;
#pragma unroll
                for (int i = 0; i < 4; ++i) { kq[i] = *(const u32x4*)(ksrc + 8 * i); vq[i] = *(const u32x4*)(vsrc + 8 * i); }
                if (half == 0) {
                    const f32x4 c0 = *(const f32x4*)(COS + (size_t)tok * 8), c1 = *(const f32x4*)(COS + (size_t)tok * 8 + 4);
                    const f32x4 s0 = *(const f32x4*)(SIN + (size_t)tok * 8), s1 = *(const f32x4*)(SIN + (size_t)tok * 8 + 4);
                    float x1[8], x2[8], cs[8], sn[8];
#pragma unroll
                    for (int i = 0; i < 4; ++i) { x1[2 * i] = lo_bf(kq[0][i]); x1[2 * i + 1] = hi_bf(kq[0][i]); x2[2 * i] = lo_bf(kq[1][i]); x2[2 * i + 1] = hi_bf(kq[1][i]); cs[i] = c0[i]; cs[4 + i] = c1[i]; sn[i] = s0[i]; sn[4 + i] = s1[i]; }
#pragma unroll
                    for (int i = 0; i < 4; ++i) {
                        kq[0][i] = pk2(x1[2 * i] * cs[2 * i] - x2[2 * i] * sn[2 * i], x1[2 * i + 1] * cs[2 * i + 1] - x2[2 * i + 1] * sn[2 * i + 1]);
                        kq[1][i] = pk2(x2[2 * i] * cs[2 * i] + x1[2 * i] * sn[2 * i], x2[2 * i + 1] * cs[2 * i + 1] + x1[2 * i + 1] * sn[2 * i + 1]); }
                }
            }
#pragma unroll
            for (int i = 0; i < 4; ++i) *(LAS u32x4*)(Ks + key * 72 + half * 32 + 8 * i) = kq[i];
#pragma unroll
            for (int i = 0; i < 4; ++i)
#pragma unroll
                for (int e = 0; e < 4; ++e) { const int d = half * 32 + 8 * i + 2 * e; Vt[d * 264 + key] = (bf16)(vq[i][e] & 0xffffu); Vt[(d + 1) * 264 + key] = (bf16)(vq[i][e] >> 16); }
        }
        __syncthreads();
        const int g = F.wave >> 1, qhalf = F.wave & 1, qh = kvh * 4 + g;
        const float sink = L_sinks[l * 8 + qh];
#pragma unroll 1
        for (int sub = 0; sub < 2; ++sub) {
            const int q0 = qhalf * 64 + sub * 32;
            const int qtok = tok0 + q0 + r;
            bf16x8 qf[4];
            {
                const bf16* qsrc = L_PROJ + (size_t)qtok * NPROJ + 2048 + qh * 64 + 8 * h;
                u32x4 qw[4];
#pragma unroll
                for (int ks = 0; ks < 4; ++ks) qw[ks] = *(const u32x4*)(qsrc + 16 * ks);
                const f32x4 c0 = *(const f32x4*)(COS + (size_t)qtok * 8), c1 = *(const f32x4*)(COS + (size_t)qtok * 8 + 4);
                const f32x4 s0 = *(const f32x4*)(SIN + (size_t)qtok * 8), s1 = *(const f32x4*)(SIN + (size_t)qtok * 8 + 4);
                float cs[8], sn[8];
#pragma unroll
                for (int i = 0; i < 4; ++i) { cs[i] = c0[i]; cs[4 + i] = c1[i]; sn[i] = s0[i]; sn[4 + i] = s1[i]; }
                u32x4 ow;
#pragma unroll
                for (int i = 0; i < 4; ++i) ow[i] = xshflu(qw[0][i], F.lane ^ 32);
                const float sg = h ? 1.0f : -1.0f;
#pragma unroll
                for (int i = 0; i < 4; ++i) {
                    const float a0 = lo_bf(qw[0][i]), a1 = hi_bf(qw[0][i]), b0 = lo_bf(ow[i]), b1 = hi_bf(ow[i]);
                    qw[0][i] = pk2((a0 * cs[2 * i] + sg * b0 * sn[2 * i]) * 0.125f, (a1 * cs[2 * i + 1] + sg * b1 * sn[2 * i + 1]) * 0.125f); }
#pragma unroll
                for (int ks = 1; ks < 4; ++ks)
#pragma unroll
                    for (int i = 0; i < 4; ++i) qw[ks][i] = pk2(lo_bf(qw[ks][i]) * 0.125f, hi_bf(qw[ks][i]) * 0.125f);
#pragma unroll
                for (int ks = 0; ks < 4; ++ks) qf[ks] = __builtin_bit_cast(bf16x8, qw[ks]);
            }
            f32x16 sc[5];
#pragma unroll
            for (int kb = 0; kb < 5; ++kb) {
                f32x16 a;
#pragma unroll
                for (int i = 0; i < 16; ++i) a[i] = 0.f;
#pragma unroll
                for (int ks = 0; ks < 4; ++ks) { const bf16x8 kf = *(const LAS bf16x8*)(Ks + (q0 + 32 * kb + r) * 72 + 16 * ks + 8 * h); a = __builtin_amdgcn_mfma_f32_32x32x16_bf16(kf, qf[ks], a, 0, 0, 0); }
                sc[kb] = a;
            }
            float mx = sink;
#pragma unroll
            for (int kb = 0; kb < 5; ++kb)
#pragma unroll
                for (int i = 0; i < 16; ++i) { const int kr = 32 * kb + crow(i, h); const bool ok = (kr > r) && (kr <= r + 128) && ((nb > 0) || (q0 + kr >= 128));
                    const float s = ok ? sc[kb][i] : -INFINITY; sc[kb][i] = s; mx = fmaxf(mx, s); }
            mx = fmaxf(mx, xshfl(mx, F.lane ^ 32));
            float ls = 0.f;
#pragma unroll
            for (int kb = 0; kb < 5; ++kb)
#pragma unroll
                for (int i = 0; i < 16; ++i) { const float p = __expf(sc[kb][i] - mx); sc[kb][i] = p; ls += p; }
            ls += xshfl(ls, F.lane ^ 32);
            ls += __expf(sink - mx);
            const float inv = __builtin_amdgcn_rcpf(ls);
            f32x16 o[2];
#pragma unroll
            for (int db = 0; db < 2; ++db) {
                f32x16 a;
#pragma unroll
                for (int i = 0; i < 16; ++i) a[i] = 0.f;
#pragma unroll
                for (int kb = 0; kb < 5; ++kb)
#pragma unroll
                    for (int s = 0; s < 2; ++s) {
                        u32x4 pw;
#pragma unroll
                        for (int i = 0; i < 4; ++i) pw[i] = pk2(sc[kb][8 * s + 2 * i], sc[kb][8 * s + 2 * i + 1]);
                        const LAS bf16* vb = Vt + (db * 32 + r) * 264 + q0 + 32 * kb + 16 * s + 4 * h;
                        const s16x4 lo = *(const LAS s16x4*)vb, hi = *(const LAS s16x4*)(vb + 8);
                        const bf16x8 vf = __builtin_shufflevector(lo, hi, 0, 1, 2, 3, 4, 5, 6, 7);
                        a = __builtin_amdgcn_mfma_f32_32x32x16_bf16(vf, __builtin_bit_cast(bf16x8, pw), a, 0, 0, 0);
                    }
                o[db] = a;
            }
            bf16* yp = L_Y + (size_t)qtok * DM + 512 + qh * 64;
#pragma unroll
            for (int db = 0; db < 2; ++db)
#pragma unroll
                for (int gg = 0; gg < 4; ++gg) { u32x2 w; w.x = pk2(o[db][4 * gg] * inv, o[db][4 * gg + 1] * inv); w.y = pk2(o[db][4 * gg + 2] * inv, o[db][4 * gg + 3] * inv);
                    *(u32x2*)(yp + db * 32 + 8 * gg + 4 * h) = w; }
        }
    }
    __syncthreads();
}

__device__ __forceinline__ void final_norm(const Frame& F_in) {
    const Frame F = relaunder(F_in);
    float* const L_out = OUTP; const float* const L_norm_final = IN_F(20);
    for (int m0 = F.gw; m0 < M; m0 += 2 * F.ngw) {
        f32x4 v[2][4]; const f32x4* gr = (const f32x4*)L_norm_final + F.lane;
#pragma unroll
        for (int q = 0; q < 2; ++q) { const f32x4* xr = (const f32x4*)(L_out + (size_t)(m0 + q * F.ngw) * DM) + F.lane;
#pragma unroll
            for (int j = 0; j < 4; ++j) v[q][j] = xr[64 * j]; }
#pragma unroll
        for (int q = 0; q < 2; ++q) { f32x4* xr = (f32x4*)(L_out + (size_t)(m0 + q * F.ngw) * DM) + F.lane; float s = 0.f;
#pragma unroll
            for (int j = 0; j < 4; ++j) s += (v[q][j][0] * v[q][j][0] + v[q][j][1] * v[q][j][1]) + (v[q][j][2] * v[q][j][2] + v[q][j][3] * v[q][j][3]);
            const float rs = __builtin_amdgcn_rsqf(wave_sum(s, F.lane) * (1.0f / DM) + EPS);
#pragma unroll
            for (int j = 0; j < 4; ++j) xr[64 * j] = v[q][j] * rs * gr[64 * j]; }
    }
}

#define RLX_AGENT __ATOMIC_RELAXED, __HIP_MEMORY_SCOPE_AGENT
#define XB_TMO      128
#define XB_XCNT(j)  (256  + 64 * (j))
#define XB_XSUB(j)  (1280 + 64 * (j))
#define XB_XGEN(j)  (2304 + 64 * (j))
#define XB_TOP      3328
#define XB_TOPGEN   3392
#define XCD_BAR_WORDS 3456
#define XB_SPIN_CAP (1u << 18)

__device__ __forceinline__ unsigned xb_ld(unsigned* p)              { return __hip_atomic_load(p, __ATOMIC_RELAXED, __HIP_MEMORY_SCOPE_AGENT); }
__device__ __forceinline__ unsigned xb_add(unsigned* p, unsigned v) { return __hip_atomic_fetch_add(p, v, __ATOMIC_RELAXED, __HIP_MEMORY_SCOPE_AGENT); }
__device__ __forceinline__ unsigned xb_xcc_id() { return (unsigned)__builtin_amdgcn_s_getreg((3 << 11) | 20) & 0xFu; }
#define XB_SPIN(cond, bar) do { unsigned _sp = 0; while (cond) { __builtin_amdgcn_s_sleep(1); \
    if ((++_sp & 255u) == 0u) { if (xb_ld(&(bar)[XB_TMO])) break; if (_sp > XB_SPIN_CAP) { atomicAdd(&(bar)[XB_TMO], 1u); break; } } } } while (0)

struct XcdBarrier {
    unsigned* bar; unsigned x;
    volatile LAS unsigned* st;
};

__device__ __forceinline__ XcdBarrier xcd_barrier_post(unsigned* bar, volatile LAS unsigned* st, bool leader) {
    XcdBarrier b; b.bar = bar; b.x = xb_xcc_id(); b.st = st;
    if (leader) (void)xb_add(&bar[XB_XCNT(b.x)], 1u);
    return b;
}
__device__ __forceinline__ void xcd_barrier_complete(unsigned* bar, unsigned x, unsigned& nloc, unsigned& nx) {
    const unsigned G = gridDim.x * gridDim.y * gridDim.z;
    unsigned sum, cnt, mine, sp = 0u;
    for (;;) {
        sum = 0u; cnt = 0u; mine = 0u;
#pragma unroll
        for (unsigned j = 0; j < 16; ++j) { const unsigned c = xb_ld(&bar[XB_XCNT(j)]); sum += c; cnt += (c > 0u) ? 1u : 0u; mine = (j == x) ? c : mine; }
        if (sum == G) break;
        __builtin_amdgcn_s_sleep(1);
        if ((++sp & 255u) == 0u) { if (xb_ld(&bar[XB_TMO])) break; if (sp > XB_SPIN_CAP) { atomicAdd(&bar[XB_TMO], 1u); break; } }
    }
    nloc = mine > 0u ? mine : 1u; nx = cnt > 0u ? cnt : 1u;
}

__device__ __forceinline__ void xcd_barrier(const XcdBarrier& b, bool leader) {
    asm volatile("s_waitcnt vmcnt(0)" ::: "memory");
    __syncthreads();
    if (leader) {
        unsigned* bar = b.bar;
        __builtin_amdgcn_s_waitcnt(0);
        unsigned nloc = b.st[0], nx = b.st[1];
        if (nloc == 0u) { xcd_barrier_complete(bar, b.x, nloc, nx); b.st[0] = nloc; b.st[1] = nx; }
        const unsigned old = xb_add(&bar[XB_XSUB(b.x)], 1u);
        const unsigned gen = old / nloc;
        if (old + 1u == (gen + 1u) * nloc) {
            __builtin_amdgcn_fence(__ATOMIC_RELEASE, "agent");
            asm volatile("s_waitcnt vmcnt(0)" ::: "memory");
            const unsigned og = xb_add(&bar[XB_TOP], 1u);
            const unsigned tg = og / nx;
            if (og + 1u == (tg + 1u) * nx) xb_add(&bar[XB_TOPGEN], 1u);
            else XB_SPIN(xb_ld(&bar[XB_TOPGEN]) == tg, bar);
            __builtin_amdgcn_fence(__ATOMIC_ACQUIRE, "agent");
            xb_add(&bar[XB_XGEN(b.x)], 1u);
            asm volatile("s_waitcnt vmcnt(0)" ::: "memory");
        } else {
            XB_SPIN(xb_ld(&bar[XB_XGEN(b.x)]) == gen, bar);
            __builtin_amdgcn_fence(__ATOMIC_ACQUIRE, "agent");
            asm volatile("s_waitcnt vmcnt(0)" ::: "memory");
        }
    }
    __syncthreads();
}

__device__ __forceinline__ void gbar(const Frame& F_in, int) {
    XcdBarrier b; b.bar = (unsigned*)(WSP + WS_MISC + 65536); b.x = xb_xcc_id(); b.st = (volatile LAS unsigned*)(F_in.lds + LDS_BYTES);
    int w_ = F_in.wave; asm volatile("" : "+s"(w_));
    xcd_barrier(b, w_ == 0 && lane_id_asm() == 0);
}

__global__ void __launch_bounds__(NTHR, 2) hybrid_fwd(Args args) {
    extern __shared__ __attribute__((aligned(16))) unsigned char lds[];
    cg::grid_group grid = cg::this_grid();
    Frame F;
    F.lds = (LAS unsigned char*)lds;
    F.wave = __builtin_amdgcn_readfirstlane((int)threadIdx.x >> 6); F.tid = 0; F.lane = 0;
    F.G = gridDim.x; F.gw = blockIdx.x * NWAVES + F.wave; F.ngw = F.G * NWAVES;

    volatile LAS unsigned* xst = (volatile LAS unsigned*)(F.lds + LDS_BYTES);
    if (threadIdx.x < 16) xst[threadIdx.x] = 0u;
    __syncthreads();
    const int xb = 0; (void)xcd_barrier_post((unsigned*)(WSP + WS_MISC + 65536), xst, F.wave == 0 && lane_id_asm() == 0);
    convert_weights(F, 0, F.gw, F.ngw);
    p0_prologue(F);
    grid.sync();
#pragma unroll 1
    for (int l = 0; l < NL; ++l) {
#pragma unroll 1
        for (int op = 0; op < 6; ++op) {
            if (op == 1) {
                gbar(F, xb);
                gdn_prep(F, l);
                mlstm_prep(F, l);
                swa_phase(F, l, 0);
                gbar(F, xb);
                {
                    int c = (int)blockIdx.x; asm volatile("" : "+s"(c));
                    if (F.wave == 0) {
                        if (c < 128) gdn_scan(F, ((c & 7) + 8 * (c >> 5)) * 4 + ((c >> 3) & 3));
                        else { const int q = c - 128, j = q >> 3; mlstm_scan(F, ((q & 7) + 8 * (j / 5)) * 5 + (j % 5)); }
                    } else if (F.wave == 2 && c < 32) { const int q = 128 + c, j = q >> 3; mlstm_scan(F, ((q & 7) + 8 * (j / 5)) * 5 + (j % 5)); }
                    else if (F.wave >= 4 && l + 1 < NL) convert_weights(F, l + 1, c * 4 + (F.wave - 4), F.G * 4);
                }
                gbar(F, xb);
                m2_post(F, l);
            }
            if (op != 5 && (l | op) != 0) gbar(F, xb);
            unsigned char* const ws = WSP; unsigned char* const wb = ws + WS_W + (size_t)(l & 1) * W_LAYER; float* const outp = OUTP;
            float* const ssq0 = (float*)(ws + WS_SSQ); float* const ssq1 = ssq0 + (size_t)M * 16; float* const ssq2 = ssq0 + (size_t)2 * M * 16;
            bf16* const xb = (bf16*)(ws + WS_XB); unsigned char* const big = ws + WS_BIG;
            pg8::Gemm g; pg8::EpiAny E; g.M = M;
            bf16* const xalt = (bf16*)(big + 192 * MiB);
            E.ssq_in = ssq0; E.ssq_out = ssq0; E.base = outp; E.xout = outp; E.ob = xb; E.pp = (const bf16*)big; E.gates = (float*)(ws + WS_GATES);
            if (op == 0)      { g.A = l == 0 ? xb : xalt; g.Bt = (const bf16*)(wb + WO_IN); g.N = NPAD; g.K = DM; E.mode = 0; E.ssq_in = ssq0; E.ob = (bf16*)big; }
            else if (op == 1) { g.A = (const bf16*)(big + 176 * MiB); g.Bt = (const bf16*)(wb + WO_OUT); g.N = DM; g.K = DM; E.mode = 3; E.ssq_out = ssq1; if (l == 0) E.base = IN_F(0); }
            else if (op == 2) { g.A = xb; g.Bt = (const bf16*)(wb + WO_UP); g.N = FF; g.K = DM; E.mode = 1; E.ssq_in = ssq1; E.ob = (bf16*)big; }
            else if (op == 3) { g.A = (const bf16*)big; g.Bt = (const bf16*)(wb + WO_DOWN); g.N = DM; g.K = FF; E.mode = 3; E.ssq_out = ssq2; }
            else if (op == 4) { g.A = (const bf16*)(ws + WS_PB); g.Bt = (const bf16*)(wb + WO_P); g.N = DM; g.K = PLE; E.mode = 2; E.ob = (bf16*)big; }
            else              { g.A = xb; g.Bt = (const bf16*)(wb + WO_G); g.N = DM; g.K = DM; E.mode = 4; E.ssq_in = ssq2; E.ssq_out = ssq0; E.ob = xalt; }
            pg8::StaticOrder S; S.init(M, g.N, F.G, (int)blockIdx.x);
#pragma unroll 1
            for (int rep = 0; rep < ((op == 0 || op == 2) ? REP_G : 1); ++rep)
            pg8::gemm_phase<pg8::EpiAny, pg8::StaticOrder, true, true>(F.lds, g, S, E, F.wave);
        }
    }
    gbar(F, xb);
    final_norm(F);
}

extern "C" void kernel_launch(void* const* d_in, const int* in_sizes, int n_in, void* d_out, int out_size, void* d_ws, size_t ws_size, hipStream_t stream) {
    static int grid = 0;
    if (grid == 0) {
        if (n_in != 21 || out_size != M * DM || ws_size < WS_END) { fprintf(stderr, "kernel_launch: unexpected shapes (n_in %d out %d ws %zu)\n", n_in, out_size, ws_size); grid = -1; return; }
        int dev = 0, cus = 0, per_cu = 0;
        hipGetDevice(&dev); hipDeviceGetAttribute(&cus, hipDeviceAttributeMultiprocessorCount, dev);
        hipFuncSetAttribute((const void*)hybrid_fwd, hipFuncAttributeMaxDynamicSharedMemorySize, LDS_BYTES + 64);
        hipOccupancyMaxActiveBlocksPerMultiprocessor(&per_cu, (const void*)hybrid_fwd, NTHR, LDS_BYTES + 64);
        (void)hipGetLastError();
        if (per_cu < 1) per_cu = 1;
        grid = cus;
        fprintf(stderr, "kernel_launch: cus %d per_cu %d grid %d ws %zu\n", cus, per_cu, grid, ws_size);
    }
    if (grid < 0) return;
    if (hipMemsetAsync((unsigned char*)d_ws + WS_MISC + 65536, 0, 16384, stream) != hipSuccess) { fprintf(stderr, "kernel_launch: memset failed\n"); return; }
    Args a{};
    for (int i = 0; i < 21; ++i) a.in[i] = d_in[i];
    a.out = (float*)d_out; a.ws = (unsigned char*)d_ws;
    void* kargs[] = {&a};
    hipError_t e = hipLaunchCooperativeKernel((const void*)hybrid_fwd, dim3(grid), dim3(NTHR), kargs, LDS_BYTES + 64, stream);
    if (e != hipSuccess) fprintf(stderr, "cooperative launch failed: %s (grid %d)\n", hipGetErrorString(e), grid);
}
```

```cpp
#include <hip/hip_runtime.h>
#include <hip/hip_cooperative_groups.h>
#include <cstdio>
#include <cstdint>
#include <cmath>
namespace pg8 {
#define PG8_LAS __attribute__((address_space(3)))
typedef unsigned short bf16_t;
typedef short bf16x8 __attribute__((ext_vector_type(8)));
typedef float f32x4 __attribute__((ext_vector_type(4)));
typedef unsigned u32x4 __attribute__((ext_vector_type(4)));
constexpr int BM = 256, BK = 64, HALF = 128, HTB = HALF * BK * 2  , STAGE_BYTES = 8 * HTB, NXCD = 8, WGM = 8;

__host__ __device__ __forceinline__ int lds_byte(int r, int c) { const int st = (r >> 4) * 2 + (c >> 5), rr = r & 15, cc = c & 31, ob = rr * 64 + cc * 2; return st * 1024 + (ob ^ (((ob >> 9) & 1) << 5)); }
__host__ __device__ __forceinline__ void stage_rc(int b, int& R, int& C) { const int st = b / 1024, sb = b % 1024, swz = sb ^ (((sb >> 9) & 1) << 5); R = (st >> 1) * 16 + swz / 64; C = (st & 1) * 32 + (swz % 64) / 2; }
__host__ __device__ __forceinline__ int perm32(int rho) { const int n = rho >> 4, i = rho & 15; return 8 * (i >> 2) + 4 * n + (i & 3); }

struct Unit { int pm, pn; };
struct Gemm { const bf16_t* A; const bf16_t* Bt; int M, N, K; };

struct StaticOrder {
    int nM, nN, nwg, G, c;
    __host__ __device__ void init(int M, int N, int G_, int c_) { nM = M / BM; nN = N / BM; nwg = nM * nN; G = G_; c = c_; }
    __host__ __device__ bool next(int i, Unit& u) const {
        const long L = (long)i * G + c; if (L >= nwg) return false;
        int wgid = (int)L; { const int q = nwg / NXCD, r = nwg % NXCD, xcd = wgid % NXCD, off = wgid / NXCD; wgid = (xcd < r ? xcd * (q + 1) : r * (q + 1) + (xcd - r) * q) + off; }
        const int nig = WGM * nN, gid = wgid / nig, fm = gid * WGM, gsz = (nM - fm) < WGM ? (nM - fm) : WGM;
        u.pm = fm + ((wgid % nig) % gsz); u.pn = (wgid % nig) / gsz; return true;
    }
    __device__ __forceinline__ void a_ready(const Unit&) const {}
    __device__ __forceinline__ void done(const Unit&) const {}
};


__device__ __forceinline__ unsigned cvt_pk_bf16(float lo, float hi) { unsigned r; asm volatile("v_cvt_pk_bf16_f32 %0, %1, %2" : "=v"(r) : "v"(lo), "v"(hi)); return r; }
typedef unsigned u32x2 __attribute__((ext_vector_type(2)));
constexpr float RMS_EPS = 1e-6f;
__device__ __forceinline__ float row_rstd(const float* ssq, int row) {
    const f32x4* p = (const f32x4*)(ssq + (size_t)row * 16);
    const f32x4 a = p[0], b = p[1], c = p[2], d = p[3];
    const float s = ((a[0] + a[1]) + (a[2] + a[3])) + ((b[0] + b[1]) + (b[2] + b[3])) + ((c[0] + c[1]) + (c[2] + c[3])) + ((d[0] + d[1]) + (d[2] + d[3]));
    return __builtin_amdgcn_rsqf(s * (1.0f / 1024.0f) + RMS_EPS);
}
struct RstdOrder : StaticOrder {
    const float* ssq; int need; int wave_id; PG8_LAS float* slots; mutable int cnt;
    __device__ __forceinline__ void a_ready(const Unit& u) const {
        if (need) {
            int ln; asm volatile("v_mbcnt_lo_u32_b32 %0, -1, 0\n\tv_mbcnt_hi_u32_b32 %0, -1, %0" : "=v"(ln));
            const int t = wave_id * 64 + ln;
            if (t < 256) slots[(cnt & 1) * 256 + t] = row_rstd(ssq, u.pm * BM + t);
        }
        ++cnt;
    }
};
struct EpiAny {
    static constexpr bool PERM = true, AFTER_DRAIN = false;
    int mode; float* ssq_out; const float* base; float* xout; bf16_t* ob; const bf16_t* pp; float* gates; const PG8_LAS float* rslots; mutable int cnt;
    __device__ __forceinline__ void operator()(const f32x4 (&acc)[2][2][4][2], const Unit& u, int wr, int wc, int fr, int fq) const {
        const int row0 = u.pm * BM + wr * 64 + fr; const int col0 = u.pn * BM + wc * 32 + 8 * fq;
        float rsv[2][4];
        if (mode != 2 && mode != 3) { const PG8_LAS float* rl = rslots + (cnt & 1) * 256 + wr * 64 + fr;
#pragma unroll
            for (int ai = 0; ai < 2; ++ai)
#pragma unroll
                for (int m = 0; m < 4; ++m) rsv[ai][m] = rl[ai * HALF + m * 16]; }
        else {
#pragma unroll
            for (int ai = 0; ai < 2; ++ai)
#pragma unroll
                for (int m = 0; m < 4; ++m) rsv[ai][m] = 1.f; }
        ++cnt;
        if (mode <= 2) {
            const int ld = mode == 0 ? 2816 : mode == 1 ? 4096 : 1024;
            if (mode != 0 || u.pn < 11) {
#pragma unroll
                for (int ai = 0; ai < 2; ++ai)
#pragma unroll
                    for (int m = 0; m < 4; ++m) { const int row = row0 + ai * HALF + m * 16; const float rs = rsv[ai][m]; bf16_t* rowp = ob + (size_t)row * ld + col0;
#pragma unroll
                        for (int bj = 0; bj < 2; ++bj) { f32x4 v0 = acc[ai][bj][m][0] * rs, v1 = acc[ai][bj][m][1] * rs;
                            if (mode == 1) {
#pragma unroll
                                for (int e = 0; e < 4; ++e) { const float a = fmaxf(v0[e], 0.f), b = fmaxf(v1[e], 0.f); v0[e] = a * a; v1[e] = b * b; } }
                            u32x4 w; w.x = cvt_pk_bf16(v0[0], v0[1]); w.y = cvt_pk_bf16(v0[2], v0[3]); w.z = cvt_pk_bf16(v1[0], v1[1]); w.w = cvt_pk_bf16(v1[2], v1[3]);
                            *(u32x4*)(rowp + bj * HALF) = w; }
                        if (m & 1) asm volatile("" ::: "memory"); }
            } else if (wc == 0 && fq < 2) {
#pragma unroll
                for (int ai = 0; ai < 2; ++ai)
#pragma unroll
                    for (int m = 0; m < 4; ++m) { const int row = row0 + ai * HALF + m * 16; const float rs = rsv[ai][m]; float* gp = gates + (size_t)row * 16 + 8 * fq;
                        *(f32x4*)(gp) = acc[ai][0][m][0] * rs; *(f32x4*)(gp + 4) = acc[ai][0][m][1] * rs; }
            }
        } else {
#pragma unroll
            for (int ap = 0; ap < 4; ++ap) { const int ai = ap >> 1, mb = (ap & 1) * 2;
                f32x4 bv[2][2][2]; u32x4 pw[2][2];
#pragma unroll
                for (int mi = 0; mi < 2; ++mi) { const size_t off = (size_t)(row0 + ai * HALF + (mb + mi) * 16) * 1024 + col0;
#pragma unroll
                    for (int bj = 0; bj < 2; ++bj) { bv[mi][bj][0] = *(const f32x4*)(base + off + bj * HALF); bv[mi][bj][1] = *(const f32x4*)(base + off + bj * HALF + 4);
                        if (mode == 4) pw[mi][bj] = *(const u32x4*)(pp + off + bj * HALF); else pw[mi][bj] = (u32x4){0u, 0u, 0u, 0u}; } }
                asm volatile("" ::: "memory");
#pragma unroll
                for (int mi = 0; mi < 2; ++mi) { const int m = mb + mi; const int row = row0 + ai * HALF + m * 16; const size_t off = (size_t)row * 1024 + col0; const float rs = rsv[ai][m];
                    float s = 0.f;
#pragma unroll
                    for (int bj = 0; bj < 2; ++bj) {
                        f32x4 a0 = acc[ai][bj][m][0], a1 = acc[ai][bj][m][1];
                        if (mode == 4) { const u32x4 q = pw[mi][bj];
                            const f32x4 p0 = (f32x4){__uint_as_float(q.x << 16), __uint_as_float(q.x & 0xffff0000u), __uint_as_float(q.y << 16), __uint_as_float(q.y & 0xffff0000u)}, p1 = (f32x4){__uint_as_float(q.z << 16), __uint_as_float(q.z & 0xffff0000u), __uint_as_float(q.w << 16), __uint_as_float(q.w & 0xffff0000u)};
#pragma unroll
                            for (int e = 0; e < 4; ++e) { a0[e] = p0[e] * __builtin_amdgcn_rcpf(1.0f + __expf(-a0[e] * rs)); a1[e] = p1[e] * __builtin_amdgcn_rcpf(1.0f + __expf(-a1[e] * rs)); } }
                        const f32x4 o0 = bv[mi][bj][0] + a0, o1 = bv[mi][bj][1] + a1;
                        *(f32x4*)(xout + off + bj * HALF) = o0; *(f32x4*)(xout + off + bj * HALF + 4) = o1;
                        u32x4 w; w.x = cvt_pk_bf16(o0[0], o0[1]); w.y = cvt_pk_bf16(o0[2], o0[3]); w.z = cvt_pk_bf16(o1[0], o1[1]); w.w = cvt_pk_bf16(o1[2], o1[3]);
                        *(u32x4*)(ob + off + bj * HALF) = w;
                        s += ((o0[0] * o0[0] + o0[1] * o0[1]) + (o0[2] * o0[2] + o0[3] * o0[3])) + ((o1[0] * o1[0] + o1[1] * o1[1]) + (o1[2] * o1[2] + o1[3] * o1[3])); }
                    s += __int_as_float(__builtin_amdgcn_ds_bpermute(((fq ^ 1) * 16 + fr) << 2, __float_as_int(s))); s += __int_as_float(__builtin_amdgcn_ds_bpermute(((fq ^ 2) * 16 + fr) << 2, __float_as_int(s)));
                    if (fq == 0) ssq_out[(size_t)row * 16 + u.pn * 4 + wc] = s; }
                asm volatile("" ::: "memory");
            }
        }
    }
};

template <class Epi, class Sched, bool ALIGN_EPI = false, bool SP2 = false>
__device__ __forceinline__ void gemm_phase(PG8_LAS unsigned char* lds, const Gemm g, const Sched& S, const Epi& E, int wave_id) {
    int tid_; asm volatile("v_mbcnt_lo_u32_b32 %0, -1, 0\n\tv_mbcnt_hi_u32_b32 %0, -1, %0" : "=v"(tid_)); tid_ += wave_id * 64; const int tid = tid_, wid = __builtin_amdgcn_readfirstlane(tid >> 6), lane = tid & 63, wr = wid >> 2, wc = wid & 3, fr = lane & 15, fq = lane >> 4;
    const int K = g.K, nt = K / BK;
    unsigned voffA[2], voffB[2];
#pragma unroll
    for (int i = 0; i < 2; ++i) { int R, C; stage_rc(tid * 16 + i * 8192, R, C); const int Rb = Epi::PERM ? ((R & ~31) + perm32(R & 31)) : R;
        voffA[i] = (unsigned)(R * K + C) * 2u; voffB[i] = (unsigned)(Rb * K + C) * 2u; }
    const size_t kstep = (size_t)(BK * 2);
    const size_t hstep = (size_t)HALF * K * 2;
    const size_t tstep = 2 * hstep;
    const unsigned ldsw = (unsigned)wid * 1024u;
    const int aoff = lds_byte(wr * 64 + fr, fq * 8), boff = lds_byte(wc * 32 + fr, fq * 8);
#define PG8_SA(b, h) (((b) * 2 + (h)) * HTB)
#define PG8_SB(b, h) ((4 + (b) * 2 + (h)) * HTB)
#define PG8_STAGE(bufoff, gbase, voff) do { _Pragma("unroll") for (int _i = 0; _i < 2; ++_i) \
        __builtin_amdgcn_global_load_lds((const unsigned*)((const char*)(gbase) + (voff)[_i]), (PG8_LAS unsigned*)(lds + (bufoff) + ldsw + _i * 8192), 16, 0, 0); } while (0)
#define PG8_LDA(dst, b, h) do { _Pragma("unroll") for (int m = 0; m < 4; ++m) _Pragma("unroll") for (int k = 0; k < 2; ++k) dst[m][k] = *(const PG8_LAS bf16x8*)(lds + PG8_SA(b, h) + aoff + m * 2048 + k * 1024); } while (0)
#define PG8_LDB(dst, b, h) do { _Pragma("unroll") for (int n = 0; n < 2; ++n) _Pragma("unroll") for (int k = 0; k < 2; ++k) dst[n][k] = *(const PG8_LAS bf16x8*)(lds + PG8_SB(b, h) + boff + n * 2048 + k * 1024); } while (0)
#define PG8_MMA(ai, bj, At, Bt) do { __builtin_amdgcn_s_setprio(1); _Pragma("unroll") for (int m = 0; m < 4; ++m) _Pragma("unroll") for (int n = 0; n < 2; ++n) _Pragma("unroll") for (int k = 0; k < 2; ++k) \
        acc[ai][bj][m][n] = __builtin_amdgcn_mfma_f32_16x16x32_bf16(Bt[n][k], At[m][k], acc[ai][bj][m][n], 0, 0, 0); __builtin_amdgcn_s_setprio(0); } while (0)
#define PG8_WAIT_V(n) asm volatile("s_waitcnt vmcnt(" #n ")" ::: "memory")
#define PG8_WAIT_L(n) asm volatile("s_waitcnt lgkmcnt(" #n ")" ::: "memory")
#define PG8_BAR __builtin_amdgcn_s_barrier()
#define PG8_SCHED __builtin_amdgcn_sched_barrier(0)
    Unit cur, nxt; int ui = 0;
    if (!S.next(0, cur)) return;
    f32x4 acc[2][2][4][2];
#pragma unroll
    for (int a = 0; a < 2; ++a)
#pragma unroll
        for (int b = 0; b < 2; ++b)
#pragma unroll
            for (int m = 0; m < 4; ++m)
#pragma unroll
                for (int n = 0; n < 2; ++n) acc[a][b][m][n] = (f32x4){0.f, 0.f, 0.f, 0.f};
    bf16x8 At[4][2], B0[2][2], B1[2][2];
    const char* cA = (const char*)g.A + (size_t)cur.pm * tstep; const char* cB = (const char*)g.Bt + (size_t)cur.pn * tstep;
    S.a_ready(cur);
    if constexpr (SP2) {
        PG8_STAGE(PG8_SB(0, 0), cB, voffB); PG8_STAGE(PG8_SB(0, 1), cB + hstep, voffB); PG8_STAGE(PG8_SA(0, 0), cA, voffA); PG8_STAGE(PG8_SA(0, 1), cA + hstep, voffA);
        if (wr == 1) PG8_BAR;
        PG8_WAIT_V(2); PG8_BAR;
        PG8_STAGE(PG8_SB(1, 0), cB + kstep, voffB); PG8_STAGE(PG8_SA(1, 0), cA + kstep, voffA); PG8_STAGE(PG8_SB(1, 1), cB + hstep + kstep, voffB);
        PG8_WAIT_V(6); PG8_BAR;
    } else {
        PG8_STAGE(PG8_SB(0, 0), cB, voffB); PG8_STAGE(PG8_SA(0, 0), cA, voffA); PG8_STAGE(PG8_SB(0, 1), cB + hstep, voffB); PG8_STAGE(PG8_SA(0, 1), cA + hstep, voffA);
        if (wr == 1) PG8_BAR;
        PG8_WAIT_V(4); PG8_BAR;
        PG8_STAGE(PG8_SB(1, 0), cB + kstep, voffB); PG8_STAGE(PG8_SA(1, 0), cA + kstep, voffA); PG8_STAGE(PG8_SB(1, 1), cB + hstep + kstep, voffB);
        PG8_WAIT_V(6); PG8_BAR;
    }
    for (;;) {
        const bool has_next = S.next(ui + 1, nxt);
        const char* nA = has_next ? (const char*)g.A + (size_t)nxt.pm * tstep : cA; const char* nB = has_next ? (const char*)g.Bt + (size_t)nxt.pn * tstep : cB;
        for (int t = 0; t < nt; t += 2) {
            const bool last = (t == nt - 2);
            const char* a1 = cA + (size_t)(t + 1) * kstep;
            const char* a2 = last ? nA : cA + (size_t)(t + 2) * kstep; const char* b2 = last ? nB : cB + (size_t)(t + 2) * kstep;
            const char* a3 = a2 + kstep; const char* b3 = b2 + kstep;
            if (last && has_next) S.a_ready(nxt);
            if constexpr (SP2) {
            PG8_LDB(B0, 0, 0); PG8_LDB(B1, 0, 1); PG8_SCHED; PG8_LDA(At, 0, 0); PG8_STAGE(PG8_SA(1, 1), a1 + hstep, voffA);
            PG8_WAIT_V(8); PG8_WAIT_L(0); PG8_BAR; PG8_MMA(0, 0, At, B0); PG8_MMA(0, 1, At, B1); PG8_BAR; PG8_SCHED;
            PG8_LDA(At, 0, 1); PG8_STAGE(PG8_SB(0, 0), b2, voffB); PG8_STAGE(PG8_SB(0, 1), b2 + hstep, voffB); PG8_STAGE(PG8_SA(0, 0), a2, voffA);
            PG8_WAIT_V(8); PG8_WAIT_L(0); PG8_BAR; PG8_MMA(1, 0, At, B0); PG8_MMA(1, 1, At, B1); PG8_BAR; PG8_SCHED;
            PG8_LDB(B0, 1, 0); PG8_LDB(B1, 1, 1); PG8_SCHED; PG8_LDA(At, 1, 0); PG8_STAGE(PG8_SA(0, 1), a2 + hstep, voffA);
            PG8_WAIT_V(8); PG8_WAIT_L(0); PG8_BAR; PG8_MMA(0, 0, At, B0); PG8_MMA(0, 1, At, B1); PG8_BAR; PG8_SCHED;
            PG8_LDA(At, 1, 1); PG8_STAGE(PG8_SB(1, 0), b3, voffB); PG8_STAGE(PG8_SB(1, 1), b3 + hstep, voffB); PG8_STAGE(PG8_SA(1, 0), a3, voffA);
            PG8_WAIT_V(8); PG8_WAIT_L(0); PG8_BAR; PG8_MMA(1, 0, At, B0); PG8_MMA(1, 1, At, B1); PG8_BAR; PG8_SCHED;
            } else {
            PG8_LDB(B0, 0, 0); PG8_SCHED; PG8_LDA(At, 0, 0); PG8_STAGE(PG8_SA(1, 1), a1 + hstep, voffA);
            PG8_WAIT_L(8); PG8_BAR; PG8_WAIT_L(0); PG8_MMA(0, 0, At, B0); PG8_BAR; PG8_SCHED;
            PG8_LDB(B1, 0, 1); PG8_STAGE(PG8_SB(0, 0), b2, voffB);
            PG8_BAR; PG8_WAIT_L(0); PG8_MMA(0, 1, At, B1); PG8_BAR;
            PG8_LDA(At, 0, 1); PG8_STAGE(PG8_SA(0, 0), a2, voffA);
            PG8_BAR; PG8_WAIT_L(0); PG8_MMA(1, 0, At, B0); PG8_BAR; PG8_SCHED;
            PG8_STAGE(PG8_SB(0, 1), b2 + hstep, voffB);
            PG8_WAIT_V(6); PG8_BAR; PG8_MMA(1, 1, At, B1); PG8_BAR;
            PG8_LDB(B0, 1, 0); PG8_SCHED; PG8_LDA(At, 1, 0); PG8_STAGE(PG8_SA(0, 1), a2 + hstep, voffA);
            PG8_WAIT_L(8); PG8_BAR; PG8_WAIT_L(0); PG8_MMA(0, 0, At, B0); PG8_BAR; PG8_SCHED;
            PG8_LDB(B1, 1, 1); PG8_STAGE(PG8_SB(1, 0), b3, voffB);
            PG8_BAR; PG8_WAIT_L(0); PG8_MMA(0, 1, At, B1); PG8_BAR;
            PG8_LDA(At, 1, 1); PG8_STAGE(PG8_SA(1, 0), a3, voffA);
            PG8_BAR; PG8_WAIT_L(0); PG8_MMA(1, 0, At, B0); PG8_BAR; PG8_SCHED;
            PG8_STAGE(PG8_SB(1, 1), b3 + hstep, voffB);
            PG8_WAIT_V(6); PG8_BAR; PG8_MMA(1, 1, At, B1); PG8_BAR;
            }
        }
        if constexpr (ALIGN_EPI) { if (wr == 0) PG8_BAR; }
        if constexpr (!Epi::AFTER_DRAIN) { E(acc, cur, wr, wc, fr, fq); S.done(cur); }
        if (!has_next) break;
#pragma unroll
        for (int a = 0; a < 2; ++a)
#pragma unroll
            for (int b = 0; b < 2; ++b)
#pragma unroll
                for (int m = 0; m < 4; ++m)
#pragma unroll
                    for (int n = 0; n < 2; ++n) acc[a][b][m][n] = (f32x4){0.f, 0.f, 0.f, 0.f};
        cur = nxt; cA = nA; cB = nB; ++ui;
        if constexpr (ALIGN_EPI) { if (wr == 1) PG8_BAR; }
    }
    PG8_WAIT_V(0);
    if constexpr (!ALIGN_EPI) { if (wr == 0) PG8_BAR; }
    PG8_BAR;
    if constexpr (Epi::AFTER_DRAIN) { E.fused(acc, cur, wr, wc, fr, fq, lds, wid, lane); S.done(cur); }
#undef PG8_SA
#undef PG8_SB
#undef PG8_STAGE
#undef PG8_LDA
#undef PG8_LDB
#undef PG8_MMA
#undef PG8_WAIT_V
#undef PG8_WAIT_L
#undef PG8_BAR
#undef PG8_SCHED
}
}

namespace cg = cooperative_groups;
#define LAS __attribute__((address_space(3)))
typedef unsigned short bf16;
typedef float f32x4 __attribute__((ext_vector_type(4)));
typedef float f32x16 __attribute__((ext_vector_type(16)));
typedef short bf16x8 __attribute__((ext_vector_type(8)));
typedef short s16x4 __attribute__((ext_vector_type(4)));
typedef unsigned u32x4 __attribute__((ext_vector_type(4)));
typedef unsigned u32x2 __attribute__((ext_vector_type(2)));

constexpr int NWAVES = 8, NTHR = 512;
constexpr int BATCH = 8, SEQ = 4096, DM = 1024, M = BATCH * SEQ, NL = 4, FF = 4096, PLE = 256;
constexpr int NPROJ = 2816, NPAD = 3072, INC = 2832;
constexpr float EPS = 1e-6f;
constexpr int LDS_BYTES = 147456;
constexpr int PF_D = 4;
constexpr int REP_MIX = 1, REP_G = 1, REP_BAR = 1, REP_P1 = 1, REP_P2 = 2, REP_P3 = 1;

constexpr size_t MiB = 1u << 20;
constexpr size_t W_LAYER = 27 * MiB;
constexpr size_t WO_IN = 0, WO_OUT = 6 * MiB, WO_UP = 8 * MiB, WO_DOWN = 16 * MiB, WO_G = 24 * MiB, WO_P = 26 * MiB;
constexpr size_t WS_W = 0;
constexpr size_t WS_XB = 108 * MiB;
constexpr size_t WS_SSQ = 172 * MiB;
constexpr size_t WS_ROPE = 178 * MiB;
constexpr size_t WS_GATES = 180 * MiB;
constexpr size_t WS_PB = 182 * MiB;
constexpr size_t WS_QKVC = 198 * MiB;
constexpr size_t WS_BIG = 246 * MiB;
constexpr size_t WS_MISC = 502 * MiB;
constexpr size_t WS_END = 503 * MiB;
constexpr size_t WS_MLB = WS_XB;
constexpr int GU_W = 0, GU_QD = 4096, GU_KD = 8192, GU_U = 12288, GU_QK = 16384, GU_STRIDE = 19456;
constexpr int GDN_NA = 1724;
constexpr int WAVE_LDS = 18432;
constexpr int MU_QB = 0, MU_PT = 4096, MU_KW = 8192, MU_VB = 12288, MU_STRIDE = 16384;

struct Args { const void* in[21]; float* out; unsigned char* ws; };

struct Frame {
    LAS unsigned char* lds;
    int tid, lane, wave, G, gw, ngw;
};
typedef const __attribute__((address_space(4))) void* kptr_t;
__device__ __forceinline__ const void* karg(int i) {
    kptr_t kp = (kptr_t)__builtin_amdgcn_kernarg_segment_ptr();
    asm volatile("" : "+s"(kp));
    return ((const void* const __attribute__((address_space(4)))*)kp)[i];
}
__device__ __forceinline__ int lane_id_asm();
__device__ __forceinline__ Frame relaunder(const Frame& f) {
    Frame r = f;
    r.lane = lane_id_asm(); r.tid = r.wave * 64 + r.lane;
    asm volatile("" : "+v"(r.tid), "+v"(r.lane));
    asm volatile("" : "+s"(r.wave), "+s"(r.gw), "+s"(r.ngw), "+s"(r.G));
    return r;
}
#define IN_F(i) ((const float*)karg(i))
#define OUTP ((float*)karg(21))
#define WSP ((unsigned char*)karg(22))

__device__ __forceinline__ float bf2f(unsigned short b) { return __uint_as_float((unsigned)b << 16); }
typedef float f32x2_t __attribute__((ext_vector_type(2))); typedef __bf16 bf16x2_t __attribute__((ext_vector_type(2)));
__device__ __forceinline__ unsigned pk2(float lo, float hi) { f32x2_t v = {lo, hi}; bf16x2_t b = __builtin_convertvector(v, bf16x2_t); return __builtin_bit_cast(unsigned, b); }
__device__ __forceinline__ unsigned f2bf(float f) { return pk2(f, 0.f) & 0xffffu; }
__device__ __forceinline__ float lo_bf(unsigned w) { return __uint_as_float(w << 16); }
__device__ __forceinline__ float hi_bf(unsigned w) { return __uint_as_float(w & 0xffff0000u); }
__device__ __forceinline__ int lane_id_asm() { int l; asm volatile("v_mbcnt_lo_u32_b32 %0, -1, 0\n\tv_mbcnt_hi_u32_b32 %0, -1, %0" : "=v"(l)); return l; }
__device__ __forceinline__ float xshfl(float v, int src_lane) { return __int_as_float(__builtin_amdgcn_ds_bpermute(src_lane << 2, __float_as_int(v))); }
__device__ __forceinline__ unsigned xshflu(unsigned v, int src_lane) { return (unsigned)__builtin_amdgcn_ds_bpermute(src_lane << 2, (int)v); }
__device__ __forceinline__ float wave_sum(float v, int lane) {
#pragma unroll
    for (int o = 1; o < 64; o <<= 1) v += xshfl(v, lane ^ o);
    return v;
}
#define LDS_WAIT() asm volatile("s_waitcnt lgkmcnt(0)" ::: "memory")
__device__ __forceinline__ float sigmoidf_(float x) { return __builtin_amdgcn_rcpf(1.0f + __expf(-x)); }
__device__ __forceinline__ float softplusf_(float x) { return fmaxf(x, 0.f) + log1pf(__expf(-fabsf(x))); }
__device__ __forceinline__ float sum8(float v) {
    v += __int_as_float(__builtin_amdgcn_update_dpp(0, __float_as_int(v), 0xB1, 0xF, 0xF, true));
    v += __int_as_float(__builtin_amdgcn_update_dpp(0, __float_as_int(v), 0x4E, 0xF, 0xF, true));
    v += __int_as_float(__builtin_amdgcn_update_dpp(0, __float_as_int(v), 0x141, 0xF, 0xF, true));
    return v;
}

__device__ __forceinline__ int win_src_col(int n) {
    if (n < 1024) return n;
    if (n < 2048) return n + 8;
    if (n < 2816) return n + 16;
    if (n < 2824) return 1024 + (n - 2816);
    if (n < 2832) return 2056 + (n - 2824);
    return -1;
}
template <int MAP>
__device__ __forceinline__ void transpose_item(const float* W, int K, int N, bf16* WT, const float* gain, LAS float* scr, int kb, int nb, int lane) {
    const int k0 = 64 * kb, n0 = 32 * nb;
    const int nd = n0 + (lane & 31);
    const int ns = MAP ? win_src_col(nd) : nd;
#pragma unroll 8
    for (int i = 0; i < 32; ++i) { const int kk = 2 * i + (lane >> 5); float v = 0.f; if (ns >= 0) v = W[(size_t)(k0 + kk) * N + ns]; if (gain) v *= gain[k0 + kk]; scr[kk * 33 + (lane & 31)] = v; }
    LDS_WAIT(); asm volatile("" ::: "memory");
    const int c = lane & 7;
#pragma unroll
    for (int j = 0; j < 4; ++j) { const int n = (lane >> 3) + 8 * j; const LAS float* s = scr + (8 * c) * 33 + n;
        u32x4 o; o.x = pk2(s[0 * 33], s[1 * 33]); o.y = pk2(s[2 * 33], s[3 * 33]); o.z = pk2(s[4 * 33], s[5 * 33]); o.w = pk2(s[6 * 33], s[7 * 33]);
        *(u32x4*)(WT + (size_t)(n0 + n) * K + k0 + 8 * c) = o; }
    LDS_WAIT(); asm volatile("" ::: "memory");
}
__device__ __forceinline__ void convert_weights(const Frame& F_in, int l, int idx, int nidx) {
    const Frame F = relaunder(F_in);
    unsigned char* const L_ws = WSP; const float* const L_w_in = IN_F(3); const float* const L_w_out = IN_F(12); const float* const L_w_up = IN_F(15); const float* const L_w_down = IN_F(16); const float* const L_w_g = IN_F(18); const float* const L_w_p = IN_F(19);
    const float* const L_norm_mix = IN_F(13); const float* const L_norm_mlp = IN_F(14); const float* const L_norm_ple = IN_F(17);
    LAS float* scr = (LAS float*)(F.lds + F.wave * 16384);
    constexpr int I_IN = 16 * 96, I_OUT = 16 * 32, I_UP = 16 * 128, I_DOWN = 64 * 32, I_G = 16 * 32, I_P = 4 * 32;
    constexpr int I_LAYER = I_IN + I_OUT + I_UP + I_DOWN + I_G + I_P;
    unsigned char* wb = L_ws + WS_W + (size_t)(l & 1) * W_LAYER;
    for (int it = idx; it < I_LAYER; it += nidx) {
        int r = it;
        if (r < I_IN) { transpose_item<1>(L_w_in + (size_t)l * DM * INC, DM, INC, (bf16*)(wb + WO_IN), L_norm_mix + l * DM, scr, r / 96, r % 96, F.lane); continue; } r -= I_IN;
        if (r < I_OUT) { transpose_item<0>(L_w_out + (size_t)l * DM * DM, DM, DM, (bf16*)(wb + WO_OUT), nullptr, scr, r / 32, r % 32, F.lane); continue; } r -= I_OUT;
        if (r < I_UP) { transpose_item<0>(L_w_up + (size_t)l * DM * FF, DM, FF, (bf16*)(wb + WO_UP), L_norm_mlp + l * DM, scr, r / 128, r % 128, F.lane); continue; } r -= I_UP;
        if (r < I_DOWN) { transpose_item<0>(L_w_down + (size_t)l * FF * DM, FF, DM, (bf16*)(wb + WO_DOWN), nullptr, scr, r / 32, r % 32, F.lane); continue; } r -= I_DOWN;
        if (r < I_G) { transpose_item<0>(L_w_g + (size_t)l * DM * DM, DM, DM, (bf16*)(wb + WO_G), L_norm_ple + l * DM, scr, r / 32, r % 32, F.lane); continue; } r -= I_G;
        transpose_item<0>(L_w_p + (size_t)l * PLE * DM, PLE, DM, (bf16*)(wb + WO_P), nullptr, scr, r / 32, r % 32, F.lane);
    }
}
__device__ __forceinline__ void p0_prologue(const Frame& F_in) {
    const Frame F = relaunder(F_in);
    unsigned char* const L_ws = WSP; const float* const L_in_x = IN_F(0); const int* const L_in_pos = (const int*)karg(2);
    bf16* const L_XB = (bf16*)(L_ws + WS_XB); float* const L_SSQ = (float*)(L_ws + WS_SSQ); float* const L_ROPE = (float*)(L_ws + WS_ROPE);
    for (int m0 = F.gw; m0 < M; m0 += 2 * F.ngw) {
        f32x4 v[2][4];
#pragma unroll
        for (int q = 0; q < 2; ++q) { const f32x4* xr = (const f32x4*)(L_in_x + (size_t)(m0 + q * F.ngw) * DM) + F.lane;
#pragma unroll
            for (int j = 0; j < 4; ++j) v[q][j] = xr[64 * j]; }
#pragma unroll
        for (int q = 0; q < 2; ++q) { const int m = m0 + q * F.ngw; float s = 0.f;
            unsigned long long* o8 = (unsigned long long*)(L_XB + (size_t)m * DM) + F.lane;
#pragma unroll
            for (int j = 0; j < 4; ++j) { const f32x4 w = v[q][j]; s += (w[0] * w[0] + w[1] * w[1]) + (w[2] * w[2] + w[3] * w[3]);
                o8[64 * j] = (unsigned long long)pk2(w[0], w[1]) | ((unsigned long long)pk2(w[2], w[3]) << 32); }
            s = wave_sum(s, F.lane);
            if (F.lane < 16) L_SSQ[(size_t)m * 16 + F.lane] = (F.lane == 0) ? s : 0.f; }
    }
    for (int i = F.gw * 64 + F.lane; i < M * 8; i += F.ngw * 64) {
        const int t = i >> 3, j = i & 7;
        const float inv = (float)exp(-(double)(2 * j) / 16.0 * 13.122363377404328);
        const float ang = (float)L_in_pos[t] * inv;
        const double a = (double)ang; const double rev = a * 0.15915494309189535; const double fr = rev - floor(rev + 0.5);
        const float rad = (float)(fr * 6.283185307179586);
        L_ROPE[i] = cosf(rad); L_ROPE[(size_t)M * 8 + i] = sinf(rad);
    }
}

#define MFMA16(a, b, c) __builtin_amdgcn_mfma_f32_16x16x32_bf16((a), (b), (c), 0, 0, 0)
__device__ __forceinline__ int kperm(int ks, int g, int j) { return 32 * ks + 16 * (j >> 2) + 4 * g + (j & 3); }
__device__ __forceinline__ bf16x8 pack_tiles(const f32x4& a, const f32x4& b) { u32x4 w; w.x = pk2(a[0], a[1]); w.y = pk2(a[2], a[3]); w.z = pk2(b[0], b[1]); w.w = pk2(b[2], b[3]); return __builtin_bit_cast(bf16x8, w); }

__device__ __forceinline__ bf16* gdn_ubuf(unsigned char* ws, int unit) {
    return unit < GDN_NA ? (bf16*)(ws + WS_PB) + (size_t)unit * GU_STRIDE : (bf16*)(ws + WS_BIG + 240 * MiB) + (size_t)(unit - GDN_NA) * GU_STRIDE;
}
__device__ __forceinline__ int qk_idx(int tt, int ks) { return tt < 2 ? tt : 2 + (tt - 2) * 2 + ks; }
__device__ __forceinline__ bf16x8 conv8(const bf16* PROJ, size_t tok, int sp, int ch0, const f32x4 (&w)[4][2]) {
    float a[8];
#pragma unroll
    for (int j = 0; j < 8; ++j) a[j] = 0.f;
#pragma unroll
    for (int tap = 0; tap < 4; ++tap) if (sp - 3 + tap >= 0) {
        const u32x4 raw = *(const u32x4*)(PROJ + (tok - 3 + tap) * NPROJ + ch0);
#pragma unroll
        for (int i = 0; i < 4; ++i) { a[2 * i] += w[tap][i >> 1][(2 * i) & 3] * lo_bf(raw[i]); a[2 * i + 1] += w[tap][i >> 1][(2 * i + 1) & 3] * hi_bf(raw[i]); }
    }
    u32x4 o;
#pragma unroll
    for (int i = 0; i < 4; ++i) o[i] = pk2(a[2 * i] * sigmoidf_(a[2 * i]), a[2 * i + 1] * sigmoidf_(a[2 * i + 1]));
    return __builtin_bit_cast(bf16x8, o);
}
__device__ __forceinline__ void solve64(float (&x)[64], const LAS float* Lm) {
#pragma unroll
    for (int c = 1; c < 64; ++c) {
        int one = 1; asm volatile("" : "+s"(one));
        if (one) {
            float a = x[c];
#pragma unroll
            for (int s4 = 0; s4 < (c + 3) / 4; ++s4) { const f32x4 lv = *(const LAS f32x4*)(Lm + c * 64 + 4 * s4);
#pragma unroll
                for (int i = 0; i < 4; ++i) if (4 * s4 + i < c) a -= lv[i] * x[4 * s4 + i]; }
            x[c] = a;
        }
    }
}
__device__ __forceinline__ void gdn_prep(const Frame& F_in, int l) {
    const Frame F = relaunder(F_in);
    unsigned char* const L_ws = WSP; const float* const cw = IN_F(4) + (size_t)l * 4 * 768; const float* const L_a_log = IN_F(5); const float* const L_dt_bias = IN_F(6);
    const bf16* const PROJ = (const bf16*)(L_ws + WS_BIG); const float* const GATES = (const float*)(L_ws + WS_GATES); float* const GL = (float*)(L_ws + WS_MISC) + 2048;
    LAS float* Lm = (LAS float*)(F.lds + F.wave * WAVE_LDS);
    LAS bf16* T = (LAS bf16*)Lm;
    LAS float* gcv = Lm + 4096; LAS float* bkv = gcv + 64; LAS float* rkv = gcv + 128; LAS float* qdf = gcv + 192; LAS float* wfv = gcv + 256; LAS float* kdf = gcv + 320; LAS float* btv = gcv + 384;
    int g, m, lane;
#define RELANE() do { int ln_ = F.lane; asm volatile("" : "+v"(ln_)); lane = ln_; g = ln_ >> 4; m = ln_ & 15; } while (0)
    for (int unit = F.gw; unit < 2048; unit += F.ngw) {
        RELANE();
        const int h = (unit >> 6) & 3, n = unit & 63; const size_t t0 = (size_t)(unit >> 8) * SEQ + (size_t)n * 64;
        bf16* const ub = gdn_ubuf(L_ws, unit);
        float gl, gc_own, beta_own;
        {
            const float* gr = GATES + (t0 + lane) * 16;
            beta_own = sigmoidf_(gr[h]);
            float gs = -__expf(L_a_log[l * 4 + h]) * softplusf_(gr[4 + h] + L_dt_bias[l * 4 + h]);
#pragma unroll
            for (int o = 1; o < 64; o <<= 1) { const float t = xshfl(gs, lane >= o ? lane - o : lane); if (lane >= o) gs += t; }
            gc_own = gs; gl = __int_as_float(__builtin_amdgcn_readlane(__float_as_int(gs), 63));
            gcv[lane] = gs; btv[lane] = beta_own;
        }
        RELANE();
        bf16x8 FQ[4][2], FK[4][2];
#pragma unroll
        for (int ks = 0; ks < 2; ++ks) {
            f32x4 wq[4][2], wk[4][2];
#pragma unroll
            for (int tap = 0; tap < 4; ++tap) { const float* wp = cw + tap * 768 + h * 64 + 32 * ks + 8 * g; wq[tap][0] = *(const f32x4*)wp; wq[tap][1] = *(const f32x4*)(wp + 4); wk[tap][0] = *(const f32x4*)(wp + 256); wk[tap][1] = *(const f32x4*)(wp + 260); }
#pragma unroll
            for (int mp = 0; mp < 2; ++mp) { int one_ = 1; asm volatile("" : "+s"(one_)); if (one_) {
#pragma unroll
                for (int mq = 0; mq < 2; ++mq) { const int mt = 2 * mp + mq;
                FQ[mt][ks] = conv8(PROJ, t0 + 16 * mt + m, 64 * n + 16 * mt + m, h * 64 + 32 * ks + 8 * g, wq);
                FK[mt][ks] = conv8(PROJ, t0 + 16 * mt + m, 64 * n + 16 * mt + m, 256 + h * 64 + 32 * ks + 8 * g, wk); }
            } }
        }
        RELANE();
#pragma unroll
        for (int tt = 0; tt < 4; ++tt) {
            f32x4 ak = (f32x4){0.f, 0.f, 0.f, 0.f}, aq = ak;
            ak = MFMA16(FK[tt][0], FK[tt][0], ak); ak = MFMA16(FK[tt][1], FK[tt][1], ak);
            aq = MFMA16(FQ[tt][0], FQ[tt][0], aq); aq = MFMA16(FQ[tt][1], FQ[tt][1], aq);
            const int r = m & 3;
            const float dk_ = r == 0 ? ak[0] : r == 1 ? ak[1] : r == 2 ? ak[2] : ak[3];
            const float dq_ = r == 0 ? aq[0] : r == 1 ? aq[1] : r == 2 ? aq[2] : aq[3];
            if ((m >> 2) == g) { rkv[16 * tt + m] = __builtin_amdgcn_rsqf(dk_ + EPS); qdf[16 * tt + m] = 0.125f * __builtin_amdgcn_rsqf(dq_ + EPS); }
        }
        LDS_WAIT(); asm volatile("" ::: "memory");
        RELANE();
        {
            const float rk = rkv[lane], rq = qdf[lane];
            LDS_WAIT(); asm volatile("" ::: "memory");
            bkv[lane] = beta_own * rk; wfv[lane] = beta_own * rk * __expf(gc_own); kdf[lane] = rk * __expf(gl - gc_own); qdf[lane] = rq;
        }
        LDS_WAIT(); asm volatile("" ::: "memory");
        RELANE();
#pragma unroll
        for (int tt = 0; tt < 4; ++tt) { int one_ = 1; asm volatile("" : "+s"(one_)); if (one_) {
            const float gct = gcv[16 * tt + m], rqt = qdf[16 * tt + m];
#pragma unroll
            for (int ks = 0; ks < 2; ++ks) if (2 * ks <= tt) {
                u32x4 ow = (u32x4){0u, 0u, 0u, 0u};
#pragma unroll
                for (int hf = 0; hf < 2; ++hf) { const int st = 2 * ks + hf;
                    if (st <= tt) {
                        f32x4 acc = (f32x4){0.f, 0.f, 0.f, 0.f};
                        acc = MFMA16(FK[st][0], FQ[tt][0], acc); acc = MFMA16(FK[st][1], FQ[tt][1], acc);
                        const f32x4 gcs = *(const LAS f32x4*)(gcv + 16 * st + 4 * g), rks = *(const LAS f32x4*)(rkv + 16 * st + 4 * g);
                        float v[4];
#pragma unroll
                        for (int r = 0; r < 4; ++r) { const int sI = 16 * st + 4 * g + r, tI = 16 * tt + m; v[r] = (sI <= tI) ? acc[r] * rqt * rks[r] * __expf(gct - gcs[r]) : 0.f; }
                        ow[2 * hf] = pk2(v[0], v[1]); ow[2 * hf + 1] = pk2(v[2], v[3]);
                    } }
                *(u32x4*)(ub + GU_QK + (qk_idx(tt, ks) * 64 + lane) * 8) = ow;
            }
        } }
        RELANE();
#pragma unroll
        for (int mt = 0; mt < 4; ++mt)
#pragma unroll
            for (int ks = 0; ks < 2; ++ks) *(LAS bf16x8*)(T + (16 * mt + m) * 72 + 32 * ks + 8 * g) = FQ[mt][ks];
        LDS_WAIT(); asm volatile("" ::: "memory");
#pragma unroll
        for (int mt = 0; mt < 4; ++mt) {
            const float f = qdf[16 * mt + m] * __expf(gcv[16 * mt + m]);
#pragma unroll
            for (int ks = 0; ks < 2; ++ks) {
                const u32x2 lo = *(const LAS u32x2*)(T + (16 * mt + m) * 72 + 32 * ks + 4 * g), hi = *(const LAS u32x2*)(T + (16 * mt + m) * 72 + 32 * ks + 16 + 4 * g);
                u32x4 ow; ow.x = pk2(lo_bf(lo.x) * f, hi_bf(lo.x) * f); ow.y = pk2(lo_bf(lo.y) * f, hi_bf(lo.y) * f); ow.z = pk2(lo_bf(hi.x) * f, hi_bf(hi.x) * f); ow.w = pk2(lo_bf(hi.y) * f, hi_bf(hi.y) * f);
                *(u32x4*)(ub + GU_QD + ((mt * 2 + ks) * 64 + lane) * 8) = ow;
            }
        }
        LDS_WAIT(); asm volatile("" ::: "memory");
        RELANE();
        float xw[64];
        {
            const int chk = 256 + h * 64 + lane;
            const float k0 = cw[chk], k1 = cw[768 + chk], k2 = cw[1536 + chk], k3 = cw[2304 + chk];
            float ka = 0.f, kb = 0.f, kc = 0.f;
            if (n > 0) { ka = bf2f(PROJ[(t0 - 3) * NPROJ + chk]); kb = bf2f(PROJ[(t0 - 2) * NPROJ + chk]); kc = bf2f(PROJ[(t0 - 1) * NPROJ + chk]); }
            unsigned short kr[64];
#pragma unroll
            for (int c = 0; c < 64; ++c) kr[c] = PROJ[(t0 + c) * NPROJ + chk];
            asm volatile("" ::: "memory");
#pragma unroll
            for (int c4 = 0; c4 < 16; ++c4) {
                const f32x4 wf4 = *(const LAS f32x4*)(wfv + 4 * c4), kd4 = *(const LAS f32x4*)(kdf + 4 * c4);
                float kt[4];
#pragma unroll
                for (int i = 0; i < 4; ++i) { const int c = 4 * c4 + i; const float kd_ = bf2f(kr[c]);
                    float ak = k0 * ka + k1 * kb + k2 * kc + k3 * kd_; ak = ak * sigmoidf_(ak); ka = kb; kb = kc; kc = kd_;
                    xw[c] = ak * wf4[i]; kt[i] = ak * kd4[i]; }
                u32x2 w2; w2.x = pk2(kt[0], kt[1]); w2.y = pk2(kt[2], kt[3]);
                *(LAS u32x2*)(T + lane * 72 + 4 * c4) = w2;
            }
        }
        LDS_WAIT(); asm volatile("" ::: "memory");
        RELANE();
#pragma unroll
        for (int dt = 0; dt < 4; ++dt)
#pragma unroll
            for (int ks = 0; ks < 2; ++ks) {
                const u32x2 lo = *(const LAS u32x2*)(T + (16 * dt + m) * 72 + 32 * ks + 4 * g), hi = *(const LAS u32x2*)(T + (16 * dt + m) * 72 + 32 * ks + 16 + 4 * g);
                u32x4 ow; ow.x = lo.x; ow.y = lo.y; ow.z = hi.x; ow.w = hi.y;
                *(u32x4*)(ub + GU_KD + ((dt * 2 + ks) * 64 + lane) * 8) = ow;
            }
        LDS_WAIT(); asm volatile("" ::: "memory");
        RELANE();
#pragma unroll
        for (int ct = 0; ct < 4; ++ct) { int one_ = 1; asm volatile("" : "+s"(one_)); if (one_) {
            const f32x4 gcc = *(const LAS f32x4*)(gcv + 16 * ct + 4 * g), bkc = *(const LAS f32x4*)(bkv + 16 * ct + 4 * g);
#pragma unroll
            for (int st = 0; st <= ct; ++st) {
                f32x4 acc = (f32x4){0.f, 0.f, 0.f, 0.f};
                acc = MFMA16(FK[ct][0], FK[st][0], acc); acc = MFMA16(FK[ct][1], FK[st][1], acc);
                const float gcs = gcv[16 * st + m], rks = rkv[16 * st + m];
#pragma unroll
                for (int r = 0; r < 4; ++r) { const int cI = 16 * ct + 4 * g + r, sI = 16 * st + m; Lm[cI * 64 + sI] = (sI < cI) ? acc[r] * bkc[r] * rks * __expf(gcc[r] - gcs) : 0.f; }
            }
        } }
        LDS_WAIT(); asm volatile("" ::: "memory");
        __builtin_amdgcn_sched_barrier(0);
        solve64(xw, Lm);
        __builtin_amdgcn_sched_barrier(0);
        {
            RELANE();
            const int l5 = lane & 31, gp = (l5 >> 2) & 3, jj = ((l5 >> 4) << 2) | (l5 & 3);
            bf16* wp = ub + GU_W + (lane >> 5) * 512 + gp * 128 + jj;
#pragma unroll
            for (int c = 0; c < 64; ++c) wp[(c >> 4) * 1024 + (c & 15) * 8] = (bf16)f2bf(xw[c]);
        }
        __builtin_amdgcn_sched_barrier(0);
        RELANE();
        float xu[64];
        {
            const int chv = 512 + h * 64 + lane;
            const float v0 = cw[chv], v1 = cw[768 + chv], v2 = cw[1536 + chv], v3 = cw[2304 + chv];
            float va = 0.f, vb = 0.f, vc = 0.f;
            if (n > 0) { va = bf2f(PROJ[(t0 - 3) * NPROJ + chv]); vb = bf2f(PROJ[(t0 - 2) * NPROJ + chv]); vc = bf2f(PROJ[(t0 - 1) * NPROJ + chv]); }
            unsigned short vr[64];
#pragma unroll
            for (int c = 0; c < 64; ++c) vr[c] = PROJ[(t0 + c) * NPROJ + chv];
            asm volatile("" ::: "memory");
#pragma unroll
            for (int c4 = 0; c4 < 16; ++c4) {
                const f32x4 bt4 = *(const LAS f32x4*)(btv + 4 * c4);
#pragma unroll
                for (int i = 0; i < 4; ++i) { const int c = 4 * c4 + i; const float vd_ = bf2f(vr[c]);
                    float av = v0 * va + v1 * vb + v2 * vc + v3 * vd_; av = av * sigmoidf_(av); va = vb; vb = vc; vc = vd_;
                    xu[c] = av * bt4[i]; }
            }
        }
        __builtin_amdgcn_sched_barrier(0);
        solve64(xu, Lm);
        __builtin_amdgcn_sched_barrier(0);
        LDS_WAIT(); asm volatile("" ::: "memory");
        RELANE();
        {
            const int sl = lane >> 4, e = lane & 15;
#pragma unroll
            for (int mt = 0; mt < 4; ++mt)
#pragma unroll
                for (int gp = 0; gp < 4; ++gp) { const int c = 16 * mt + 4 * gp; u32x2 w2; w2.x = pk2(xu[c], xu[c + 1]); w2.y = pk2(xu[c + 2], xu[c + 3]);
                    *(u32x2*)(ub + GU_U + ((sl * 4 + mt) * 64 + gp * 16 + e) * 4) = w2; }
        }
        if (lane == 0) GL[unit] = __expf(gl);
        LDS_WAIT(); asm volatile("" ::: "memory");
    }
#undef RELANE
}
__device__ __forceinline__ void gdn_scan(const Frame& F_in, int task) {
    const Frame F = relaunder(F_in);
    unsigned char* const L_ws = WSP; bf16* const PROJ = (bf16*)(L_ws + WS_BIG); const float* const GL = (const float*)(L_ws + WS_MISC) + 2048;
    const int bh = task >> 2, sl = task & 3;
    const int b = bh >> 2, h = bh & 3, unit0 = b * 256 + h * 64;
    f32x4 St[4];
#pragma unroll
    for (int i = 0; i < 4; ++i) St[i] = (f32x4){0.f, 0.f, 0.f, 0.f};
    bf16x8 W[8], QD[8], KD[8], QK[6]; u32x2 U[4], UN[4]; float gl; int vz = 0; asm volatile("" : "+v"(vz)); unsigned pA = 0, pB = 0;
    {
        const bf16* u0 = gdn_ubuf(L_ws, unit0) + F.lane * 8;
#pragma unroll
        for (int f = 0; f < 8; ++f) { W[f] = *(const bf16x8*)(u0 + GU_W + f * 512); QD[f] = *(const bf16x8*)(u0 + GU_QD + f * 512); KD[f] = *(const bf16x8*)(u0 + GU_KD + f * 512); }
#pragma unroll
        for (int f = 0; f < 6; ++f) QK[f] = *(const bf16x8*)(u0 + GU_QK + f * 512);
#pragma unroll
        for (int mt = 0; mt < 4; ++mt) U[mt] = *(const u32x2*)(u0 - F.lane * 8 + GU_U + ((sl * 4 + mt) * 64 + F.lane) * 4);
        gl = GL[unit0 + vz];
    }
#pragma unroll 1
    for (int n = 0; n < 64; ++n) {
        const int nn = n < 63 ? n + 1 : 63;
        int ln_ = F.lane; asm volatile("" : "+v"(ln_)); const int g = ln_ >> 4, e = ln_ & 15;
        const bf16* un = gdn_ubuf(L_ws, unit0 + nn) + ln_ * 8;
        const float cgl = gl; gl = GL[unit0 + nn + vz];
        const bf16x8 SB0 = pack_tiles(St[0], St[1]), SB1 = pack_tiles(St[2], St[3]);
        const size_t t0 = (size_t)b * SEQ + (size_t)n * 64;
        f32x4 vn[4];
#pragma unroll
        for (int tt = 0; tt < 4; ++tt) {
            f32x4 ws_ = (f32x4){0.f, 0.f, 0.f, 0.f};
            ws_ = MFMA16(W[tt * 2], SB0, ws_); ws_ = MFMA16(W[tt * 2 + 1], SB1, ws_);
            W[tt * 2] = *(const bf16x8*)(un + GU_W + (tt * 2) * 512); W[tt * 2 + 1] = *(const bf16x8*)(un + GU_W + (tt * 2 + 1) * 512);
            vn[tt] = (f32x4){lo_bf(U[tt].x), hi_bf(U[tt].x), lo_bf(U[tt].y), hi_bf(U[tt].y)} - ws_;
            U[tt] = *(const u32x2*)(un - ln_ * 8 + GU_U + ((sl * 4 + tt) * 64 + ln_) * 4);
        }
        const bf16x8 VB0 = pack_tiles(vn[0], vn[1]), VB1 = pack_tiles(vn[2], vn[3]);
#pragma unroll
        for (int tt = 0; tt < 4; ++tt) {
            f32x4 o = (f32x4){0.f, 0.f, 0.f, 0.f};
            o = MFMA16(QD[tt * 2], SB0, o); o = MFMA16(QD[tt * 2 + 1], SB1, o);
            QD[tt * 2] = *(const bf16x8*)(un + GU_QD + (tt * 2) * 512); QD[tt * 2 + 1] = *(const bf16x8*)(un + GU_QD + (tt * 2 + 1) * 512);
            o = MFMA16(QK[qk_idx(tt, 0)], VB0, o); QK[qk_idx(tt, 0)] = *(const bf16x8*)(un + GU_QK + qk_idx(tt, 0) * 512);
            if (tt >= 2) { o = MFMA16(QK[qk_idx(tt, 1)], VB1, o); QK[qk_idx(tt, 1)] = *(const bf16x8*)(un + GU_QK + qk_idx(tt, 1) * 512); }
#pragma unroll
            for (int r = 0; r < 4; ++r) PROJ[(t0 + 16 * tt + 4 * g + r) * NPROJ + 512 + h * 64 + 16 * sl + e] = (bf16)f2bf(o[r]);
        }
#pragma unroll
        for (int dt = 0; dt < 4; ++dt) { f32x4 c = St[dt] * cgl; c = MFMA16(KD[dt * 2], VB0, c); c = MFMA16(KD[dt * 2 + 1], VB1, c); St[dt] = c;
            KD[dt * 2] = *(const bf16x8*)(un + GU_KD + (dt * 2) * 512); KD[dt * 2 + 1] = *(const bf16x8*)(un + GU_KD + (dt * 2 + 1) * 512); }
    }
}

__device__ __forceinline__ void mlstm_prep(const Frame& F_in, int l) {
    const Frame F = relaunder(F_in);
    unsigned char* const L_ws = WSP; const float* const L_i_bias = IN_F(8); const float* const L_f_bias = IN_F(9);
    const bf16* const PROJ = (const bf16*)(L_ws + WS_BIG); const float* const GATES = (const float*)(L_ws + WS_GATES); float* const FL = (float*)(L_ws + WS_MISC);
    LAS float* bvec = (LAS float*)(F.lds + F.wave * WAVE_LDS); LAS float* avec = bvec + 64;
    const int g = F.lane >> 4, m = F.lane & 15;
    for (int unit = F.gw; unit < 2048; unit += F.ngw) {
        const int h = (unit >> 6) & 3; const size_t t0 = (size_t)(unit >> 8) * SEQ + (size_t)(unit & 63) * 64;
        bf16* const ub = (bf16*)(L_ws + WS_MLB) + (size_t)unit * MU_STRIDE;
        float bl;
        {
            const float* gr = GATES + (t0 + F.lane) * 16;
            const float iv = 15.0f * tanhf((gr[8 + h] + L_i_bias[l * 4 + h]) * (1.0f / 15.0f));
            const float c = 15.0f * tanhf((gr[12 + h] + L_f_bias[l * 4 + h]) * (1.0f / 15.0f));
            float bs = -softplusf_(-c);
#pragma unroll
            for (int o = 1; o < 64; o <<= 1) { const float t = xshfl(bs, F.lane >= o ? F.lane - o : F.lane); if (F.lane >= o) bs += t; }
            bl = __int_as_float(__builtin_amdgcn_readlane(__float_as_int(bs), 63));
            bvec[F.lane] = bs; avec[F.lane] = iv - bs;
        }
        LDS_WAIT(); asm volatile("" ::: "memory");
        const bf16* qrow = PROJ + (t0 + m) * NPROJ + 1024 + h * 64;
        bf16x8 FQ[4][2], FK[4][2];
#pragma unroll
        for (int mt = 0; mt < 4; ++mt)
#pragma unroll
            for (int ks = 0; ks < 2; ++ks) { FQ[mt][ks] = *(const bf16x8*)(qrow + (size_t)(16 * mt) * NPROJ + 32 * ks + 8 * g); FK[mt][ks] = *(const bf16x8*)(qrow + (size_t)(16 * mt) * NPROJ + 256 + 32 * ks + 8 * g); }
#pragma unroll
        for (int tt = 0; tt < 4; ++tt) {
            const float bt = bvec[16 * tt + m];
#pragma unroll
            for (int ks = 0; ks < 2; ++ks) {
                u32x4 ow = (u32x4){0u, 0u, 0u, 0u};
#pragma unroll
                for (int hf = 0; hf < 2; ++hf) { const int st = 2 * ks + hf;
                    if (st <= tt) {
                        f32x4 acc = (f32x4){0.f, 0.f, 0.f, 0.f};
                        acc = MFMA16(FK[st][0], FQ[tt][0], acc); acc = MFMA16(FK[st][1], FQ[tt][1], acc);
                        const f32x4 av = *(const LAS f32x4*)(avec + 16 * st + 4 * g);
                        float v[4];
#pragma unroll
                        for (int r = 0; r < 4; ++r) { const int sI = 16 * st + 4 * g + r, tI = 16 * tt + m; v[r] = (sI <= tI) ? acc[r] * 0.125f * __expf(bt + av[r]) : 0.f; }
                        ow[2 * hf] = pk2(v[0], v[1]); ow[2 * hf + 1] = pk2(v[2], v[3]);
                    } }
                *(u32x4*)(ub + MU_PT + ((tt * 2 + ks) * 64 + F.lane) * 8) = ow;
            }
        }
#pragma unroll
        for (int mt = 0; mt < 4; ++mt) {
            const float f = __expf(bvec[16 * mt + m]);
#pragma unroll
            for (int ks = 0; ks < 2; ++ks) {
                const u32x2 lo = *(const u32x2*)(qrow + (size_t)(16 * mt) * NPROJ + 32 * ks + 4 * g), hi = *(const u32x2*)(qrow + (size_t)(16 * mt) * NPROJ + 32 * ks + 16 + 4 * g);
                u32x4 ow; ow.x = pk2(lo_bf(lo.x) * f, hi_bf(lo.x) * f); ow.y = pk2(lo_bf(lo.y) * f, hi_bf(lo.y) * f); ow.z = pk2(lo_bf(hi.x) * f, hi_bf(hi.x) * f); ow.w = pk2(lo_bf(hi.y) * f, hi_bf(hi.y) * f);
                *(u32x4*)(ub + MU_QB + ((mt * 2 + ks) * 64 + F.lane) * 8) = ow;
            }
        }
#pragma unroll
        for (int ks = 0; ks < 2; ++ks) {
            const f32x4 a0 = *(const LAS f32x4*)(avec + 32 * ks + 4 * g), a1 = *(const LAS f32x4*)(avec + 32 * ks + 16 + 4 * g);
            float fac[8];
#pragma unroll
            for (int j = 0; j < 4; ++j) { fac[j] = 0.125f * __expf(bl + a0[j]); fac[4 + j] = 0.125f * __expf(bl + a1[j]); }
            const bf16* kcol = PROJ + (t0 + 32 * ks + 4 * g) * NPROJ + 1280 + h * 64 + m;
#pragma unroll
            for (int dt = 0; dt < 4; ++dt) {
                float kv[8];
#pragma unroll
                for (int j = 0; j < 8; ++j) kv[j] = bf2f(kcol[(size_t)(16 * (j >> 2) + (j & 3)) * NPROJ + 16 * dt]) * fac[j];
                u32x4 ow; ow.x = pk2(kv[0], kv[1]); ow.y = pk2(kv[2], kv[3]); ow.z = pk2(kv[4], kv[5]); ow.w = pk2(kv[6], kv[7]);
                *(u32x4*)(ub + MU_KW + ((dt * 2 + ks) * 64 + F.lane) * 8) = ow;
            }
#pragma unroll
            for (int sl = 0; sl < 4; ++sl) {
                unsigned short vv[8];
#pragma unroll
                for (int j = 0; j < 8; ++j) vv[j] = kcol[(size_t)(16 * (j >> 2) + (j & 3)) * NPROJ + 256 + 16 * sl];
                u32x4 ow; ow.x = vv[0] | ((unsigned)vv[1] << 16); ow.y = vv[2] | ((unsigned)vv[3] << 16); ow.z = vv[4] | ((unsigned)vv[5] << 16); ow.w = vv[6] | ((unsigned)vv[7] << 16);
                *(u32x4*)(ub + MU_VB + ((sl * 2 + ks) * 64 + F.lane) * 8) = ow;
            }
        }
        if (F.lane == 0) FL[unit] = __expf(bl);
        LDS_WAIT(); asm volatile("" ::: "memory");
    }
}
__device__ __forceinline__ void mlstm_scan(const Frame& F_in, int task) {
    const Frame F = relaunder(F_in);
    unsigned char* const L_ws = WSP; bf16* const PROJ = (bf16*)(L_ws + WS_BIG); float* const GATES = (float*)(L_ws + WS_GATES); const float* const FL = (const float*)(L_ws + WS_MISC);
    const int bh = task / 5, sl = task % 5;
    const int b = bh >> 2, h = bh & 3;
    const bf16* ub0 = (const bf16*)(L_ws + WS_MLB) + (size_t)(b * 256 + h * 64) * MU_STRIDE; const bf16* ub = ub0 + F.lane * 8;
    const u32x4 ones = (u32x4){0x3f803f80u, 0x3f803f80u, 0x3f803f80u, 0x3f803f80u};
    f32x4 Ct[4];
#pragma unroll
    for (int i = 0; i < 4; ++i) Ct[i] = (f32x4){0.f, 0.f, 0.f, 0.f};
    bf16x8 QB[8], PT[8], KW[8], VB[2], VN[2]; float fl; unsigned pA = 0, pB = 0, pC = 0, pD = 0;
#define ML_VB(dst, n_) do { const bf16* u_ = ub + (size_t)(n_) * MU_STRIDE; if (sl < 4) { dst[0] = *(const bf16x8*)(u_ + MU_VB + (sl * 2) * 512); dst[1] = *(const bf16x8*)(u_ + MU_VB + (sl * 2 + 1) * 512); } else { dst[0] = __builtin_bit_cast(bf16x8, ones); dst[1] = dst[0]; } } while (0)
#pragma unroll
    for (int f = 0; f < 8; ++f) { QB[f] = *(const bf16x8*)(ub + MU_QB + f * 512); PT[f] = *(const bf16x8*)(ub + MU_PT + f * 512); KW[f] = *(const bf16x8*)(ub + MU_KW + f * 512); }
    int vz = 0; asm volatile("" : "+v"(vz)); ML_VB(VB, 0); fl = FL[b * 256 + h * 64 + vz];
#pragma unroll 1
    for (int n = 0; n < 64; ++n) {
        const int nn = n < 63 ? n + 1 : 63;
        int ln_ = F.lane; asm volatile("" : "+v"(ln_)); const int g = ln_ >> 4, e = ln_ & 15;
        const bf16* un = ub0 + ln_ * 8 + (size_t)nn * MU_STRIDE;
        const float cfl = fl; fl = FL[b * 256 + h * 64 + nn + vz];
        ML_VB(VN, nn);
        const bf16x8 CB0 = pack_tiles(Ct[0], Ct[1]), CB1 = pack_tiles(Ct[2], Ct[3]);
        const size_t t0 = (size_t)b * SEQ + (size_t)n * 64;
#pragma unroll
        for (int tt = 0; tt < 4; ++tt) {
            f32x4 o = (f32x4){0.f, 0.f, 0.f, 0.f};
            o = MFMA16(QB[tt * 2], CB0, o); o = MFMA16(QB[tt * 2 + 1], CB1, o); o = MFMA16(PT[tt * 2], VB[0], o); o = MFMA16(PT[tt * 2 + 1], VB[1], o);
            QB[tt * 2] = *(const bf16x8*)(un + MU_QB + (tt * 2) * 512); QB[tt * 2 + 1] = *(const bf16x8*)(un + MU_QB + (tt * 2 + 1) * 512);
            PT[tt * 2] = *(const bf16x8*)(un + MU_PT + (tt * 2) * 512); PT[tt * 2 + 1] = *(const bf16x8*)(un + MU_PT + (tt * 2 + 1) * 512);
            if (sl < 4) {
#pragma unroll
                for (int r = 0; r < 4; ++r) PROJ[(t0 + 16 * tt + 4 * g + r) * NPROJ + 1536 + h * 64 + 16 * sl + e] = (bf16)f2bf(o[r]);
            } else if (e == 0) {
#pragma unroll
                for (int r = 0; r < 4; ++r) GATES[(t0 + 16 * tt + 4 * g + r) * 16 + 8 + h] = o[r];
            }
        }
#pragma unroll
        for (int dt = 0; dt < 4; ++dt) { f32x4 c = Ct[dt] * cfl; c = MFMA16(KW[dt * 2], VB[0], c); c = MFMA16(KW[dt * 2 + 1], VB[1], c); Ct[dt] = c;
            KW[dt * 2] = *(const bf16x8*)(un + MU_KW + (dt * 2) * 512); KW[dt * 2 + 1] = *(const bf16x8*)(un + MU_KW + (dt * 2 + 1) * 512); }
        VB[0] = VN[0]; VB[1] = VN[1];
    }
#undef ML_VB
}

__device__ __forceinline__ float sum16(float v) {
    v += __int_as_float(__builtin_amdgcn_update_dpp(0, __float_as_int(v), 0xB1, 0xF, 0xF, true));
    v += __int_as_float(__builtin_amdgcn_update_dpp(0, __float_as_int(v), 0x4E, 0xF, 0xF, true));
    v += __int_as_float(__builtin_amdgcn_update_dpp(0, __float_as_int(v), 0x141, 0xF, 0xF, true));
    v += __int_as_float(__builtin_amdgcn_update_dpp(0, __float_as_int(v), 0x140, 0xF, 0xF, true));
    return v;
}
__device__ __forceinline__ void m2_post(const Frame& F_in, int l) {
    const Frame F = relaunder(F_in);
    unsigned char* const L_ws = WSP;
    {
        const f32x4* ps = (const f32x4*)(IN_F(1) + (size_t)l * M * PLE); u32x2* pb = (u32x2*)(L_ws + WS_PB);
        const int stride = F.ngw * 64;
        for (int i = F.gw * 64 + F.lane; i < M * PLE / 4; i += 4 * stride) {
            f32x4 v[4];
#pragma unroll
            for (int u = 0; u < 4; ++u) v[u] = ps[i + u * stride];
#pragma unroll
            for (int u = 0; u < 4; ++u) { u32x2 w; w.x = pk2(v[u][0], v[u][1]); w.y = pk2(v[u][2], v[u][3]); pb[i + u * stride] = w; }
        }
    }
    const bf16* const PROJ = (const bf16*)(L_ws + WS_BIG); bf16* const Y = (bf16*)(L_ws + WS_BIG + 176 * MiB); const float* const GATES = (const float*)(L_ws + WS_GATES);
    const f32x4 gn = *(const f32x4*)(IN_F(7) + l * 64 + ((4 * F.lane) & 63)), mn = *(const f32x4*)(IN_F(10) + l * 256 + 4 * F.lane);
    for (int t = F.gw * 4; t < M; t += F.ngw * 4) {
        u32x2 og[4], zg[4], om[4], pm[4]; float dn[4];
#pragma unroll
        for (int u = 0; u < 4; ++u) { const bf16* row = PROJ + (size_t)(t + u) * NPROJ + 4 * F.lane;
            og[u] = *(const u32x2*)(row + 512); zg[u] = *(const u32x2*)(row + 768); om[u] = *(const u32x2*)(row + 1536); pm[u] = *(const u32x2*)(row + 1792);
            dn[u] = GATES[(size_t)(t + u) * 16 + 8 + (F.lane >> 4)]; }
#pragma unroll
        for (int u = 0; u < 4; ++u) {
            float o[4] = {lo_bf(og[u].x), hi_bf(og[u].x), lo_bf(og[u].y), hi_bf(og[u].y)}, z[4] = {lo_bf(zg[u].x), hi_bf(zg[u].x), lo_bf(zg[u].y), hi_bf(zg[u].y)};
            float rs = __builtin_amdgcn_rsqf(sum16((o[0] * o[0] + o[1] * o[1]) + (o[2] * o[2] + o[3] * o[3])) * (1.0f / 64.0f) + EPS);
            float y[4];
#pragma unroll
            for (int i = 0; i < 4; ++i) y[i] = o[i] * rs * gn[i] * (z[i] * sigmoidf_(z[i]));
            u32x2 w; w.x = pk2(y[0], y[1]); w.y = pk2(y[2], y[3]);
            *(u32x2*)(Y + (size_t)(t + u) * DM + 4 * F.lane) = w;
            const float inv = __builtin_amdgcn_rcpf(fmaxf(fabsf(dn[u]), 1.0f));
            float hm[4] = {lo_bf(om[u].x) * inv, hi_bf(om[u].x) * inv, lo_bf(om[u].y) * inv, hi_bf(om[u].y) * inv}, p[4] = {lo_bf(pm[u].x), hi_bf(pm[u].x), lo_bf(pm[u].y), hi_bf(pm[u].y)};
            rs = __builtin_amdgcn_rsqf(sum16((hm[0] * hm[0] + hm[1] * hm[1]) + (hm[2] * hm[2] + hm[3] * hm[3])) * (1.0f / 64.0f) + EPS);
#pragma unroll
            for (int i = 0; i < 4; ++i) y[i] = hm[i] * rs * mn[i] * sigmoidf_(p[i]);
            w.x = pk2(y[0], y[1]); w.y = pk2(y[2], y[3]);
            *(u32x2*)(Y + (size_t)(t + u) * DM + 256 + 4 * F.lane) = w;
        }
    }
}

__device__ __forceinline__ int crow(int reg, int h) { return (reg & 3) + 8 * (reg >> 2) + 4 * h; }
__device__ __forceinline__ void swa_phase(const Frame& F_in, int l, int blk0) {
    const Frame F = relaunder(F_in);
    unsigned char* const L_ws = WSP; const float* const L_sinks = IN_F(11); const bf16* const L_PROJ = (const bf16*)(L_ws + WS_BIG); bf16* const L_Y = (bf16*)(L_ws + WS_BIG + 176 * MiB); const float* const L_ROPE = (const float*)(L_ws + WS_ROPE);
    LAS bf16* Ks = (LAS bf16*)F.lds;
    LAS bf16* Vt = (LAS bf16*)(F.lds + 36864);
    const float* COS = L_ROPE; const float* SIN = L_ROPE + (size_t)M * 8;
    const int r = F.lane & 31, h = F.lane >> 5;
    for (int unit = (int)blockIdx.x - blk0; unit < 512; unit += F.G - blk0) {
        const int b = unit >> 6, kvh = (unit >> 5) & 1, nb = unit & 31;
        const int tok0 = b * SEQ + nb * 128;
        __syncthreads();
        {
            const int key = F.tid >> 1, half = F.tid & 1; const int tok = tok0 - 128 + key; const bool valid = (nb > 0) || (key >= 128);
            u32x4 kq[4], vq[4];
#pragma unroll
            for (int i = 0; i < 4; ++i) { kq[i] = (u32x4){0u, 0u, 0u, 0u}; vq[i] = (u32x4){0u, 0u, 0u, 0u}; }
            if (valid) {
                const bf16* ksrc = L_PROJ + (size_t)tok * NPROJ + 2560 + kvh * 64 + half * 32;
                const bf16* vsrc = L_PROJ + (size_t)tok * NPROJ + 2688 + kvh * 64 + half * 32;
#pragma unroll
                for (int i = 0; i < 4; ++i) { kq[i] = *(const u32x4*)(ksrc + 8 * i); vq[i] = *(const u32x4*)(vsrc + 8 * i); }
                if (half == 0) {
                    const f32x4 c0 = *(const f32x4*)(COS + (size_t)tok * 8), c1 = *(const f32x4*)(COS + (size_t)tok * 8 + 4);
                    const f32x4 s0 = *(const f32x4*)(SIN + (size_t)tok * 8), s1 = *(const f32x4*)(SIN + (size_t)tok * 8 + 4);
                    float x1[8], x2[8], cs[8], sn[8];
#pragma unroll
                    for (int i = 0; i < 4; ++i) { x1[2 * i] = lo_bf(kq[0][i]); x1[2 * i + 1] = hi_bf(kq[0][i]); x2[2 * i] = lo_bf(kq[1][i]); x2[2 * i + 1] = hi_bf(kq[1][i]); cs[i] = c0[i]; cs[4 + i] = c1[i]; sn[i] = s0[i]; sn[4 + i] = s1[i]; }
#pragma unroll
                    for (int i = 0; i < 4; ++i) {
                        kq[0][i] = pk2(x1[2 * i] * cs[2 * i] - x2[2 * i] * sn[2 * i], x1[2 * i + 1] * cs[2 * i + 1] - x2[2 * i + 1] * sn[2 * i + 1]);
                        kq[1][i] = pk2(x2[2 * i] * cs[2 * i] + x1[2 * i] * sn[2 * i], x2[2 * i + 1] * cs[2 * i + 1] + x1[2 * i + 1] * sn[2 * i + 1]); }
                }
            }
#pragma unroll
            for (int i = 0; i < 4; ++i) *(LAS u32x4*)(Ks + key * 72 + half * 32 + 8 * i) = kq[i];
#pragma unroll
            for (int i = 0; i < 4; ++i)
#pragma unroll
                for (int e = 0; e < 4; ++e) { const int d = half * 32 + 8 * i + 2 * e; Vt[d * 264 + key] = (bf16)(vq[i][e] & 0xffffu); Vt[(d + 1) * 264 + key] = (bf16)(vq[i][e] >> 16); }
        }
        __syncthreads();
        const int g = F.wave >> 1, qhalf = F.wave & 1, qh = kvh * 4 + g;
        const float sink = L_sinks[l * 8 + qh];
#pragma unroll 1
        for (int sub = 0; sub < 2; ++sub) {
            const int q0 = qhalf * 64 + sub * 32;
            const int qtok = tok0 + q0 + r;
            bf16x8 qf[4];
            {
                const bf16* qsrc = L_PROJ + (size_t)qtok * NPROJ + 2048 + qh * 64 + 8 * h;
                u32x4 qw[4];
#pragma unroll
                for (int ks = 0; ks < 4; ++ks) qw[ks] = *(const u32x4*)(qsrc + 16 * ks);
                const f32x4 c0 = *(const f32x4*)(COS + (size_t)qtok * 8), c1 = *(const f32x4*)(COS + (size_t)qtok * 8 + 4);
                const f32x4 s0 = *(const f32x4*)(SIN + (size_t)qtok * 8), s1 = *(const f32x4*)(SIN + (size_t)qtok * 8 + 4);
                float cs[8], sn[8];
#pragma unroll
                for (int i = 0; i < 4; ++i) { cs[i] = c0[i]; cs[4 + i] = c1[i]; sn[i] = s0[i]; sn[4 + i] = s1[i]; }
                u32x4 ow;
#pragma unroll
                for (int i = 0; i < 4; ++i) ow[i] = xshflu(qw[0][i], F.lane ^ 32);
                const float sg = h ? 1.0f : -1.0f;
#pragma unroll
                for (int i = 0; i < 4; ++i) {
                    const float a0 = lo_bf(qw[0][i]), a1 = hi_bf(qw[0][i]), b0 = lo_bf(ow[i]), b1 = hi_bf(ow[i]);
                    qw[0][i] = pk2((a0 * cs[2 * i] + sg * b0 * sn[2 * i]) * 0.125f, (a1 * cs[2 * i + 1] + sg * b1 * sn[2 * i + 1]) * 0.125f); }
#pragma unroll
                for (int ks = 1; ks < 4; ++ks)
#pragma unroll
                    for (int i = 0; i < 4; ++i) qw[ks][i] = pk2(lo_bf(qw[ks][i]) * 0.125f, hi_bf(qw[ks][i]) * 0.125f);
#pragma unroll
                for (int ks = 0; ks < 4; ++ks) qf[ks] = __builtin_bit_cast(bf16x8, qw[ks]);
            }
            f32x16 sc[5];
#pragma unroll
            for (int kb = 0; kb < 5; ++kb) {
                f32x16 a;
#pragma unroll
                for (int i = 0; i < 16; ++i) a[i] = 0.f;
#pragma unroll
                for (int ks = 0; ks < 4; ++ks) { const bf16x8 kf = *(const LAS bf16x8*)(Ks + (q0 + 32 * kb + r) * 72 + 16 * ks + 8 * h); a = __builtin_amdgcn_mfma_f32_32x32x16_bf16(kf, qf[ks], a, 0, 0, 0); }
                sc[kb] = a;
            }
            float mx = sink;
#pragma unroll
            for (int kb = 0; kb < 5; ++kb)
#pragma unroll
                for (int i = 0; i < 16; ++i) { const int kr = 32 * kb + crow(i, h); const bool ok = (kr > r) && (kr <= r + 128) && ((nb > 0) || (q0 + kr >= 128));
                    const float s = ok ? sc[kb][i] : -INFINITY; sc[kb][i] = s; mx = fmaxf(mx, s); }
            mx = fmaxf(mx, xshfl(mx, F.lane ^ 32));
            float ls = 0.f;
#pragma unroll
            for (int kb = 0; kb < 5; ++kb)
#pragma unroll
                for (int i = 0; i < 16; ++i) { const float p = __expf(sc[kb][i] - mx); sc[kb][i] = p; ls += p; }
            ls += xshfl(ls, F.lane ^ 32);
            ls += __expf(sink - mx);
            const float inv = __builtin_amdgcn_rcpf(ls);
            f32x16 o[2];
#pragma unroll
            for (int db = 0; db < 2; ++db) {
                f32x16 a;
#pragma unroll
                for (int i = 0; i < 16; ++i) a[i] = 0.f;
#pragma unroll
                for (int kb = 0; kb < 5; ++kb)
#pragma unroll
                    for (int s = 0; s < 2; ++s) {
                        u32x4 pw;
#pragma unroll
                        for (int i = 0; i < 4; ++i) pw[i] = pk2(sc[kb][8 * s + 2 * i], sc[kb][8 * s + 2 * i + 1]);
                        const LAS bf16* vb = Vt + (db * 32 + r) * 264 + q0 + 32 * kb + 16 * s + 4 * h;
                        const s16x4 lo = *(const LAS s16x4*)vb, hi = *(const LAS s16x4*)(vb + 8);
                        const bf16x8 vf = __builtin_shufflevector(lo, hi, 0, 1, 2, 3, 4, 5, 6, 7);
                        a = __builtin_amdgcn_mfma_f32_32x32x16_bf16(vf, __builtin_bit_cast(bf16x8, pw), a, 0, 0, 0);
                    }
                o[db] = a;
            }
            bf16* yp = L_Y + (size_t)qtok * DM + 512 + qh * 64;
#pragma unroll
            for (int db = 0; db < 2; ++db)
#pragma unroll
                for (int gg = 0; gg < 4; ++gg) { u32x2 w; w.x = pk2(o[db][4 * gg] * inv, o[db][4 * gg + 1] * inv); w.y = pk2(o[db][4 * gg + 2] * inv, o[db][4 * gg + 3] * inv);
                    *(u32x2*)(yp + db * 32 + 8 * gg + 4 * h) = w; }
        }
    }
    __syncthreads();
}

__device__ __forceinline__ void final_norm(const Frame& F_in) {
    const Frame F = relaunder(F_in);
    float* const L_out = OUTP; const float* const L_norm_final = IN_F(20);
    for (int m0 = F.gw; m0 < M; m0 += 2 * F.ngw) {
        f32x4 v[2][4]; const f32x4* gr = (const f32x4*)L_norm_final + F.lane;
#pragma unroll
        for (int q = 0; q < 2; ++q) { const f32x4* xr = (const f32x4*)(L_out + (size_t)(m0 + q * F.ngw) * DM) + F.lane;
#pragma unroll
            for (int j = 0; j < 4; ++j) v[q][j] = xr[64 * j]; }
#pragma unroll
        for (int q = 0; q < 2; ++q) { f32x4* xr = (f32x4*)(L_out + (size_t)(m0 + q * F.ngw) * DM) + F.lane; float s = 0.f;
#pragma unroll
            for (int j = 0; j < 4; ++j) s += (v[q][j][0] * v[q][j][0] + v[q][j][1] * v[q][j][1]) + (v[q][j][2] * v[q][j][2] + v[q][j][3] * v[q][j][3]);
            const float rs = __builtin_amdgcn_rsqf(wave_sum(s, F.lane) * (1.0f / DM) + EPS);
#pragma unroll
            for (int j = 0; j < 4; ++j) xr[64 * j] = v[q][j] * rs * gr[64 * j]; }
    }
}

#define RLX_AGENT __ATOMIC_RELAXED, __HIP_MEMORY_SCOPE_AGENT
#define XB_TMO      128
#define XB_XCNT(j)  (256  + 64 * (j))
#define XB_XSUB(j)  (1280 + 64 * (j))
#define XB_XGEN(j)  (2304 + 64 * (j))
#define XB_TOP      3328
#define XB_TOPGEN   3392
#define XCD_BAR_WORDS 3456
#define XB_SPIN_CAP (1u << 18)

__device__ __forceinline__ unsigned xb_ld(unsigned* p)              { return __hip_atomic_load(p, __ATOMIC_RELAXED, __HIP_MEMORY_SCOPE_AGENT); }
__device__ __forceinline__ unsigned xb_add(unsigned* p, unsigned v) { return __hip_atomic_fetch_add(p, v, __ATOMIC_RELAXED, __HIP_MEMORY_SCOPE_AGENT); }
__device__ __forceinline__ unsigned xb_xcc_id() { return (unsigned)__builtin_amdgcn_s_getreg((3 << 11) | 20) & 0xFu; }
#define XB_SPIN(cond, bar) do { unsigned _sp = 0; while (cond) { __builtin_amdgcn_s_sleep(1); \
    if ((++_sp & 255u) == 0u) { if (xb_ld(&(bar)[XB_TMO])) break; if (_sp > XB_SPIN_CAP) { atomicAdd(&(bar)[XB_TMO], 1u); break; } } } } while (0)

struct XcdBarrier {
    unsigned* bar; unsigned x;
    volatile LAS unsigned* st;
};

__device__ __forceinline__ XcdBarrier xcd_barrier_post(unsigned* bar, volatile LAS unsigned* st, bool leader) {
    XcdBarrier b; b.bar = bar; b.x = xb_xcc_id(); b.st = st;
    if (leader) (void)xb_add(&bar[XB_XCNT(b.x)], 1u);
    return b;
}
__device__ __forceinline__ void xcd_barrier_complete(unsigned* bar, unsigned x, unsigned& nloc, unsigned& nx) {
    const unsigned G = gridDim.x * gridDim.y * gridDim.z;
    unsigned sum, cnt, mine, sp = 0u;
    for (;;) {
        sum = 0u; cnt = 0u; mine = 0u;
#pragma unroll
        for (unsigned j = 0; j < 16; ++j) { const unsigned c = xb_ld(&bar[XB_XCNT(j)]); sum += c; cnt += (c > 0u) ? 1u : 0u; mine = (j == x) ? c : mine; }
        if (sum == G) break;
        __builtin_amdgcn_s_sleep(1);
        if ((++sp & 255u) == 0u) { if (xb_ld(&bar[XB_TMO])) break; if (sp > XB_SPIN_CAP) { atomicAdd(&bar[XB_TMO], 1u); break; } }
    }
    nloc = mine > 0u ? mine : 1u; nx = cnt > 0u ? cnt : 1u;
}

__device__ __forceinline__ void xcd_barrier(const XcdBarrier& b, bool leader) {
    asm volatile("s_waitcnt vmcnt(0)" ::: "memory");
    __syncthreads();
    if (leader) {
        unsigned* bar = b.bar;
        __builtin_amdgcn_s_waitcnt(0);
        unsigned nloc = b.st[0], nx = b.st[1];
        if (nloc == 0u) { xcd_barrier_complete(bar, b.x, nloc, nx); b.st[0] = nloc; b.st[1] = nx; }
        const unsigned old = xb_add(&bar[XB_XSUB(b.x)], 1u);
        const unsigned gen = old / nloc;
        if (old + 1u == (gen + 1u) * nloc) {
            __builtin_amdgcn_fence(__ATOMIC_RELEASE, "agent");
            asm volatile("s_waitcnt vmcnt(0)" ::: "memory");
            const unsigned og = xb_add(&bar[XB_TOP], 1u);
            const unsigned tg = og / nx;
            if (og + 1u == (tg + 1u) * nx) xb_add(&bar[XB_TOPGEN], 1u);
            else XB_SPIN(xb_ld(&bar[XB_TOPGEN]) == tg, bar);
            __builtin_amdgcn_fence(__ATOMIC_ACQUIRE, "agent");
            xb_add(&bar[XB_XGEN(b.x)], 1u);
            asm volatile("s_waitcnt vmcnt(0)" ::: "memory");
        } else {
            XB_SPIN(xb_ld(&bar[XB_XGEN(b.x)]) == gen, bar);
            __builtin_amdgcn_fence(__ATOMIC_ACQUIRE, "agent");
            asm volatile("s_waitcnt vmcnt(0)" ::: "memory");
        }
    }
    __syncthreads();
}

__device__ __forceinline__ void gbar(const Frame& F_in, int) {
    XcdBarrier b; b.bar = (unsigned*)(WSP + WS_MISC + 65536); b.x = xb_xcc_id(); b.st = (volatile LAS unsigned*)(F_in.lds + LDS_BYTES);
    int w_ = F_in.wave; asm volatile("" : "+s"(w_));
    xcd_barrier(b, w_ == 0 && lane_id_asm() == 0);
}

__global__ void __launch_bounds__(NTHR, 2) hybrid_fwd(Args args) {
    extern __shared__ __attribute__((aligned(16))) unsigned char lds[];
    cg::grid_group grid = cg::this_grid();
    Frame F;
    F.lds = (LAS unsigned char*)lds;
    F.wave = __builtin_amdgcn_readfirstlane((int)threadIdx.x >> 6); F.tid = 0; F.lane = 0;
    F.G = gridDim.x; F.gw = blockIdx.x * NWAVES + F.wave; F.ngw = F.G * NWAVES;

    volatile LAS unsigned* xst = (volatile LAS unsigned*)(F.lds + LDS_BYTES);
    if (threadIdx.x < 16) xst[threadIdx.x] = 0u;
    __syncthreads();
    const int xb = 0; (void)xcd_barrier_post((unsigned*)(WSP + WS_MISC + 65536), xst, F.wave == 0 && lane_id_asm() == 0);
    convert_weights(F, 0, F.gw, F.ngw);
    p0_prologue(F);
    grid.sync();
#pragma unroll 1
    for (int l = 0; l < NL; ++l) {
#pragma unroll 1
        for (int op = 0; op < 6; ++op) {
            if (op == 1) {
                gbar(F, xb);
                gdn_prep(F, l);
                mlstm_prep(F, l);
                swa_phase(F, l, 0);
                gbar(F, xb);
                {
                    int c = (int)blockIdx.x; asm volatile("" : "+s"(c));
                    if (F.wave == 0) {
                        if (c < 128) gdn_scan(F, ((c & 7) + 8 * (c >> 5)) * 4 + ((c >> 3) & 3));
                        else { const int q = c - 128, j = q >> 3; mlstm_scan(F, ((q & 7) + 8 * (j / 5)) * 5 + (j % 5)); }
                    } else if (F.wave == 2 && c < 32) { const int q = 128 + c, j = q >> 3; mlstm_scan(F, ((q & 7) + 8 * (j / 5)) * 5 + (j % 5)); }
                    else if (F.wave >= 4 && l + 1 < NL) convert_weights(F, l + 1, c * 4 + (F.wave - 4), F.G * 4);
                }
                gbar(F, xb);
                m2_post(F, l);
            }
            if (op != 5 && (l | op) != 0) gbar(F, xb);
            unsigned char* const ws = WSP; unsigned char* const wb = ws + WS_W + (size_t)(l & 1) * W_LAYER; float* const outp = OUTP;
            float* const ssq0 = (float*)(ws + WS_SSQ); float* const ssq1 = ssq0 + (size_t)M * 16; float* const ssq2 = ssq0 + (size_t)2 * M * 16;
            bf16* const xb = (bf16*)(ws + WS_XB); unsigned char* const big = ws + WS_BIG;
            pg8::Gemm g; pg8::EpiAny E; g.M = M;
            bf16* const xalt = (bf16*)(big + 192 * MiB);
            const float* ssq_in = ssq0; E.rslots = (const LAS float*)(F.lds + 131072); E.cnt = 0; E.ssq_out = ssq0; E.base = outp; E.xout = outp; E.ob = xb; E.pp = (const bf16*)big; E.gates = (float*)(ws + WS_GATES);
            if (op == 0)      { g.A = l == 0 ? xb : xalt; g.Bt = (const bf16*)(wb + WO_IN); g.N = NPAD; g.K = DM; E.mode = 0; ssq_in = ssq0; E.ob = (bf16*)big; }
            else if (op == 1) { g.A = (const bf16*)(big + 176 * MiB); g.Bt = (const bf16*)(wb + WO_OUT); g.N = DM; g.K = DM; E.mode = 3; E.ssq_out = ssq1; if (l == 0) E.base = IN_F(0); }
            else if (op == 2) { g.A = xb; g.Bt = (const bf16*)(wb + WO_UP); g.N = FF; g.K = DM; E.mode = 1; ssq_in = ssq1; E.ob = (bf16*)big; }
            else if (op == 3) { g.A = (const bf16*)big; g.Bt = (const bf16*)(wb + WO_DOWN); g.N = DM; g.K = FF; E.mode = 3; E.ssq_out = ssq2; }
            else if (op == 4) { g.A = (const bf16*)(ws + WS_PB); g.Bt = (const bf16*)(wb + WO_P); g.N = DM; g.K = PLE; E.mode = 2; E.ob = (bf16*)big; }
            else              { g.A = xb; g.Bt = (const bf16*)(wb + WO_G); g.N = DM; g.K = DM; E.mode = 4; ssq_in = ssq2; E.ssq_out = ssq0; E.ob = xalt; }
            pg8::RstdOrder S; S.init(M, g.N, F.G, (int)blockIdx.x); S.ssq = ssq_in; S.need = (E.mode != 2 && E.mode != 3); S.wave_id = F.wave; S.slots = (LAS float*)(F.lds + 131072); S.cnt = 0;
#pragma unroll 1
            for (int rep = 0; rep < ((op == 0 || op == 2) ? REP_G : 1); ++rep)
            pg8::gemm_phase<pg8::EpiAny, pg8::RstdOrder, true, true>(F.lds, g, S, E, F.wave);
        }
    }
    gbar(F, xb);
    final_norm(F);
}

extern "C" void kernel_launch(void* const* d_in, const int* in_sizes, int n_in, void* d_out, int out_size, void* d_ws, size_t ws_size, hipStream_t stream) {
    static int grid = 0;
    if (grid == 0) {
        if (n_in != 21 || out_size != M * DM || ws_size < WS_END) { fprintf(stderr, "kernel_launch: unexpected shapes (n_in %d out %d ws %zu)\n", n_in, out_size, ws_size); grid = -1; return; }
        int dev = 0, cus = 0, per_cu = 0;
        hipGetDevice(&dev); hipDeviceGetAttribute(&cus, hipDeviceAttributeMultiprocessorCount, dev);
        hipFuncSetAttribute((const void*)hybrid_fwd, hipFuncAttributeMaxDynamicSharedMemorySize, LDS_BYTES + 64);
        hipOccupancyMaxActiveBlocksPerMultiprocessor(&per_cu, (const void*)hybrid_fwd, NTHR, LDS_BYTES + 64);
        (void)hipGetLastError();
        if (per_cu < 1) per_cu = 1;
        grid = cus;
        fprintf(stderr, "kernel_launch: cus %d per_cu %d grid %d ws %zu\n", cus, per_cu, grid, ws_size);
    }
    if (grid < 0) return;
    if (hipMemsetAsync((unsigned char*)d_ws + WS_MISC + 65536, 0, 16384, stream) != hipSuccess) { fprintf(stderr, "kernel_launch: memset failed\n"); return; }
    Args a{};
    for (int i = 0; i < 21; ++i) a.in[i] = d_in[i];
    a.out = (float*)d_out; a.ws = (unsigned char*)d_ws;
    void* kargs[] = {&a};
    hipError_t e = hipLaunchCooperativeKernel((const void*)hybrid_fwd, dim3(grid), dim3(NTHR), kargs, LDS_BYTES + 64, stream);
    if (e != hipSuccess) fprintf(stderr, "cooperative launch failed: %s (grid %d)\n", hipGetErrorString(e), grid);
}
```

```cpp
#include <hip/hip_runtime.h>
#include <hip/hip_cooperative_groups.h>
#include <cstdio>
#include <cstdint>
#include <cmath>
namespace pg8 {
#define PG8_LAS __attribute__((address_space(3)))
typedef unsigned short bf16_t;
typedef short bf16x8 __attribute__((ext_vector_type(8)));
typedef float f32x4 __attribute__((ext_vector_type(4)));
typedef unsigned u32x4 __attribute__((ext_vector_type(4)));
constexpr int BM = 256, BK = 64, HALF = 128, HTB = HALF * BK * 2  , STAGE_BYTES = 8 * HTB, NXCD = 8, WGM = 8;

__host__ __device__ __forceinline__ int lds_byte(int r, int c) { const int st = (r >> 4) * 2 + (c >> 5), rr = r & 15, cc = c & 31, ob = rr * 64 + cc * 2; return st * 1024 + (ob ^ (((ob >> 9) & 1) << 5)); }
__host__ __device__ __forceinline__ void stage_rc(int b, int& R, int& C) { const int st = b / 1024, sb = b % 1024, swz = sb ^ (((sb >> 9) & 1) << 5); R = (st >> 1) * 16 + swz / 64; C = (st & 1) * 32 + (swz % 64) / 2; }
__host__ __device__ __forceinline__ int perm32(int rho) { const int n = rho >> 4, i = rho & 15; return 8 * (i >> 2) + 4 * n + (i & 3); }

struct Unit { int pm, pn; };
struct Gemm { const bf16_t* A; const bf16_t* Bt; int M, N, K; };

struct StaticOrder {
    int nM, nN, nwg, G, c;
    __host__ __device__ void init(int M, int N, int G_, int c_) { nM = M / BM; nN = N / BM; nwg = nM * nN; G = G_; c = c_; }
    __host__ __device__ bool next(int i, Unit& u) const {
        const long L = (long)i * G + c; if (L >= nwg) return false;
        int wgid = (int)L; { const int q = nwg / NXCD, r = nwg % NXCD, xcd = wgid % NXCD, off = wgid / NXCD; wgid = (xcd < r ? xcd * (q + 1) : r * (q + 1) + (xcd - r) * q) + off; }
        const int nig = WGM * nN, gid = wgid / nig, fm = gid * WGM, gsz = (nM - fm) < WGM ? (nM - fm) : WGM;
        u.pm = fm + ((wgid % nig) % gsz); u.pn = (wgid % nig) / gsz; return true;
    }
    __device__ __forceinline__ void a_ready(const Unit&) const {}
    __device__ __forceinline__ void done(const Unit&) const {}
};


__device__ __forceinline__ unsigned cvt_pk_bf16(float lo, float hi) { unsigned r; asm volatile("v_cvt_pk_bf16_f32 %0, %1, %2" : "=v"(r) : "v"(lo), "v"(hi)); return r; }
typedef unsigned u32x2 __attribute__((ext_vector_type(2)));
constexpr float RMS_EPS = 1e-6f;
__device__ __forceinline__ float row_rstd(const float* ssq, int row) {
    const f32x4* p = (const f32x4*)(ssq + (size_t)row * 16);
    const f32x4 a = p[0], b = p[1], c = p[2], d = p[3];
    const float s = ((a[0] + a[1]) + (a[2] + a[3])) + ((b[0] + b[1]) + (b[2] + b[3])) + ((c[0] + c[1]) + (c[2] + c[3])) + ((d[0] + d[1]) + (d[2] + d[3]));
    return __builtin_amdgcn_rsqf(s * (1.0f / 1024.0f) + RMS_EPS);
}
struct RstdOrder : StaticOrder {
    const float* ssq; int need; int wave_id; PG8_LAS float* slots; mutable int cnt;
    __device__ __forceinline__ void a_ready(const Unit& u) const {
        if (need) {
            int ln; asm volatile("v_mbcnt_lo_u32_b32 %0, -1, 0\n\tv_mbcnt_hi_u32_b32 %0, -1, %0" : "=v"(ln));
            const int t = wave_id * 64 + ln;
            if (t < 256) slots[(cnt & 1) * 256 + t] = row_rstd(ssq, u.pm * BM + t);
        }
        ++cnt;
    }
};
struct EpiAny {
    static constexpr bool PERM = true, AFTER_DRAIN = false;
    int mode; float* ssq_out; const bf16_t* bhi; unsigned char* xl; bf16_t* ob; const bf16_t* pp; float* gates; const PG8_LAS float* rslots; mutable int cnt;
    __device__ __forceinline__ void operator()(const f32x4 (&acc)[2][2][4][2], const Unit& u, int wr, int wc, int fr, int fq) const {
        const int row0 = u.pm * BM + wr * 64 + fr; const int col0 = u.pn * BM + wc * 32 + 8 * fq;
        float rsv[2][4];
        if (mode != 2 && mode != 3) { const PG8_LAS float* rl = rslots + (cnt & 1) * 256 + wr * 64 + fr;
#pragma unroll
            for (int ai = 0; ai < 2; ++ai)
#pragma unroll
                for (int m = 0; m < 4; ++m) rsv[ai][m] = rl[ai * HALF + m * 16]; }
        else {
#pragma unroll
            for (int ai = 0; ai < 2; ++ai)
#pragma unroll
                for (int m = 0; m < 4; ++m) rsv[ai][m] = 1.f; }
        ++cnt;
        if (mode <= 2) {
            const int ld = mode == 0 ? 2816 : mode == 1 ? 4096 : 1024;
            if (mode != 0 || u.pn < 11) {
#pragma unroll
                for (int ai = 0; ai < 2; ++ai)
#pragma unroll
                    for (int m = 0; m < 4; ++m) { const int row = row0 + ai * HALF + m * 16; const float rs = rsv[ai][m]; bf16_t* rowp = ob + (size_t)row * ld + col0;
#pragma unroll
                        for (int bj = 0; bj < 2; ++bj) { f32x4 v0 = acc[ai][bj][m][0] * rs, v1 = acc[ai][bj][m][1] * rs;
                            if (mode == 1) {
#pragma unroll
                                for (int e = 0; e < 4; ++e) { const float a = fmaxf(v0[e], 0.f), b = fmaxf(v1[e], 0.f); v0[e] = a * a; v1[e] = b * b; } }
                            u32x4 w; w.x = cvt_pk_bf16(v0[0], v0[1]); w.y = cvt_pk_bf16(v0[2], v0[3]); w.z = cvt_pk_bf16(v1[0], v1[1]); w.w = cvt_pk_bf16(v1[2], v1[3]);
                            *(u32x4*)(rowp + bj * HALF) = w; }
                        if (m & 1) asm volatile("" ::: "memory"); }
            } else if (wc == 0 && fq < 2) {
#pragma unroll
                for (int ai = 0; ai < 2; ++ai)
#pragma unroll
                    for (int m = 0; m < 4; ++m) { const int row = row0 + ai * HALF + m * 16; const float rs = rsv[ai][m]; float* gp = gates + (size_t)row * 16 + 8 * fq;
                        *(f32x4*)(gp) = acc[ai][0][m][0] * rs; *(f32x4*)(gp + 4) = acc[ai][0][m][1] * rs; }
            }
        } else {
#pragma unroll
            for (int ap = 0; ap < 4; ++ap) { const int ai = ap >> 1, mb = (ap & 1) * 2;
                u32x4 hw[2][2], pw[2][2]; u32x2 lw[2][2];
#pragma unroll
                for (int mi = 0; mi < 2; ++mi) { const size_t off = (size_t)(row0 + ai * HALF + (mb + mi) * 16) * 1024 + col0;
#pragma unroll
                    for (int bj = 0; bj < 2; ++bj) { hw[mi][bj] = *(const u32x4*)(bhi + off + bj * HALF); lw[mi][bj] = *(const u32x2*)(xl + off + bj * HALF);
                        if (mode == 4) pw[mi][bj] = *(const u32x4*)(pp + off + bj * HALF); else pw[mi][bj] = (u32x4){0u, 0u, 0u, 0u}; } }
                asm volatile("" ::: "memory");
#pragma unroll
                for (int mi = 0; mi < 2; ++mi) { const int m = mb + mi; const int row = row0 + ai * HALF + m * 16; const size_t off = (size_t)row * 1024 + col0; const float rs = rsv[ai][m];
                    float s = 0.f;
#pragma unroll
                    for (int bj = 0; bj < 2; ++bj) {
                        f32x4 a0 = acc[ai][bj][m][0], a1 = acc[ai][bj][m][1];
                        if (mode == 4) { const u32x4 q = pw[mi][bj];
                            const f32x4 p0 = (f32x4){__uint_as_float(q.x << 16), __uint_as_float(q.x & 0xffff0000u), __uint_as_float(q.y << 16), __uint_as_float(q.y & 0xffff0000u)}, p1 = (f32x4){__uint_as_float(q.z << 16), __uint_as_float(q.z & 0xffff0000u), __uint_as_float(q.w << 16), __uint_as_float(q.w & 0xffff0000u)};
#pragma unroll
                            for (int e = 0; e < 4; ++e) { a0[e] = p0[e] * __builtin_amdgcn_rcpf(1.0f + __expf(-a0[e] * rs)); a1[e] = p1[e] * __builtin_amdgcn_rcpf(1.0f + __expf(-a1[e] * rs)); } }
                        const u32x4 h = hw[mi][bj]; const u32x2 lo8 = lw[mi][bj];
                        f32x4 o0 = (f32x4){__uint_as_float(h.x << 16), __uint_as_float(h.x & 0xffff0000u), __uint_as_float(h.y << 16), __uint_as_float(h.y & 0xffff0000u)};
                        f32x4 o1 = (f32x4){__uint_as_float(h.z << 16), __uint_as_float(h.z & 0xffff0000u), __uint_as_float(h.w << 16), __uint_as_float(h.w & 0xffff0000u)};
                        o0 += (f32x4){__builtin_amdgcn_cvt_f32_bf8((int)lo8.x, 0), __builtin_amdgcn_cvt_f32_bf8((int)lo8.x, 1), __builtin_amdgcn_cvt_f32_bf8((int)lo8.x, 2), __builtin_amdgcn_cvt_f32_bf8((int)lo8.x, 3)};
                        o1 += (f32x4){__builtin_amdgcn_cvt_f32_bf8((int)lo8.y, 0), __builtin_amdgcn_cvt_f32_bf8((int)lo8.y, 1), __builtin_amdgcn_cvt_f32_bf8((int)lo8.y, 2), __builtin_amdgcn_cvt_f32_bf8((int)lo8.y, 3)};
                        o0 += a0; o1 += a1;
                        u32x4 w; w.x = cvt_pk_bf16(o0[0], o0[1]); w.y = cvt_pk_bf16(o0[2], o0[3]); w.z = cvt_pk_bf16(o1[0], o1[1]); w.w = cvt_pk_bf16(o1[2], o1[3]);
                        *(u32x4*)(ob + off + bj * HALF) = w;
                        const f32x4 r0 = o0 - (f32x4){__uint_as_float(w.x << 16), __uint_as_float(w.x & 0xffff0000u), __uint_as_float(w.y << 16), __uint_as_float(w.y & 0xffff0000u)};
                        const f32x4 r1 = o1 - (f32x4){__uint_as_float(w.z << 16), __uint_as_float(w.z & 0xffff0000u), __uint_as_float(w.w << 16), __uint_as_float(w.w & 0xffff0000u)};
                        u32x2 lq; int t0_ = __builtin_amdgcn_cvt_pk_bf8_f32(r0[0], r0[1], 0, false); t0_ = __builtin_amdgcn_cvt_pk_bf8_f32(r0[2], r0[3], t0_, true);
                        int t1_ = __builtin_amdgcn_cvt_pk_bf8_f32(r1[0], r1[1], 0, false); t1_ = __builtin_amdgcn_cvt_pk_bf8_f32(r1[2], r1[3], t1_, true);
                        lq.x = (unsigned)t0_; lq.y = (unsigned)t1_;
                        *(u32x2*)(xl + off + bj * HALF) = lq;
                        s += ((o0[0] * o0[0] + o0[1] * o0[1]) + (o0[2] * o0[2] + o0[3] * o0[3])) + ((o1[0] * o1[0] + o1[1] * o1[1]) + (o1[2] * o1[2] + o1[3] * o1[3])); }
                    s += __int_as_float(__builtin_amdgcn_ds_bpermute(((fq ^ 1) * 16 + fr) << 2, __float_as_int(s))); s += __int_as_float(__builtin_amdgcn_ds_bpermute(((fq ^ 2) * 16 + fr) << 2, __float_as_int(s)));
                    if (fq == 0) ssq_out[(size_t)row * 16 + u.pn * 4 + wc] = s; }
                asm volatile("" ::: "memory");
            }
        }
    }
};

template <class Epi, class Sched, bool ALIGN_EPI = false, bool SP2 = false>
__device__ __forceinline__ void gemm_phase(PG8_LAS unsigned char* lds, const Gemm g, const Sched& S, const Epi& E, int wave_id) {
    int tid_; asm volatile("v_mbcnt_lo_u32_b32 %0, -1, 0\n\tv_mbcnt_hi_u32_b32 %0, -1, %0" : "=v"(tid_)); tid_ += wave_id * 64; const int tid = tid_, wid = __builtin_amdgcn_readfirstlane(tid >> 6), lane = tid & 63, wr = wid >> 2, wc = wid & 3, fr = lane & 15, fq = lane >> 4;
    const int K = g.K, nt = K / BK;
    unsigned voffA[2], voffB[2];
#pragma unroll
    for (int i = 0; i < 2; ++i) { int R, C; stage_rc(tid * 16 + i * 8192, R, C); const int Rb = Epi::PERM ? ((R & ~31) + perm32(R & 31)) : R;
        voffA[i] = (unsigned)(R * K + C) * 2u; voffB[i] = (unsigned)(Rb * K + C) * 2u; }
    const size_t kstep = (size_t)(BK * 2);
    const size_t hstep = (size_t)HALF * K * 2;
    const size_t tstep = 2 * hstep;
    const unsigned ldsw = (unsigned)wid * 1024u;
    const int aoff = lds_byte(wr * 64 + fr, fq * 8), boff = lds_byte(wc * 32 + fr, fq * 8);
#define PG8_SA(b, h) (((b) * 2 + (h)) * HTB)
#define PG8_SB(b, h) ((4 + (b) * 2 + (h)) * HTB)
#define PG8_STAGE(bufoff, gbase, voff) do { _Pragma("unroll") for (int _i = 0; _i < 2; ++_i) \
        __builtin_amdgcn_global_load_lds((const unsigned*)((const char*)(gbase) + (voff)[_i]), (PG8_LAS unsigned*)(lds + (bufoff) + ldsw + _i * 8192), 16, 0, 0); } while (0)
#define PG8_LDA(dst, b, h) do { _Pragma("unroll") for (int m = 0; m < 4; ++m) _Pragma("unroll") for (int k = 0; k < 2; ++k) dst[m][k] = *(const PG8_LAS bf16x8*)(lds + PG8_SA(b, h) + aoff + m * 2048 + k * 1024); } while (0)
#define PG8_LDB(dst, b, h) do { _Pragma("unroll") for (int n = 0; n < 2; ++n) _Pragma("unroll") for (int k = 0; k < 2; ++k) dst[n][k] = *(const PG8_LAS bf16x8*)(lds + PG8_SB(b, h) + boff + n * 2048 + k * 1024); } while (0)
#define PG8_MMA(ai, bj, At, Bt) do { __builtin_amdgcn_s_setprio(1); _Pragma("unroll") for (int m = 0; m < 4; ++m) _Pragma("unroll") for (int n = 0; n < 2; ++n) _Pragma("unroll") for (int k = 0; k < 2; ++k) \
        acc[ai][bj][m][n] = __builtin_amdgcn_mfma_f32_16x16x32_bf16(Bt[n][k], At[m][k], acc[ai][bj][m][n], 0, 0, 0); __builtin_amdgcn_s_setprio(0); } while (0)
#define PG8_WAIT_V(n) asm volatile("s_waitcnt vmcnt(" #n ")" ::: "memory")
#define PG8_WAIT_L(n) asm volatile("s_waitcnt lgkmcnt(" #n ")" ::: "memory")
#define PG8_BAR __builtin_amdgcn_s_barrier()
#define PG8_SCHED __builtin_amdgcn_sched_barrier(0)
    Unit cur, nxt; int ui = 0;
    if (!S.next(0, cur)) return;
    f32x4 acc[2][2][4][2];
#pragma unroll
    for (int a = 0; a < 2; ++a)
#pragma unroll
        for (int b = 0; b < 2; ++b)
#pragma unroll
            for (int m = 0; m < 4; ++m)
#pragma unroll
                for (int n = 0; n < 2; ++n) acc[a][b][m][n] = (f32x4){0.f, 0.f, 0.f, 0.f};
    bf16x8 At[4][2], B0[2][2], B1[2][2];
    const char* cA = (const char*)g.A + (size_t)cur.pm * tstep; const char* cB = (const char*)g.Bt + (size_t)cur.pn * tstep;
    S.a_ready(cur);
    if constexpr (SP2) {
        PG8_STAGE(PG8_SB(0, 0), cB, voffB); PG8_STAGE(PG8_SB(0, 1), cB + hstep, voffB); PG8_STAGE(PG8_SA(0, 0), cA, voffA); PG8_STAGE(PG8_SA(0, 1), cA + hstep, voffA);
        if (wr == 1) PG8_BAR;
        PG8_WAIT_V(2); PG8_BAR;
        PG8_STAGE(PG8_SB(1, 0), cB + kstep, voffB); PG8_STAGE(PG8_SA(1, 0), cA + kstep, voffA); PG8_STAGE(PG8_SB(1, 1), cB + hstep + kstep, voffB);
        PG8_WAIT_V(6); PG8_BAR;
    } else {
        PG8_STAGE(PG8_SB(0, 0), cB, voffB); PG8_STAGE(PG8_SA(0, 0), cA, voffA); PG8_STAGE(PG8_SB(0, 1), cB + hstep, voffB); PG8_STAGE(PG8_SA(0, 1), cA + hstep, voffA);
        if (wr == 1) PG8_BAR;
        PG8_WAIT_V(4); PG8_BAR;
        PG8_STAGE(PG8_SB(1, 0), cB + kstep, voffB); PG8_STAGE(PG8_SA(1, 0), cA + kstep, voffA); PG8_STAGE(PG8_SB(1, 1), cB + hstep + kstep, voffB);
        PG8_WAIT_V(6); PG8_BAR;
    }
    for (;;) {
        const bool has_next = S.next(ui + 1, nxt);
        const char* nA = has_next ? (const char*)g.A + (size_t)nxt.pm * tstep : cA; const char* nB = has_next ? (const char*)g.Bt + (size_t)nxt.pn * tstep : cB;
        for (int t = 0; t < nt; t += 2) {
            const bool last = (t == nt - 2);
            const char* a1 = cA + (size_t)(t + 1) * kstep;
            const char* a2 = last ? nA : cA + (size_t)(t + 2) * kstep; const char* b2 = last ? nB : cB + (size_t)(t + 2) * kstep;
            const char* a3 = a2 + kstep; const char* b3 = b2 + kstep;
            if (last && has_next) S.a_ready(nxt);
            if constexpr (SP2) {
            PG8_LDB(B0, 0, 0); PG8_LDB(B1, 0, 1); PG8_SCHED; PG8_LDA(At, 0, 0); PG8_STAGE(PG8_SA(1, 1), a1 + hstep, voffA);
            PG8_WAIT_V(8); PG8_WAIT_L(0); PG8_BAR; PG8_MMA(0, 0, At, B0); PG8_MMA(0, 1, At, B1); PG8_BAR; PG8_SCHED;
            PG8_LDA(At, 0, 1); PG8_STAGE(PG8_SB(0, 0), b2, voffB); PG8_STAGE(PG8_SB(0, 1), b2 + hstep, voffB); PG8_STAGE(PG8_SA(0, 0), a2, voffA);
            PG8_WAIT_V(8); PG8_WAIT_L(0); PG8_BAR; PG8_MMA(1, 0, At, B0); PG8_MMA(1, 1, At, B1); PG8_BAR; PG8_SCHED;
            PG8_LDB(B0, 1, 0); PG8_LDB(B1, 1, 1); PG8_SCHED; PG8_LDA(At, 1, 0); PG8_STAGE(PG8_SA(0, 1), a2 + hstep, voffA);
            PG8_WAIT_V(8); PG8_WAIT_L(0); PG8_BAR; PG8_MMA(0, 0, At, B0); PG8_MMA(0, 1, At, B1); PG8_BAR; PG8_SCHED;
            PG8_LDA(At, 1, 1); PG8_STAGE(PG8_SB(1, 0), b3, voffB); PG8_STAGE(PG8_SB(1, 1), b3 + hstep, voffB); PG8_STAGE(PG8_SA(1, 0), a3, voffA);
            PG8_WAIT_V(8); PG8_WAIT_L(0); PG8_BAR; PG8_MMA(1, 0, At, B0); PG8_MMA(1, 1, At, B1); PG8_BAR; PG8_SCHED;
            } else {
            PG8_LDB(B0, 0, 0); PG8_SCHED; PG8_LDA(At, 0, 0); PG8_STAGE(PG8_SA(1, 1), a1 + hstep, voffA);
            PG8_WAIT_L(8); PG8_BAR; PG8_WAIT_L(0); PG8_MMA(0, 0, At, B0); PG8_BAR; PG8_SCHED;
            PG8_LDB(B1, 0, 1); PG8_STAGE(PG8_SB(0, 0), b2, voffB);
            PG8_BAR; PG8_WAIT_L(0); PG8_MMA(0, 1, At, B1); PG8_BAR;
            PG8_LDA(At, 0, 1); PG8_STAGE(PG8_SA(0, 0), a2, voffA);
            PG8_BAR; PG8_WAIT_L(0); PG8_MMA(1, 0, At, B0); PG8_BAR; PG8_SCHED;
            PG8_STAGE(PG8_SB(0, 1), b2 + hstep, voffB);
            PG8_WAIT_V(6); PG8_BAR; PG8_MMA(1, 1, At, B1); PG8_BAR;
            PG8_LDB(B0, 1, 0); PG8_SCHED; PG8_LDA(At, 1, 0); PG8_STAGE(PG8_SA(0, 1), a2 + hstep, voffA);
            PG8_WAIT_L(8); PG8_BAR; PG8_WAIT_L(0); PG8_MMA(0, 0, At, B0); PG8_BAR; PG8_SCHED;
            PG8_LDB(B1, 1, 1); PG8_STAGE(PG8_SB(1, 0), b3, voffB);
            PG8_BAR; PG8_WAIT_L(0); PG8_MMA(0, 1, At, B1); PG8_BAR;
            PG8_LDA(At, 1, 1); PG8_STAGE(PG8_SA(1, 0), a3, voffA);
            PG8_BAR; PG8_WAIT_L(0); PG8_MMA(1, 0, At, B0); PG8_BAR; PG8_SCHED;
            PG8_STAGE(PG8_SB(1, 1), b3 + hstep, voffB);
            PG8_WAIT_V(6); PG8_BAR; PG8_MMA(1, 1, At, B1); PG8_BAR;
            }
        }
        if constexpr (ALIGN_EPI) { if (wr == 0) PG8_BAR; }
        if constexpr (!Epi::AFTER_DRAIN) { E(acc, cur, wr, wc, fr, fq); S.done(cur); }
        if (!has_next) break;
#pragma unroll
        for (int a = 0; a < 2; ++a)
#pragma unroll
            for (int b = 0; b < 2; ++b)
#pragma unroll
                for (int m = 0; m < 4; ++m)
#pragma unroll
                    for (int n = 0; n < 2; ++n) acc[a][b][m][n] = (f32x4){0.f, 0.f, 0.f, 0.f};
        cur = nxt; cA = nA; cB = nB; ++ui;
        if constexpr (ALIGN_EPI) { if (wr == 1) PG8_BAR; }
    }
    PG8_WAIT_V(0);
    if constexpr (!ALIGN_EPI) { if (wr == 0) PG8_BAR; }
    PG8_BAR;
    if constexpr (Epi::AFTER_DRAIN) { E.fused(acc, cur, wr, wc, fr, fq, lds, wid, lane); S.done(cur); }
#undef PG8_SA
#undef PG8_SB
#undef PG8_STAGE
#undef PG8_LDA
#undef PG8_LDB
#undef PG8_MMA
#undef PG8_WAIT_V
#undef PG8_WAIT_L
#undef PG8_BAR
#undef PG8_SCHED
}
}

namespace cg = cooperative_groups;
#define LAS __attribute__((address_space(3)))
typedef unsigned short bf16;
typedef float f32x4 __attribute__((ext_vector_type(4)));
typedef float f32x16 __attribute__((ext_vector_type(16)));
typedef short bf16x8 __attribute__((ext_vector_type(8)));
typedef short s16x4 __attribute__((ext_vector_type(4)));
typedef unsigned u32x4 __attribute__((ext_vector_type(4)));
typedef unsigned u32x2 __attribute__((ext_vector_type(2)));

constexpr int NWAVES = 8, NTHR = 512;
constexpr int BATCH = 8, SEQ = 4096, DM = 1024, M = BATCH * SEQ, NL = 4, FF = 4096, PLE = 256;
constexpr int NPROJ = 2816, NPAD = 3072, INC = 2832;
constexpr float EPS = 1e-6f;
constexpr int LDS_BYTES = 147456;
constexpr int PF_D = 4;
constexpr int REP_MIX = 1, REP_G = 1, REP_BAR = 1, REP_P1 = 1, REP_P2 = 2, REP_P3 = 1;

constexpr size_t MiB = 1u << 20;
constexpr size_t W_LAYER = 27 * MiB;
constexpr size_t WO_IN = 0, WO_OUT = 6 * MiB, WO_UP = 8 * MiB, WO_DOWN = 16 * MiB, WO_G = 24 * MiB, WO_P = 26 * MiB;
constexpr size_t WS_W = 0;
constexpr size_t WS_XL = 54 * MiB;
constexpr size_t WS_XB = 108 * MiB;
constexpr size_t WS_SSQ = 172 * MiB;
constexpr size_t WS_ROPE = 178 * MiB;
constexpr size_t WS_GATES = 180 * MiB;
constexpr size_t WS_PB = 182 * MiB;
constexpr size_t WS_QKVC = 198 * MiB;
constexpr size_t WS_BIG = 246 * MiB;
constexpr size_t WS_MISC = 502 * MiB;
constexpr size_t WS_END = 503 * MiB;
constexpr size_t WS_MLB = WS_XB;
constexpr int GU_W = 0, GU_QD = 4096, GU_KD = 8192, GU_U = 12288, GU_QK = 16384, GU_STRIDE = 19456;
constexpr int GDN_NA = 1724;
constexpr int WAVE_LDS = 18432;
constexpr int MU_QB = 0, MU_PT = 4096, MU_KW = 8192, MU_VB = 12288, MU_STRIDE = 16384;

struct Args { const void* in[21]; float* out; unsigned char* ws; };

struct Frame {
    LAS unsigned char* lds;
    int tid, lane, wave, G, gw, ngw;
};
typedef const __attribute__((address_space(4))) void* kptr_t;
__device__ __forceinline__ const void* karg(int i) {
    kptr_t kp = (kptr_t)__builtin_amdgcn_kernarg_segment_ptr();
    asm volatile("" : "+s"(kp));
    return ((const void* const __attribute__((address_space(4)))*)kp)[i];
}
__device__ __forceinline__ int lane_id_asm();
__device__ __forceinline__ Frame relaunder(const Frame& f) {
    Frame r = f;
    r.lane = lane_id_asm(); r.tid = r.wave * 64 + r.lane;
    asm volatile("" : "+v"(r.tid), "+v"(r.lane));
    asm volatile("" : "+s"(r.wave), "+s"(r.gw), "+s"(r.ngw), "+s"(r.G));
    return r;
}
#define IN_F(i) ((const float*)karg(i))
#define OUTP ((float*)karg(21))
#define WSP ((unsigned char*)karg(22))

__device__ __forceinline__ float bf2f(unsigned short b) { return __uint_as_float((unsigned)b << 16); }
typedef float f32x2_t __attribute__((ext_vector_type(2))); typedef __bf16 bf16x2_t __attribute__((ext_vector_type(2)));
__device__ __forceinline__ unsigned pk2(float lo, float hi) { f32x2_t v = {lo, hi}; bf16x2_t b = __builtin_convertvector(v, bf16x2_t); return __builtin_bit_cast(unsigned, b); }
__device__ __forceinline__ unsigned f2bf(float f) { return pk2(f, 0.f) & 0xffffu; }
__device__ __forceinline__ float lo_bf(unsigned w) { return __uint_as_float(w << 16); }
__device__ __forceinline__ float hi_bf(unsigned w) { return __uint_as_float(w & 0xffff0000u); }
__device__ __forceinline__ int lane_id_asm() { int l; asm volatile("v_mbcnt_lo_u32_b32 %0, -1, 0\n\tv_mbcnt_hi_u32_b32 %0, -1, %0" : "=v"(l)); return l; }
__device__ __forceinline__ float xshfl(float v, int src_lane) { return __int_as_float(__builtin_amdgcn_ds_bpermute(src_lane << 2, __float_as_int(v))); }
__device__ __forceinline__ unsigned xshflu(unsigned v, int src_lane) { return (unsigned)__builtin_amdgcn_ds_bpermute(src_lane << 2, (int)v); }
__device__ __forceinline__ float wave_sum(float v, int lane) {
#pragma unroll
    for (int o = 1; o < 64; o <<= 1) v += xshfl(v, lane ^ o);
    return v;
}
#define LDS_WAIT() asm volatile("s_waitcnt lgkmcnt(0)" ::: "memory")
__device__ __forceinline__ float sigmoidf_(float x) { return __builtin_amdgcn_rcpf(1.0f + __expf(-x)); }
__device__ __forceinline__ float softplusf_(float x) { return fmaxf(x, 0.f) + log1pf(__expf(-fabsf(x))); }
__device__ __forceinline__ float sum8(float v) {
    v += __int_as_float(__builtin_amdgcn_update_dpp(0, __float_as_int(v), 0xB1, 0xF, 0xF, true));
    v += __int_as_float(__builtin_amdgcn_update_dpp(0, __float_as_int(v), 0x4E, 0xF, 0xF, true));
    v += __int_as_float(__builtin_amdgcn_update_dpp(0, __float_as_int(v), 0x141, 0xF, 0xF, true));
    return v;
}

__device__ __forceinline__ int win_src_col(int n) {
    if (n < 1024) return n;
    if (n < 2048) return n + 8;
    if (n < 2816) return n + 16;
    if (n < 2824) return 1024 + (n - 2816);
    if (n < 2832) return 2056 + (n - 2824);
    return -1;
}
template <int MAP>
__device__ __forceinline__ void transpose_item(const float* W, int K, int N, bf16* WT, const float* gain, LAS float* scr, int kb, int nb, int lane) {
    const int k0 = 64 * kb, n0 = 32 * nb;
    const int nd = n0 + (lane & 31);
    const int ns = MAP ? win_src_col(nd) : nd;
#pragma unroll 8
    for (int i = 0; i < 32; ++i) { const int kk = 2 * i + (lane >> 5); float v = 0.f; if (ns >= 0) v = W[(size_t)(k0 + kk) * N + ns]; if (gain) v *= gain[k0 + kk]; scr[kk * 33 + (lane & 31)] = v; }
    LDS_WAIT(); asm volatile("" ::: "memory");
    const int c = lane & 7;
#pragma unroll
    for (int j = 0; j < 4; ++j) { const int n = (lane >> 3) + 8 * j; const LAS float* s = scr + (8 * c) * 33 + n;
        u32x4 o; o.x = pk2(s[0 * 33], s[1 * 33]); o.y = pk2(s[2 * 33], s[3 * 33]); o.z = pk2(s[4 * 33], s[5 * 33]); o.w = pk2(s[6 * 33], s[7 * 33]);
        *(u32x4*)(WT + (size_t)(n0 + n) * K + k0 + 8 * c) = o; }
    LDS_WAIT(); asm volatile("" ::: "memory");
}
__device__ __forceinline__ void convert_weights(const Frame& F_in, int l, int idx, int nidx) {
    const Frame F = relaunder(F_in);
    unsigned char* const L_ws = WSP; const float* const L_w_in = IN_F(3); const float* const L_w_out = IN_F(12); const float* const L_w_up = IN_F(15); const float* const L_w_down = IN_F(16); const float* const L_w_g = IN_F(18); const float* const L_w_p = IN_F(19);
    const float* const L_norm_mix = IN_F(13); const float* const L_norm_mlp = IN_F(14); const float* const L_norm_ple = IN_F(17);
    LAS float* scr = (LAS float*)(F.lds + F.wave * 16384);
    constexpr int I_IN = 16 * 96, I_OUT = 16 * 32, I_UP = 16 * 128, I_DOWN = 64 * 32, I_G = 16 * 32, I_P = 4 * 32;
    constexpr int I_LAYER = I_IN + I_OUT + I_UP + I_DOWN + I_G + I_P;
    unsigned char* wb = L_ws + WS_W + (size_t)(l & 1) * W_LAYER;
    for (int it = idx; it < I_LAYER; it += nidx) {
        int r = it;
        if (r < I_IN) { transpose_item<1>(L_w_in + (size_t)l * DM * INC, DM, INC, (bf16*)(wb + WO_IN), L_norm_mix + l * DM, scr, r / 96, r % 96, F.lane); continue; } r -= I_IN;
        if (r < I_OUT) { transpose_item<0>(L_w_out + (size_t)l * DM * DM, DM, DM, (bf16*)(wb + WO_OUT), nullptr, scr, r / 32, r % 32, F.lane); continue; } r -= I_OUT;
        if (r < I_UP) { transpose_item<0>(L_w_up + (size_t)l * DM * FF, DM, FF, (bf16*)(wb + WO_UP), L_norm_mlp + l * DM, scr, r / 128, r % 128, F.lane); continue; } r -= I_UP;
        if (r < I_DOWN) { transpose_item<0>(L_w_down + (size_t)l * FF * DM, FF, DM, (bf16*)(wb + WO_DOWN), nullptr, scr, r / 32, r % 32, F.lane); continue; } r -= I_DOWN;
        if (r < I_G) { transpose_item<0>(L_w_g + (size_t)l * DM * DM, DM, DM, (bf16*)(wb + WO_G), L_norm_ple + l * DM, scr, r / 32, r % 32, F.lane); continue; } r -= I_G;
        transpose_item<0>(L_w_p + (size_t)l * PLE * DM, PLE, DM, (bf16*)(wb + WO_P), nullptr, scr, r / 32, r % 32, F.lane);
    }
}
__device__ __forceinline__ void p0_prologue(const Frame& F_in) {
    const Frame F = relaunder(F_in);
    unsigned char* const L_ws = WSP; const float* const L_in_x = IN_F(0); const int* const L_in_pos = (const int*)karg(2);
    bf16* const L_XB = (bf16*)(L_ws + WS_XB); float* const L_SSQ = (float*)(L_ws + WS_SSQ); float* const L_ROPE = (float*)(L_ws + WS_ROPE);
    for (int m0 = F.gw; m0 < M; m0 += 2 * F.ngw) {
        f32x4 v[2][4];
#pragma unroll
        for (int q = 0; q < 2; ++q) { const f32x4* xr = (const f32x4*)(L_in_x + (size_t)(m0 + q * F.ngw) * DM) + F.lane;
#pragma unroll
            for (int j = 0; j < 4; ++j) v[q][j] = xr[64 * j]; }
#pragma unroll
        for (int q = 0; q < 2; ++q) { const int m = m0 + q * F.ngw; float s = 0.f;
            unsigned long long* o8 = (unsigned long long*)(L_XB + (size_t)m * DM) + F.lane;
#pragma unroll
            for (int j = 0; j < 4; ++j) { const f32x4 w = v[q][j]; s += (w[0] * w[0] + w[1] * w[1]) + (w[2] * w[2] + w[3] * w[3]);
                const unsigned h0 = pk2(w[0], w[1]), h1 = pk2(w[2], w[3]);
                o8[64 * j] = (unsigned long long)h0 | ((unsigned long long)h1 << 32);
                int lq = __builtin_amdgcn_cvt_pk_bf8_f32(w[0] - lo_bf(h0), w[1] - hi_bf(h0), 0, false); lq = __builtin_amdgcn_cvt_pk_bf8_f32(w[2] - lo_bf(h1), w[3] - hi_bf(h1), lq, true);
                ((unsigned*)(L_ws + WS_XL + (size_t)m * DM))[64 * j + F.lane] = (unsigned)lq; }
            s = wave_sum(s, F.lane);
            if (F.lane < 16) L_SSQ[(size_t)m * 16 + F.lane] = (F.lane == 0) ? s : 0.f; }
    }
    for (int i = F.gw * 64 + F.lane; i < M * 8; i += F.ngw * 64) {
        const int t = i >> 3, j = i & 7;
        const float inv = (float)exp(-(double)(2 * j) / 16.0 * 13.122363377404328);
        const float ang = (float)L_in_pos[t] * inv;
        const double a = (double)ang; const double rev = a * 0.15915494309189535; const double fr = rev - floor(rev + 0.5);
        const float rad = (float)(fr * 6.283185307179586);
        L_ROPE[i] = cosf(rad); L_ROPE[(size_t)M * 8 + i] = sinf(rad);
    }
}

#define MFMA16(a, b, c) __builtin_amdgcn_mfma_f32_16x16x32_bf16((a), (b), (c), 0, 0, 0)
__device__ __forceinline__ int kperm(int ks, int g, int j) { return 32 * ks + 16 * (j >> 2) + 4 * g + (j & 3); }
__device__ __forceinline__ bf16x8 pack_tiles(const f32x4& a, const f32x4& b) { u32x4 w; w.x = pk2(a[0], a[1]); w.y = pk2(a[2], a[3]); w.z = pk2(b[0], b[1]); w.w = pk2(b[2], b[3]); return __builtin_bit_cast(bf16x8, w); }

__device__ __forceinline__ bf16* gdn_ubuf(unsigned char* ws, int unit) {
    return unit < GDN_NA ? (bf16*)(ws + WS_PB) + (size_t)unit * GU_STRIDE : (bf16*)(ws + WS_BIG + 240 * MiB) + (size_t)(unit - GDN_NA) * GU_STRIDE;
}
__device__ __forceinline__ int qk_idx(int tt, int ks) { return tt < 2 ? tt : 2 + (tt - 2) * 2 + ks; }
__device__ __forceinline__ bf16x8 conv8(const bf16* PROJ, size_t tok, int sp, int ch0, const f32x4 (&w)[4][2]) {
    float a[8];
#pragma unroll
    for (int j = 0; j < 8; ++j) a[j] = 0.f;
#pragma unroll
    for (int tap = 0; tap < 4; ++tap) if (sp - 3 + tap >= 0) {
        const u32x4 raw = *(const u32x4*)(PROJ + (tok - 3 + tap) * NPROJ + ch0);
#pragma unroll
        for (int i = 0; i < 4; ++i) { a[2 * i] += w[tap][i >> 1][(2 * i) & 3] * lo_bf(raw[i]); a[2 * i + 1] += w[tap][i >> 1][(2 * i + 1) & 3] * hi_bf(raw[i]); }
    }
    u32x4 o;
#pragma unroll
    for (int i = 0; i < 4; ++i) o[i] = pk2(a[2 * i] * sigmoidf_(a[2 * i]), a[2 * i + 1] * sigmoidf_(a[2 * i + 1]));
    return __builtin_bit_cast(bf16x8, o);
}
__device__ __forceinline__ void solve64(float (&x)[64], const LAS float* Lm) {
#pragma unroll
    for (int c = 1; c < 64; ++c) {
        int one = 1; asm volatile("" : "+s"(one));
        if (one) {
            float a = x[c];
#pragma unroll
            for (int s4 = 0; s4 < (c + 3) / 4; ++s4) { const f32x4 lv = *(const LAS f32x4*)(Lm + c * 64 + 4 * s4);
#pragma unroll
                for (int i = 0; i < 4; ++i) if (4 * s4 + i < c) a -= lv[i] * x[4 * s4 + i]; }
            x[c] = a;
        }
    }
}
__device__ __forceinline__ void gdn_prep(const Frame& F_in, int l) {
    const Frame F = relaunder(F_in);
    unsigned char* const L_ws = WSP; const float* const cw = IN_F(4) + (size_t)l * 4 * 768; const float* const L_a_log = IN_F(5); const float* const L_dt_bias = IN_F(6);
    const bf16* const PROJ = (const bf16*)(L_ws + WS_BIG); const float* const GATES = (const float*)(L_ws + WS_GATES); float* const GL = (float*)(L_ws + WS_MISC) + 2048;
    LAS float* Lm = (LAS float*)(F.lds + F.wave * WAVE_LDS);
    LAS bf16* T = (LAS bf16*)Lm;
    LAS float* gcv = Lm + 4096; LAS float* bkv = gcv + 64; LAS float* rkv = gcv + 128; LAS float* qdf = gcv + 192; LAS float* wfv = gcv + 256; LAS float* kdf = gcv + 320; LAS float* btv = gcv + 384;
    int g, m, lane;
#define RELANE() do { int ln_ = F.lane; asm volatile("" : "+v"(ln_)); lane = ln_; g = ln_ >> 4; m = ln_ & 15; } while (0)
    for (int unit = F.gw; unit < 2048; unit += F.ngw) {
        RELANE();
        const int h = (unit >> 6) & 3, n = unit & 63; const size_t t0 = (size_t)(unit >> 8) * SEQ + (size_t)n * 64;
        bf16* const ub = gdn_ubuf(L_ws, unit);
        float gl, gc_own, beta_own;
        {
            const float* gr = GATES + (t0 + lane) * 16;
            beta_own = sigmoidf_(gr[h]);
            float gs = -__expf(L_a_log[l * 4 + h]) * softplusf_(gr[4 + h] + L_dt_bias[l * 4 + h]);
#pragma unroll
            for (int o = 1; o < 64; o <<= 1) { const float t = xshfl(gs, lane >= o ? lane - o : lane); if (lane >= o) gs += t; }
            gc_own = gs; gl = __int_as_float(__builtin_amdgcn_readlane(__float_as_int(gs), 63));
            gcv[lane] = gs; btv[lane] = beta_own;
        }
        RELANE();
        bf16x8 FQ[4][2], FK[4][2];
#pragma unroll
        for (int ks = 0; ks < 2; ++ks) {
            f32x4 wq[4][2], wk[4][2];
#pragma unroll
            for (int tap = 0; tap < 4; ++tap) { const float* wp = cw + tap * 768 + h * 64 + 32 * ks + 8 * g; wq[tap][0] = *(const f32x4*)wp; wq[tap][1] = *(const f32x4*)(wp + 4); wk[tap][0] = *(const f32x4*)(wp + 256); wk[tap][1] = *(const f32x4*)(wp + 260); }
#pragma unroll
            for (int mp = 0; mp < 2; ++mp) { int one_ = 1; asm volatile("" : "+s"(one_)); if (one_) {
#pragma unroll
                for (int mq = 0; mq < 2; ++mq) { const int mt = 2 * mp + mq;
                FQ[mt][ks] = conv8(PROJ, t0 + 16 * mt + m, 64 * n + 16 * mt + m, h * 64 + 32 * ks + 8 * g, wq);
                FK[mt][ks] = conv8(PROJ, t0 + 16 * mt + m, 64 * n + 16 * mt + m, 256 + h * 64 + 32 * ks + 8 * g, wk); }
            } }
        }
        RELANE();
#pragma unroll
        for (int tt = 0; tt < 4; ++tt) {
            f32x4 ak = (f32x4){0.f, 0.f, 0.f, 0.f}, aq = ak;
            ak = MFMA16(FK[tt][0], FK[tt][0], ak); ak = MFMA16(FK[tt][1], FK[tt][1], ak);
            aq = MFMA16(FQ[tt][0], FQ[tt][0], aq); aq = MFMA16(FQ[tt][1], FQ[tt][1], aq);
            const int r = m & 3;
            const float dk_ = r == 0 ? ak[0] : r == 1 ? ak[1] : r == 2 ? ak[2] : ak[3];
            const float dq_ = r == 0 ? aq[0] : r == 1 ? aq[1] : r == 2 ? aq[2] : aq[3];
            if ((m >> 2) == g) { rkv[16 * tt + m] = __builtin_amdgcn_rsqf(dk_ + EPS); qdf[16 * tt + m] = 0.125f * __builtin_amdgcn_rsqf(dq_ + EPS); }
        }
        LDS_WAIT(); asm volatile("" ::: "memory");
        RELANE();
        {
            const float rk = rkv[lane], rq = qdf[lane];
            LDS_WAIT(); asm volatile("" ::: "memory");
            bkv[lane] = beta_own * rk; wfv[lane] = beta_own * rk * __expf(gc_own); kdf[lane] = rk * __expf(gl - gc_own); qdf[lane] = rq;
        }
        LDS_WAIT(); asm volatile("" ::: "memory");
        RELANE();
#pragma unroll
        for (int tt = 0; tt < 4; ++tt) { int one_ = 1; asm volatile("" : "+s"(one_)); if (one_) {
            const float gct = gcv[16 * tt + m], rqt = qdf[16 * tt + m];
#pragma unroll
            for (int ks = 0; ks < 2; ++ks) if (2 * ks <= tt) {
                u32x4 ow = (u32x4){0u, 0u, 0u, 0u};
#pragma unroll
                for (int hf = 0; hf < 2; ++hf) { const int st = 2 * ks + hf;
                    if (st <= tt) {
                        f32x4 acc = (f32x4){0.f, 0.f, 0.f, 0.f};
                        acc = MFMA16(FK[st][0], FQ[tt][0], acc); acc = MFMA16(FK[st][1], FQ[tt][1], acc);
                        const f32x4 gcs = *(const LAS f32x4*)(gcv + 16 * st + 4 * g), rks = *(const LAS f32x4*)(rkv + 16 * st + 4 * g);
                        float v[4];
#pragma unroll
                        for (int r = 0; r < 4; ++r) { const int sI = 16 * st + 4 * g + r, tI = 16 * tt + m; v[r] = (sI <= tI) ? acc[r] * rqt * rks[r] * __expf(gct - gcs[r]) : 0.f; }
                        ow[2 * hf] = pk2(v[0], v[1]); ow[2 * hf + 1] = pk2(v[2], v[3]);
                    } }
                *(u32x4*)(ub + GU_QK + (qk_idx(tt, ks) * 64 + lane) * 8) = ow;
            }
        } }
        RELANE();
#pragma unroll
        for (int mt = 0; mt < 4; ++mt)
#pragma unroll
            for (int ks = 0; ks < 2; ++ks) *(LAS bf16x8*)(T + (16 * mt + m) * 72 + 32 * ks + 8 * g) = FQ[mt][ks];
        LDS_WAIT(); asm volatile("" ::: "memory");
#pragma unroll
        for (int mt = 0; mt < 4; ++mt) {
            const float f = qdf[16 * mt + m] * __expf(gcv[16 * mt + m]);
#pragma unroll
            for (int ks = 0; ks < 2; ++ks) {
                const u32x2 lo = *(const LAS u32x2*)(T + (16 * mt + m) * 72 + 32 * ks + 4 * g), hi = *(const LAS u32x2*)(T + (16 * mt + m) * 72 + 32 * ks + 16 + 4 * g);
                u32x4 ow; ow.x = pk2(lo_bf(lo.x) * f, hi_bf(lo.x) * f); ow.y = pk2(lo_bf(lo.y) * f, hi_bf(lo.y) * f); ow.z = pk2(lo_bf(hi.x) * f, hi_bf(hi.x) * f); ow.w = pk2(lo_bf(hi.y) * f, hi_bf(hi.y) * f);
                *(u32x4*)(ub + GU_QD + ((mt * 2 + ks) * 64 + lane) * 8) = ow;
            }
        }
        LDS_WAIT(); asm volatile("" ::: "memory");
        RELANE();
        float xw[64];
        {
            const int chk = 256 + h * 64 + lane;
            const float k0 = cw[chk], k1 = cw[768 + chk], k2 = cw[1536 + chk], k3 = cw[2304 + chk];
            float ka = 0.f, kb = 0.f, kc = 0.f;
            if (n > 0) { ka = bf2f(PROJ[(t0 - 3) * NPROJ + chk]); kb = bf2f(PROJ[(t0 - 2) * NPROJ + chk]); kc = bf2f(PROJ[(t0 - 1) * NPROJ + chk]); }
            unsigned short kr[64];
#pragma unroll
            for (int c = 0; c < 64; ++c) kr[c] = PROJ[(t0 + c) * NPROJ + chk];
            asm volatile("" ::: "memory");
#pragma unroll
            for (int c4 = 0; c4 < 16; ++c4) {
                const f32x4 wf4 = *(const LAS f32x4*)(wfv + 4 * c4), kd4 = *(const LAS f32x4*)(kdf + 4 * c4);
                float kt[4];
#pragma unroll
                for (int i = 0; i < 4; ++i) { const int c = 4 * c4 + i; const float kd_ = bf2f(kr[c]);
                    float ak = k0 * ka + k1 * kb + k2 * kc + k3 * kd_; ak = ak * sigmoidf_(ak); ka = kb; kb = kc; kc = kd_;
                    xw[c] = ak * wf4[i]; kt[i] = ak * kd4[i]; }
                u32x2 w2; w2.x = pk2(kt[0], kt[1]); w2.y = pk2(kt[2], kt[3]);
                *(LAS u32x2*)(T + lane * 72 + 4 * c4) = w2;
            }
        }
        LDS_WAIT(); asm volatile("" ::: "memory");
        RELANE();
#pragma unroll
        for (int dt = 0; dt < 4; ++dt)
#pragma unroll
            for (int ks = 0; ks < 2; ++ks) {
                const u32x2 lo = *(const LAS u32x2*)(T + (16 * dt + m) * 72 + 32 * ks + 4 * g), hi = *(const LAS u32x2*)(T + (16 * dt + m) * 72 + 32 * ks + 16 + 4 * g);
                u32x4 ow; ow.x = lo.x; ow.y = lo.y; ow.z = hi.x; ow.w = hi.y;
                *(u32x4*)(ub + GU_KD + ((dt * 2 + ks) * 64 + lane) * 8) = ow;
            }
        LDS_WAIT(); asm volatile("" ::: "memory");
        RELANE();
#pragma unroll
        for (int ct = 0; ct < 4; ++ct) { int one_ = 1; asm volatile("" : "+s"(one_)); if (one_) {
            const f32x4 gcc = *(const LAS f32x4*)(gcv + 16 * ct + 4 * g), bkc = *(const LAS f32x4*)(bkv + 16 * ct + 4 * g);
#pragma unroll
            for (int st = 0; st <= ct; ++st) {
                f32x4 acc = (f32x4){0.f, 0.f, 0.f, 0.f};
                acc = MFMA16(FK[ct][0], FK[st][0], acc); acc = MFMA16(FK[ct][1], FK[st][1], acc);
                const float gcs = gcv[16 * st + m], rks = rkv[16 * st + m];
#pragma unroll
                for (int r = 0; r < 4; ++r) { const int cI = 16 * ct + 4 * g + r, sI = 16 * st + m; Lm[cI * 64 + sI] = (sI < cI) ? acc[r] * bkc[r] * rks * __expf(gcc[r] - gcs) : 0.f; }
            }
        } }
        LDS_WAIT(); asm volatile("" ::: "memory");
        __builtin_amdgcn_sched_barrier(0);
        solve64(xw, Lm);
        __builtin_amdgcn_sched_barrier(0);
        {
            RELANE();
            const int l5 = lane & 31, gp = (l5 >> 2) & 3, jj = ((l5 >> 4) << 2) | (l5 & 3);
            bf16* wp = ub + GU_W + (lane >> 5) * 512 + gp * 128 + jj;
#pragma unroll
            for (int c = 0; c < 64; ++c) wp[(c >> 4) * 1024 + (c & 15) * 8] = (bf16)f2bf(xw[c]);
        }
        __builtin_amdgcn_sched_barrier(0);
        RELANE();
        float xu[64];
        {
            const int chv = 512 + h * 64 + lane;
            const float v0 = cw[chv], v1 = cw[768 + chv], v2 = cw[1536 + chv], v3 = cw[2304 + chv];
            float va = 0.f, vb = 0.f, vc = 0.f;
            if (n > 0) { va = bf2f(PROJ[(t0 - 3) * NPROJ + chv]); vb = bf2f(PROJ[(t0 - 2) * NPROJ + chv]); vc = bf2f(PROJ[(t0 - 1) * NPROJ + chv]); }
            unsigned short vr[64];
#pragma unroll
            for (int c = 0; c < 64; ++c) vr[c] = PROJ[(t0 + c) * NPROJ + chv];
            asm volatile("" ::: "memory");
#pragma unroll
            for (int c4 = 0; c4 < 16; ++c4) {
                const f32x4 bt4 = *(const LAS f32x4*)(btv + 4 * c4);
#pragma unroll
                for (int i = 0; i < 4; ++i) { const int c = 4 * c4 + i; const float vd_ = bf2f(vr[c]);
                    float av = v0 * va + v1 * vb + v2 * vc + v3 * vd_; av = av * sigmoidf_(av); va = vb; vb = vc; vc = vd_;
                    xu[c] = av * bt4[i]; }
            }
        }
        __builtin_amdgcn_sched_barrier(0);
        solve64(xu, Lm);
        __builtin_amdgcn_sched_barrier(0);
        LDS_WAIT(); asm volatile("" ::: "memory");
        RELANE();
        {
            const int sl = lane >> 4, e = lane & 15;
#pragma unroll
            for (int mt = 0; mt < 4; ++mt)
#pragma unroll
                for (int gp = 0; gp < 4; ++gp) { const int c = 16 * mt + 4 * gp; u32x2 w2; w2.x = pk2(xu[c], xu[c + 1]); w2.y = pk2(xu[c + 2], xu[c + 3]);
                    *(u32x2*)(ub + GU_U + ((sl * 4 + mt) * 64 + gp * 16 + e) * 4) = w2; }
        }
        if (lane == 0) GL[unit] = __expf(gl);
        LDS_WAIT(); asm volatile("" ::: "memory");
    }
#undef RELANE
}
__device__ __forceinline__ void gdn_scan(const Frame& F_in, int task) {
    const Frame F = relaunder(F_in);
    unsigned char* const L_ws = WSP; bf16* const PROJ = (bf16*)(L_ws + WS_BIG); const float* const GL = (const float*)(L_ws + WS_MISC) + 2048;
    const int bh = task >> 2, sl = task & 3;
    const int b = bh >> 2, h = bh & 3, unit0 = b * 256 + h * 64;
    f32x4 St[4];
#pragma unroll
    for (int i = 0; i < 4; ++i) St[i] = (f32x4){0.f, 0.f, 0.f, 0.f};
    bf16x8 W[8], QD[8], KD[8], QK[6]; u32x2 U[4], UN[4]; float gl; int vz = 0; asm volatile("" : "+v"(vz)); unsigned pA = 0, pB = 0;
    {
        const bf16* u0 = gdn_ubuf(L_ws, unit0) + F.lane * 8;
#pragma unroll
        for (int f = 0; f < 8; ++f) { W[f] = *(const bf16x8*)(u0 + GU_W + f * 512); QD[f] = *(const bf16x8*)(u0 + GU_QD + f * 512); KD[f] = *(const bf16x8*)(u0 + GU_KD + f * 512); }
#pragma unroll
        for (int f = 0; f < 6; ++f) QK[f] = *(const bf16x8*)(u0 + GU_QK + f * 512);
#pragma unroll
        for (int mt = 0; mt < 4; ++mt) U[mt] = *(const u32x2*)(u0 - F.lane * 8 + GU_U + ((sl * 4 + mt) * 64 + F.lane) * 4);
        gl = GL[unit0 + vz];
    }
#pragma unroll 1
    for (int n = 0; n < 64; ++n) {
        const int nn = n < 63 ? n + 1 : 63;
        int ln_ = F.lane; asm volatile("" : "+v"(ln_)); const int g = ln_ >> 4, e = ln_ & 15;
        const bf16* un = gdn_ubuf(L_ws, unit0 + nn) + ln_ * 8;
        const float cgl = gl; gl = GL[unit0 + nn + vz];
        const bf16x8 SB0 = pack_tiles(St[0], St[1]), SB1 = pack_tiles(St[2], St[3]);
        const size_t t0 = (size_t)b * SEQ + (size_t)n * 64;
        f32x4 vn[4];
#pragma unroll
        for (int tt = 0; tt < 4; ++tt) {
            f32x4 ws_ = (f32x4){0.f, 0.f, 0.f, 0.f};
            ws_ = MFMA16(W[tt * 2], SB0, ws_); ws_ = MFMA16(W[tt * 2 + 1], SB1, ws_);
            W[tt * 2] = *(const bf16x8*)(un + GU_W + (tt * 2) * 512); W[tt * 2 + 1] = *(const bf16x8*)(un + GU_W + (tt * 2 + 1) * 512);
            vn[tt] = (f32x4){lo_bf(U[tt].x), hi_bf(U[tt].x), lo_bf(U[tt].y), hi_bf(U[tt].y)} - ws_;
            U[tt] = *(const u32x2*)(un - ln_ * 8 + GU_U + ((sl * 4 + tt) * 64 + ln_) * 4);
        }
        const bf16x8 VB0 = pack_tiles(vn[0], vn[1]), VB1 = pack_tiles(vn[2], vn[3]);
#pragma unroll
        for (int tt = 0; tt < 4; ++tt) {
            f32x4 o = (f32x4){0.f, 0.f, 0.f, 0.f};
            o = MFMA16(QD[tt * 2], SB0, o); o = MFMA16(QD[tt * 2 + 1], SB1, o);
            QD[tt * 2] = *(const bf16x8*)(un + GU_QD + (tt * 2) * 512); QD[tt * 2 + 1] = *(const bf16x8*)(un + GU_QD + (tt * 2 + 1) * 512);
            o = MFMA16(QK[qk_idx(tt, 0)], VB0, o); QK[qk_idx(tt, 0)] = *(const bf16x8*)(un + GU_QK + qk_idx(tt, 0) * 512);
            if (tt >= 2) { o = MFMA16(QK[qk_idx(tt, 1)], VB1, o); QK[qk_idx(tt, 1)] = *(const bf16x8*)(un + GU_QK + qk_idx(tt, 1) * 512); }
#pragma unroll
            for (int r = 0; r < 4; ++r) PROJ[(t0 + 16 * tt + 4 * g + r) * NPROJ + 512 + h * 64 + 16 * sl + e] = (bf16)f2bf(o[r]);
        }
#pragma unroll
        for (int dt = 0; dt < 4; ++dt) { f32x4 c = St[dt] * cgl; c = MFMA16(KD[dt * 2], VB0, c); c = MFMA16(KD[dt * 2 + 1], VB1, c); St[dt] = c;
            KD[dt * 2] = *(const bf16x8*)(un + GU_KD + (dt * 2) * 512); KD[dt * 2 + 1] = *(const bf16x8*)(un + GU_KD + (dt * 2 + 1) * 512); }
    }
}

__device__ __forceinline__ void mlstm_prep(const Frame& F_in, int l) {
    const Frame F = relaunder(F_in);
    unsigned char* const L_ws = WSP; const float* const L_i_bias = IN_F(8); const float* const L_f_bias = IN_F(9);
    const bf16* const PROJ = (const bf16*)(L_ws + WS_BIG); const float* const GATES = (const float*)(L_ws + WS_GATES); float* const FL = (float*)(L_ws + WS_MISC);
    LAS float* bvec = (LAS float*)(F.lds + F.wave * WAVE_LDS); LAS float* avec = bvec + 64;
    const int g = F.lane >> 4, m = F.lane & 15;
    for (int unit = F.gw; unit < 2048; unit += F.ngw) {
        const int h = (unit >> 6) & 3; const size_t t0 = (size_t)(unit >> 8) * SEQ + (size_t)(unit & 63) * 64;
        bf16* const ub = (bf16*)OUTP + (size_t)unit * MU_STRIDE;
        float bl;
        {
            const float* gr = GATES + (t0 + F.lane) * 16;
            const float iv = 15.0f * tanhf((gr[8 + h] + L_i_bias[l * 4 + h]) * (1.0f / 15.0f));
            const float c = 15.0f * tanhf((gr[12 + h] + L_f_bias[l * 4 + h]) * (1.0f / 15.0f));
            float bs = -softplusf_(-c);
#pragma unroll
            for (int o = 1; o < 64; o <<= 1) { const float t = xshfl(bs, F.lane >= o ? F.lane - o : F.lane); if (F.lane >= o) bs += t; }
            bl = __int_as_float(__builtin_amdgcn_readlane(__float_as_int(bs), 63));
            bvec[F.lane] = bs; avec[F.lane] = iv - bs;
        }
        LDS_WAIT(); asm volatile("" ::: "memory");
        const bf16* qrow = PROJ + (t0 + m) * NPROJ + 1024 + h * 64;
        bf16x8 FQ[4][2], FK[4][2];
#pragma unroll
        for (int mt = 0; mt < 4; ++mt)
#pragma unroll
            for (int ks = 0; ks < 2; ++ks) { FQ[mt][ks] = *(const bf16x8*)(qrow + (size_t)(16 * mt) * NPROJ + 32 * ks + 8 * g); FK[mt][ks] = *(const bf16x8*)(qrow + (size_t)(16 * mt) * NPROJ + 256 + 32 * ks + 8 * g); }
#pragma unroll
        for (int tt = 0; tt < 4; ++tt) {
            const float bt = bvec[16 * tt + m];
#pragma unroll
            for (int ks = 0; ks < 2; ++ks) {
                u32x4 ow = (u32x4){0u, 0u, 0u, 0u};
#pragma unroll
                for (int hf = 0; hf < 2; ++hf) { const int st = 2 * ks + hf;
                    if (st <= tt) {
                        f32x4 acc = (f32x4){0.f, 0.f, 0.f, 0.f};
                        acc = MFMA16(FK[st][0], FQ[tt][0], acc); acc = MFMA16(FK[st][1], FQ[tt][1], acc);
                        const f32x4 av = *(const LAS f32x4*)(avec + 16 * st + 4 * g);
                        float v[4];
#pragma unroll
                        for (int r = 0; r < 4; ++r) { const int sI = 16 * st + 4 * g + r, tI = 16 * tt + m; v[r] = (sI <= tI) ? acc[r] * 0.125f * __expf(bt + av[r]) : 0.f; }
                        ow[2 * hf] = pk2(v[0], v[1]); ow[2 * hf + 1] = pk2(v[2], v[3]);
                    } }
                *(u32x4*)(ub + MU_PT + ((tt * 2 + ks) * 64 + F.lane) * 8) = ow;
            }
        }
#pragma unroll
        for (int mt = 0; mt < 4; ++mt) {
            const float f = __expf(bvec[16 * mt + m]);
#pragma unroll
            for (int ks = 0; ks < 2; ++ks) {
                const u32x2 lo = *(const u32x2*)(qrow + (size_t)(16 * mt) * NPROJ + 32 * ks + 4 * g), hi = *(const u32x2*)(qrow + (size_t)(16 * mt) * NPROJ + 32 * ks + 16 + 4 * g);
                u32x4 ow; ow.x = pk2(lo_bf(lo.x) * f, hi_bf(lo.x) * f); ow.y = pk2(lo_bf(lo.y) * f, hi_bf(lo.y) * f); ow.z = pk2(lo_bf(hi.x) * f, hi_bf(hi.x) * f); ow.w = pk2(lo_bf(hi.y) * f, hi_bf(hi.y) * f);
                *(u32x4*)(ub + MU_QB + ((mt * 2 + ks) * 64 + F.lane) * 8) = ow;
            }
        }
#pragma unroll
        for (int ks = 0; ks < 2; ++ks) {
            const f32x4 a0 = *(const LAS f32x4*)(avec + 32 * ks + 4 * g), a1 = *(const LAS f32x4*)(avec + 32 * ks + 16 + 4 * g);
            float fac[8];
#pragma unroll
            for (int j = 0; j < 4; ++j) { fac[j] = 0.125f * __expf(bl + a0[j]); fac[4 + j] = 0.125f * __expf(bl + a1[j]); }
            const bf16* kcol = PROJ + (t0 + 32 * ks + 4 * g) * NPROJ + 1280 + h * 64 + m;
#pragma unroll
            for (int dt = 0; dt < 4; ++dt) {
                float kv[8];
#pragma unroll
                for (int j = 0; j < 8; ++j) kv[j] = bf2f(kcol[(size_t)(16 * (j >> 2) + (j & 3)) * NPROJ + 16 * dt]) * fac[j];
                u32x4 ow; ow.x = pk2(kv[0], kv[1]); ow.y = pk2(kv[2], kv[3]); ow.z = pk2(kv[4], kv[5]); ow.w = pk2(kv[6], kv[7]);
                *(u32x4*)(ub + MU_KW + ((dt * 2 + ks) * 64 + F.lane) * 8) = ow;
            }
#pragma unroll
            for (int sl = 0; sl < 4; ++sl) {
                unsigned short vv[8];
#pragma unroll
                for (int j = 0; j < 8; ++j) vv[j] = kcol[(size_t)(16 * (j >> 2) + (j & 3)) * NPROJ + 256 + 16 * sl];
                u32x4 ow; ow.x = vv[0] | ((unsigned)vv[1] << 16); ow.y = vv[2] | ((unsigned)vv[3] << 16); ow.z = vv[4] | ((unsigned)vv[5] << 16); ow.w = vv[6] | ((unsigned)vv[7] << 16);
                *(u32x4*)(ub + MU_VB + ((sl * 2 + ks) * 64 + F.lane) * 8) = ow;
            }
        }
        if (F.lane == 0) FL[unit] = __expf(bl);
        LDS_WAIT(); asm volatile("" ::: "memory");
    }
}
__device__ __forceinline__ void mlstm_scan(const Frame& F_in, int task) {
    const Frame F = relaunder(F_in);
    unsigned char* const L_ws = WSP; bf16* const PROJ = (bf16*)(L_ws + WS_BIG); float* const GATES = (float*)(L_ws + WS_GATES); const float* const FL = (const float*)(L_ws + WS_MISC);
    const int bh = task / 5, sl = task % 5;
    const int b = bh >> 2, h = bh & 3;
    const bf16* ub0 = (const bf16*)OUTP + (size_t)(b * 256 + h * 64) * MU_STRIDE; const bf16* ub = ub0 + F.lane * 8;
    const u32x4 ones = (u32x4){0x3f803f80u, 0x3f803f80u, 0x3f803f80u, 0x3f803f80u};
    f32x4 Ct[4];
#pragma unroll
    for (int i = 0; i < 4; ++i) Ct[i] = (f32x4){0.f, 0.f, 0.f, 0.f};
    bf16x8 QB[8], PT[8], KW[8], VB[2], VN[2]; float fl; unsigned pA = 0, pB = 0, pC = 0, pD = 0;
#define ML_VB(dst, n_) do { const bf16* u_ = ub + (size_t)(n_) * MU_STRIDE; if (sl < 4) { dst[0] = *(const bf16x8*)(u_ + MU_VB + (sl * 2) * 512); dst[1] = *(const bf16x8*)(u_ + MU_VB + (sl * 2 + 1) * 512); } else { dst[0] = __builtin_bit_cast(bf16x8, ones); dst[1] = dst[0]; } } while (0)
#pragma unroll
    for (int f = 0; f < 8; ++f) { QB[f] = *(const bf16x8*)(ub + MU_QB + f * 512); PT[f] = *(const bf16x8*)(ub + MU_PT + f * 512); KW[f] = *(const bf16x8*)(ub + MU_KW + f * 512); }
    int vz = 0; asm volatile("" : "+v"(vz)); ML_VB(VB, 0); fl = FL[b * 256 + h * 64 + vz];
#pragma unroll 1
    for (int n = 0; n < 64; ++n) {
        const int nn = n < 63 ? n + 1 : 63;
        int ln_ = F.lane; asm volatile("" : "+v"(ln_)); const int g = ln_ >> 4, e = ln_ & 15;
        const bf16* un = ub0 + ln_ * 8 + (size_t)nn * MU_STRIDE;
        const float cfl = fl; fl = FL[b * 256 + h * 64 + nn + vz];
        ML_VB(VN, nn);
        const bf16x8 CB0 = pack_tiles(Ct[0], Ct[1]), CB1 = pack_tiles(Ct[2], Ct[3]);
        const size_t t0 = (size_t)b * SEQ + (size_t)n * 64;
#pragma unroll
        for (int tt = 0; tt < 4; ++tt) {
            f32x4 o = (f32x4){0.f, 0.f, 0.f, 0.f};
            o = MFMA16(QB[tt * 2], CB0, o); o = MFMA16(QB[tt * 2 + 1], CB1, o); o = MFMA16(PT[tt * 2], VB[0], o); o = MFMA16(PT[tt * 2 + 1], VB[1], o);
            QB[tt * 2] = *(const bf16x8*)(un + MU_QB + (tt * 2) * 512); QB[tt * 2 + 1] = *(const bf16x8*)(un + MU_QB + (tt * 2 + 1) * 512);
            PT[tt * 2] = *(const bf16x8*)(un + MU_PT + (tt * 2) * 512); PT[tt * 2 + 1] = *(const bf16x8*)(un + MU_PT + (tt * 2 + 1) * 512);
            if (sl < 4) {
#pragma unroll
                for (int r = 0; r < 4; ++r) PROJ[(t0 + 16 * tt + 4 * g + r) * NPROJ + 1536 + h * 64 + 16 * sl + e] = (bf16)f2bf(o[r]);
            } else if (e == 0) {
#pragma unroll
                for (int r = 0; r < 4; ++r) GATES[(t0 + 16 * tt + 4 * g + r) * 16 + 8 + h] = o[r];
            }
        }
#pragma unroll
        for (int dt = 0; dt < 4; ++dt) { f32x4 c = Ct[dt] * cfl; c = MFMA16(KW[dt * 2], VB[0], c); c = MFMA16(KW[dt * 2 + 1], VB[1], c); Ct[dt] = c;
            KW[dt * 2] = *(const bf16x8*)(un + MU_KW + (dt * 2) * 512); KW[dt * 2 + 1] = *(const bf16x8*)(un + MU_KW + (dt * 2 + 1) * 512); }
        VB[0] = VN[0]; VB[1] = VN[1];
    }
#undef ML_VB
}

__device__ __forceinline__ float sum16(float v) {
    v += __int_as_float(__builtin_amdgcn_update_dpp(0, __float_as_int(v), 0xB1, 0xF, 0xF, true));
    v += __int_as_float(__builtin_amdgcn_update_dpp(0, __float_as_int(v), 0x4E, 0xF, 0xF, true));
    v += __int_as_float(__builtin_amdgcn_update_dpp(0, __float_as_int(v), 0x141, 0xF, 0xF, true));
    v += __int_as_float(__builtin_amdgcn_update_dpp(0, __float_as_int(v), 0x140, 0xF, 0xF, true));
    return v;
}
__device__ __forceinline__ void m2_post(const Frame& F_in, int l) {
    const Frame F = relaunder(F_in);
    unsigned char* const L_ws = WSP;
    {
        const f32x4* ps = (const f32x4*)(IN_F(1) + (size_t)l * M * PLE); u32x2* pb = (u32x2*)(L_ws + WS_PB);
        const int stride = F.ngw * 64;
        for (int i = F.gw * 64 + F.lane; i < M * PLE / 4; i += 4 * stride) {
            f32x4 v[4];
#pragma unroll
            for (int u = 0; u < 4; ++u) v[u] = ps[i + u * stride];
#pragma unroll
            for (int u = 0; u < 4; ++u) { u32x2 w; w.x = pk2(v[u][0], v[u][1]); w.y = pk2(v[u][2], v[u][3]); pb[i + u * stride] = w; }
        }
    }
    const bf16* const PROJ = (const bf16*)(L_ws + WS_BIG); bf16* const Y = (bf16*)(L_ws + WS_BIG + 176 * MiB); const float* const GATES = (const float*)(L_ws + WS_GATES);
    const f32x4 gn = *(const f32x4*)(IN_F(7) + l * 64 + ((4 * F.lane) & 63)), mn = *(const f32x4*)(IN_F(10) + l * 256 + 4 * F.lane);
    for (int t = F.gw * 4; t < M; t += F.ngw * 4) {
        u32x2 og[4], zg[4], om[4], pm[4]; float dn[4];
#pragma unroll
        for (int u = 0; u < 4; ++u) { const bf16* row = PROJ + (size_t)(t + u) * NPROJ + 4 * F.lane;
            og[u] = *(const u32x2*)(row + 512); zg[u] = *(const u32x2*)(row + 768); om[u] = *(const u32x2*)(row + 1536); pm[u] = *(const u32x2*)(row + 1792);
            dn[u] = GATES[(size_t)(t + u) * 16 + 8 + (F.lane >> 4)]; }
#pragma unroll
        for (int u = 0; u < 4; ++u) {
            float o[4] = {lo_bf(og[u].x), hi_bf(og[u].x), lo_bf(og[u].y), hi_bf(og[u].y)}, z[4] = {lo_bf(zg[u].x), hi_bf(zg[u].x), lo_bf(zg[u].y), hi_bf(zg[u].y)};
            float rs = __builtin_amdgcn_rsqf(sum16((o[0] * o[0] + o[1] * o[1]) + (o[2] * o[2] + o[3] * o[3])) * (1.0f / 64.0f) + EPS);
            float y[4];
#pragma unroll
            for (int i = 0; i < 4; ++i) y[i] = o[i] * rs * gn[i] * (z[i] * sigmoidf_(z[i]));
            u32x2 w; w.x = pk2(y[0], y[1]); w.y = pk2(y[2], y[3]);
            *(u32x2*)(Y + (size_t)(t + u) * DM + 4 * F.lane) = w;
            const float inv = __builtin_amdgcn_rcpf(fmaxf(fabsf(dn[u]), 1.0f));
            float hm[4] = {lo_bf(om[u].x) * inv, hi_bf(om[u].x) * inv, lo_bf(om[u].y) * inv, hi_bf(om[u].y) * inv}, p[4] = {lo_bf(pm[u].x), hi_bf(pm[u].x), lo_bf(pm[u].y), hi_bf(pm[u].y)};
            rs = __builtin_amdgcn_rsqf(sum16((hm[0] * hm[0] + hm[1] * hm[1]) + (hm[2] * hm[2] + hm[3] * hm[3])) * (1.0f / 64.0f) + EPS);
#pragma unroll
            for (int i = 0; i < 4; ++i) y[i] = hm[i] * rs * mn[i] * sigmoidf_(p[i]);
            w.x = pk2(y[0], y[1]); w.y = pk2(y[2], y[3]);
            *(u32x2*)(Y + (size_t)(t + u) * DM + 256 + 4 * F.lane) = w;
        }
    }
}

__device__ __forceinline__ int crow(int reg, int h) { return (reg & 3) + 8 * (reg >> 2) + 4 * h; }
__device__ __forceinline__ void swa_phase(const Frame& F_in, int l, int blk0) {
    const Frame F = relaunder(F_in);
    unsigned char* const L_ws = WSP; const float* const L_sinks = IN_F(11); const bf16* const L_PROJ = (const bf16*)(L_ws + WS_BIG); bf16* const L_Y = (bf16*)(L_ws + WS_BIG + 176 * MiB); const float* const L_ROPE = (const float*)(L_ws + WS_ROPE);
    LAS bf16* Ks = (LAS bf16*)F.lds;
    LAS bf16* Vt = (LAS bf16*)(F.lds + 36864);
    const float* COS = L_ROPE; const float* SIN = L_ROPE + (size_t)M * 8;
    const int r = F.lane & 31, h = F.lane >> 5;
    for (int unit = (int)blockIdx.x - blk0; unit < 512; unit += F.G - blk0) {
        const int b = unit >> 6, kvh = (unit >> 5) & 1, nb = unit & 31;
        const int tok0 = b * SEQ + nb * 128;
        __syncthreads();
        {
            const int key = F.tid >> 1, half = F.tid & 1; const int tok = tok0 - 128 + key; const bool valid = (nb > 0) || (key >= 128);
            u32x4 kq[4], vq[4];
#pragma unroll
            for (int i = 0; i < 4; ++i) { kq[i] = (u32x4){0u, 0u, 0u, 0u}; vq[i] = (u32x4){0u, 0u, 0u, 0u}; }
            if (valid) {
                const bf16* ksrc = L_PROJ + (size_t)tok * NPROJ + 2560 + kvh * 64 + half * 32;
                const bf16* vsrc = L_PROJ + (size_t)tok * NPROJ + 2688 + kvh * 64 + half * 32;
#pragma unroll
                for (int i = 0; i < 4; ++i) { kq[i] = *(const u32x4*)(ksrc + 8 * i); vq[i] = *(const u32x4*)(vsrc + 8 * i); }
                if (half == 0) {
                    const f32x4 c0 = *(const f32x4*)(COS + (size_t)tok * 8), c1 = *(const f32x4*)(COS + (size_t)tok * 8 + 4);
                    const f32x4 s0 = *(const f32x4*)(SIN + (size_t)tok * 8), s1 = *(const f32x4*)(SIN + (size_t)tok * 8 + 4);
                    float x1[8], x2[8], cs[8], sn[8];
#pragma unroll
                    for (int i = 0; i < 4; ++i) { x1[2 * i] = lo_bf(kq[0][i]); x1[2 * i + 1] = hi_bf(kq[0][i]); x2[2 * i] = lo_bf(kq[1][i]); x2[2 * i + 1] = hi_bf(kq[1][i]); cs[i] = c0[i]; cs[4 + i] = c1[i]; sn[i] = s0[i]; sn[4 + i] = s1[i]; }
#pragma unroll
                    for (int i = 0; i < 4; ++i) {
                        kq[0][i] = pk2(x1[2 * i] * cs[2 * i] - x2[2 * i] * sn[2 * i], x1[2 * i + 1] * cs[2 * i + 1] - x2[2 * i + 1] * sn[2 * i + 1]);
                        kq[1][i] = pk2(x2[2 * i] * cs[2 * i] + x1[2 * i] * sn[2 * i], x2[2 * i + 1] * cs[2 * i + 1] + x1[2 * i + 1] * sn[2 * i + 1]); }
                }
            }
#pragma unroll
            for (int i = 0; i < 4; ++i) *(LAS u32x4*)(Ks + key * 72 + half * 32 + 8 * i) = kq[i];
#pragma unroll
            for (int i = 0; i < 4; ++i)
#pragma unroll
                for (int e = 0; e < 4; ++e) { const int d = half * 32 + 8 * i + 2 * e; Vt[d * 264 + key] = (bf16)(vq[i][e] & 0xffffu); Vt[(d + 1) * 264 + key] = (bf16)(vq[i][e] >> 16); }
        }
        __syncthreads();
        const int g = F.wave >> 1, qhalf = F.wave & 1, qh = kvh * 4 + g;
        const float sink = L_sinks[l * 8 + qh];
#pragma unroll 1
        for (int sub = 0; sub < 2; ++sub) {
            const int q0 = qhalf * 64 + sub * 32;
            const int qtok = tok0 + q0 + r;
            bf16x8 qf[4];
            {
                const bf16* qsrc = L_PROJ + (size_t)qtok * NPROJ + 2048 + qh * 64 + 8 * h;
                u32x4 qw[4];
#pragma unroll
                for (int ks = 0; ks < 4; ++ks) qw[ks] = *(const u32x4*)(qsrc + 16 * ks);
                const f32x4 c0 = *(const f32x4*)(COS + (size_t)qtok * 8), c1 = *(const f32x4*)(COS + (size_t)qtok * 8 + 4);
                const f32x4 s0 = *(const f32x4*)(SIN + (size_t)qtok * 8), s1 = *(const f32x4*)(SIN + (size_t)qtok * 8 + 4);
                float cs[8], sn[8];
#pragma unroll
                for (int i = 0; i < 4; ++i) { cs[i] = c0[i]; cs[4 + i] = c1[i]; sn[i] = s0[i]; sn[4 + i] = s1[i]; }
                u32x4 ow;
#pragma unroll
                for (int i = 0; i < 4; ++i) ow[i] = xshflu(qw[0][i], F.lane ^ 32);
                const float sg = h ? 1.0f : -1.0f;
#pragma unroll
                for (int i = 0; i < 4; ++i) {
                    const float a0 = lo_bf(qw[0][i]), a1 = hi_bf(qw[0][i]), b0 = lo_bf(ow[i]), b1 = hi_bf(ow[i]);
                    qw[0][i] = pk2((a0 * cs[2 * i] + sg * b0 * sn[2 * i]) * 0.125f, (a1 * cs[2 * i + 1] + sg * b1 * sn[2 * i + 1]) * 0.125f); }
#pragma unroll
                for (int ks = 1; ks < 4; ++ks)
#pragma unroll
                    for (int i = 0; i < 4; ++i) qw[ks][i] = pk2(lo_bf(qw[ks][i]) * 0.125f, hi_bf(qw[ks][i]) * 0.125f);
#pragma unroll
                for (int ks = 0; ks < 4; ++ks) qf[ks] = __builtin_bit_cast(bf16x8, qw[ks]);
            }
            f32x16 sc[5];
#pragma unroll
            for (int kb = 0; kb < 5; ++kb) {
                f32x16 a;
#pragma unroll
                for (int i = 0; i < 16; ++i) a[i] = 0.f;
#pragma unroll
                for (int ks = 0; ks < 4; ++ks) { const bf16x8 kf = *(const LAS bf16x8*)(Ks + (q0 + 32 * kb + r) * 72 + 16 * ks + 8 * h); a = __builtin_amdgcn_mfma_f32_32x32x16_bf16(kf, qf[ks], a, 0, 0, 0); }
                sc[kb] = a;
            }
            float mx = sink;
#pragma unroll
            for (int kb = 0; kb < 5; ++kb)
#pragma unroll
                for (int i = 0; i < 16; ++i) { const int kr = 32 * kb + crow(i, h); const bool ok = (kr > r) && (kr <= r + 128) && ((nb > 0) || (q0 + kr >= 128));
                    const float s = ok ? sc[kb][i] : -INFINITY; sc[kb][i] = s; mx = fmaxf(mx, s); }
            mx = fmaxf(mx, xshfl(mx, F.lane ^ 32));
            float ls = 0.f;
#pragma unroll
            for (int kb = 0; kb < 5; ++kb)
#pragma unroll
                for (int i = 0; i < 16; ++i) { const float p = __expf(sc[kb][i] - mx); sc[kb][i] = p; ls += p; }
            ls += xshfl(ls, F.lane ^ 32);
            ls += __expf(sink - mx);
            const float inv = __builtin_amdgcn_rcpf(ls);
            f32x16 o[2];
#pragma unroll
            for (int db = 0; db < 2; ++db) {
                f32x16 a;
#pragma unroll
                for (int i = 0; i < 16; ++i) a[i] = 0.f;
#pragma unroll
                for (int kb = 0; kb < 5; ++kb)
#pragma unroll
                    for (int s = 0; s < 2; ++s) {
                        u32x4 pw;
#pragma unroll
                        for (int i = 0; i < 4; ++i) pw[i] = pk2(sc[kb][8 * s + 2 * i], sc[kb][8 * s + 2 * i + 1]);
                        const LAS bf16* vb = Vt + (db * 32 + r) * 264 + q0 + 32 * kb + 16 * s + 4 * h;
                        const s16x4 lo = *(const LAS s16x4*)vb, hi = *(const LAS s16x4*)(vb + 8);
                        const bf16x8 vf = __builtin_shufflevector(lo, hi, 0, 1, 2, 3, 4, 5, 6, 7);
                        a = __builtin_amdgcn_mfma_f32_32x32x16_bf16(vf, __builtin_bit_cast(bf16x8, pw), a, 0, 0, 0);
                    }
                o[db] = a;
            }
            bf16* yp = L_Y + (size_t)qtok * DM + 512 + qh * 64;
#pragma unroll
            for (int db = 0; db < 2; ++db)
#pragma unroll
                for (int gg = 0; gg < 4; ++gg) { u32x2 w; w.x = pk2(o[db][4 * gg] * inv, o[db][4 * gg + 1] * inv); w.y = pk2(o[db][4 * gg + 2] * inv, o[db][4 * gg + 3] * inv);
                    *(u32x2*)(yp + db * 32 + 8 * gg + 4 * h) = w; }
        }
    }
    __syncthreads();
}

__device__ __forceinline__ void final_norm(const Frame& F_in) {
    const Frame F = relaunder(F_in);
    float* const L_out = OUTP; const float* const L_norm_final = IN_F(20); unsigned char* const L_ws = WSP;
    const bf16* const XH = (const bf16*)(L_ws + WS_XB); const unsigned* const XLw = (const unsigned*)(L_ws + WS_XL);
    for (int m0 = F.gw; m0 < M; m0 += 2 * F.ngw) {
        f32x4 v[2][4]; const f32x4* gr = (const f32x4*)L_norm_final + F.lane;
#pragma unroll
        for (int q = 0; q < 2; ++q) { const u32x2* xr = (const u32x2*)(XH + (size_t)(m0 + q * F.ngw) * DM) + F.lane; const unsigned* lr = XLw + (size_t)(m0 + q * F.ngw) * (DM / 4) + F.lane;
#pragma unroll
            for (int j = 0; j < 4; ++j) { const u32x2 h = xr[64 * j]; const int lo = (int)lr[64 * j];
                v[q][j] = (f32x4){lo_bf(h.x) + __builtin_amdgcn_cvt_f32_bf8(lo, 0), hi_bf(h.x) + __builtin_amdgcn_cvt_f32_bf8(lo, 1), lo_bf(h.y) + __builtin_amdgcn_cvt_f32_bf8(lo, 2), hi_bf(h.y) + __builtin_amdgcn_cvt_f32_bf8(lo, 3)}; } }
#pragma unroll
        for (int q = 0; q < 2; ++q) { f32x4* xr = (f32x4*)(L_out + (size_t)(m0 + q * F.ngw) * DM) + F.lane; float s = 0.f;
#pragma unroll
            for (int j = 0; j < 4; ++j) s += (v[q][j][0] * v[q][j][0] + v[q][j][1] * v[q][j][1]) + (v[q][j][2] * v[q][j][2] + v[q][j][3] * v[q][j][3]);
            const float rs = __builtin_amdgcn_rsqf(wave_sum(s, F.lane) * (1.0f / DM) + EPS);
#pragma unroll
            for (int j = 0; j < 4; ++j) xr[64 * j] = v[q][j] * rs * gr[64 * j]; }
    }
}

#define RLX_AGENT __ATOMIC_RELAXED, __HIP_MEMORY_SCOPE_AGENT
#define XB_TMO      128
#define XB_XCNT(j)  (256  + 64 * (j))
#define XB_XSUB(j)  (1280 + 64 * (j))
#define XB_XGEN(j)  (2304 + 64 * (j))
#define XB_TOP      3328
#define XB_TOPGEN   3392
#define XCD_BAR_WORDS 3456
#define XB_SPIN_CAP (1u << 18)

__device__ __forceinline__ unsigned xb_ld(unsigned* p)              { return __hip_atomic_load(p, __ATOMIC_RELAXED, __HIP_MEMORY_SCOPE_AGENT); }
__device__ __forceinline__ unsigned xb_add(unsigned* p, unsigned v) { return __hip_atomic_fetch_add(p, v, __ATOMIC_RELAXED, __HIP_MEMORY_SCOPE_AGENT); }
__device__ __forceinline__ unsigned xb_xcc_id() { return (unsigned)__builtin_amdgcn_s_getreg((3 << 11) | 20) & 0xFu; }
#define XB_SPIN(cond, bar) do { unsigned _sp = 0; while (cond) { __builtin_amdgcn_s_sleep(1); \
    if ((++_sp & 255u) == 0u) { if (xb_ld(&(bar)[XB_TMO])) break; if (_sp > XB_SPIN_CAP) { atomicAdd(&(bar)[XB_TMO], 1u); break; } } } } while (0)

struct XcdBarrier {
    unsigned* bar; unsigned x;
    volatile LAS unsigned* st;
};

__device__ __forceinline__ XcdBarrier xcd_barrier_post(unsigned* bar, volatile LAS unsigned* st, bool leader) {
    XcdBarrier b; b.bar = bar; b.x = xb_xcc_id(); b.st = st;
    if (leader) (void)xb_add(&bar[XB_XCNT(b.x)], 1u);
    return b;
}
__device__ __forceinline__ void xcd_barrier_complete(unsigned* bar, unsigned x, unsigned& nloc, unsigned& nx) {
    const unsigned G = gridDim.x * gridDim.y * gridDim.z;
    unsigned sum, cnt, mine, sp = 0u;
    for (;;) {
        sum = 0u; cnt = 0u; mine = 0u;
#pragma unroll
        for (unsigned j = 0; j < 16; ++j) { const unsigned c = xb_ld(&bar[XB_XCNT(j)]); sum += c; cnt += (c > 0u) ? 1u : 0u; mine = (j == x) ? c : mine; }
        if (sum == G) break;
        __builtin_amdgcn_s_sleep(1);
        if ((++sp & 255u) == 0u) { if (xb_ld(&bar[XB_TMO])) break; if (sp > XB_SPIN_CAP) { atomicAdd(&bar[XB_TMO], 1u); break; } }
    }
    nloc = mine > 0u ? mine : 1u; nx = cnt > 0u ? cnt : 1u;
}

__device__ __forceinline__ void xcd_barrier(const XcdBarrier& b, bool leader) {
    asm volatile("s_waitcnt vmcnt(0)" ::: "memory");
    __syncthreads();
    if (leader) {
        unsigned* bar = b.bar;
        __builtin_amdgcn_s_waitcnt(0);
        unsigned nloc = b.st[0], nx = b.st[1];
        if (nloc == 0u) { xcd_barrier_complete(bar, b.x, nloc, nx); b.st[0] = nloc; b.st[1] = nx; }
        const unsigned old = xb_add(&bar[XB_XSUB(b.x)], 1u);
        const unsigned gen = old / nloc;
        if (old + 1u == (gen + 1u) * nloc) {
            __builtin_amdgcn_fence(__ATOMIC_RELEASE, "agent");
            asm volatile("s_waitcnt vmcnt(0)" ::: "memory");
            const unsigned og = xb_add(&bar[XB_TOP], 1u);
            const unsigned tg = og / nx;
            if (og + 1u == (tg + 1u) * nx) xb_add(&bar[XB_TOPGEN], 1u);
            else XB_SPIN(xb_ld(&bar[XB_TOPGEN]) == tg, bar);
            __builtin_amdgcn_fence(__ATOMIC_ACQUIRE, "agent");
            xb_add(&bar[XB_XGEN(b.x)], 1u);
            asm volatile("s_waitcnt vmcnt(0)" ::: "memory");
        } else {
            XB_SPIN(xb_ld(&bar[XB_XGEN(b.x)]) == gen, bar);
            __builtin_amdgcn_fence(__ATOMIC_ACQUIRE, "agent");
            asm volatile("s_waitcnt vmcnt(0)" ::: "memory");
        }
    }
    __syncthreads();
}

__device__ __forceinline__ void gbar(const Frame& F_in, int) {
    XcdBarrier b; b.bar = (unsigned*)(WSP + WS_MISC + 65536); b.x = xb_xcc_id(); b.st = (volatile LAS unsigned*)(F_in.lds + LDS_BYTES);
    int w_ = F_in.wave; asm volatile("" : "+s"(w_));
    xcd_barrier(b, w_ == 0 && lane_id_asm() == 0);
}

__global__ void __launch_bounds__(NTHR, 2) hybrid_fwd(Args args) {
    extern __shared__ __attribute__((aligned(16))) unsigned char lds[];
    cg::grid_group grid = cg::this_grid();
    Frame F;
    F.lds = (LAS unsigned char*)lds;
    F.wave = __builtin_amdgcn_readfirstlane((int)threadIdx.x >> 6); F.tid = 0; F.lane = 0;
    F.G = gridDim.x; F.gw = blockIdx.x * NWAVES + F.wave; F.ngw = F.G * NWAVES;

    volatile LAS unsigned* xst = (volatile LAS unsigned*)(F.lds + LDS_BYTES);
    if (threadIdx.x < 16) xst[threadIdx.x] = 0u;
    __syncthreads();
    const int xb = 0; (void)xcd_barrier_post((unsigned*)(WSP + WS_MISC + 65536), xst, F.wave == 0 && lane_id_asm() == 0);
    convert_weights(F, 0, F.gw, F.ngw);
    p0_prologue(F);
    grid.sync();
#pragma unroll 1
    for (int l = 0; l < NL; ++l) {
#pragma unroll 1
        for (int op = 0; op < 6; ++op) {
            if (op == 1) {
                gbar(F, xb);
                gdn_prep(F, l);
                mlstm_prep(F, l);
                swa_phase(F, l, 0);
                gbar(F, xb);
                {
                    int c = (int)blockIdx.x; asm volatile("" : "+s"(c));
                    if (F.wave == 0) {
                        if (c < 128) gdn_scan(F, ((c & 7) + 8 * (c >> 5)) * 4 + ((c >> 3) & 3));
                        else { const int q = c - 128, j = q >> 3; mlstm_scan(F, ((q & 7) + 8 * (j / 5)) * 5 + (j % 5)); }
                    } else if (F.wave == 2 && c < 32) { const int q = 128 + c, j = q >> 3; mlstm_scan(F, ((q & 7) + 8 * (j / 5)) * 5 + (j % 5)); }
                    else if (F.wave >= 4 && l + 1 < NL) convert_weights(F, l + 1, c * 4 + (F.wave - 4), F.G * 4);
                }
                gbar(F, xb);
                m2_post(F, l);
            }
            if (op != 5 && (l | op) != 0) gbar(F, xb);
            unsigned char* const ws = WSP; unsigned char* const wb = ws + WS_W + (size_t)(l & 1) * W_LAYER; float* const outp = OUTP;
            float* const ssq0 = (float*)(ws + WS_SSQ); float* const ssq1 = ssq0 + (size_t)M * 16; float* const ssq2 = ssq0 + (size_t)2 * M * 16;
            unsigned char* const big = ws + WS_BIG;
            bf16* const xws = (bf16*)(ws + WS_XB); bf16* const xo = (bf16*)((unsigned char*)outp + 64 * MiB);
            bf16* const xb = (l & 1) ? xo : xws; bf16* const xn = (l & 1) ? xws : xo;
            pg8::Gemm g; pg8::EpiAny E; g.M = M;
            const float* ssq_in = ssq0; E.rslots = (const LAS float*)(F.lds + 131072); E.cnt = 0; E.ssq_out = ssq0; E.bhi = xb; E.xl = ws + WS_XL; E.ob = xb; E.pp = (const bf16*)big; E.gates = (float*)(ws + WS_GATES);
            if (op == 0)      { g.A = xb; g.Bt = (const bf16*)(wb + WO_IN); g.N = NPAD; g.K = DM; E.mode = 0; ssq_in = ssq0; E.ob = (bf16*)big; }
            else if (op == 1) { g.A = (const bf16*)(big + 176 * MiB); g.Bt = (const bf16*)(wb + WO_OUT); g.N = DM; g.K = DM; E.mode = 3; E.ssq_out = ssq1; }
            else if (op == 2) { g.A = xb; g.Bt = (const bf16*)(wb + WO_UP); g.N = FF; g.K = DM; E.mode = 1; ssq_in = ssq1; E.ob = (bf16*)big; }
            else if (op == 3) { g.A = (const bf16*)big; g.Bt = (const bf16*)(wb + WO_DOWN); g.N = DM; g.K = FF; E.mode = 3; E.ssq_out = ssq2; }
            else if (op == 4) { g.A = (const bf16*)(ws + WS_PB); g.Bt = (const bf16*)(wb + WO_P); g.N = DM; g.K = PLE; E.mode = 2; E.ob = (bf16*)big; }
            else              { g.A = xb; g.Bt = (const bf16*)(wb + WO_G); g.N = DM; g.K = DM; E.mode = 4; ssq_in = ssq2; E.ssq_out = ssq0; E.ob = xn; }
            pg8::RstdOrder S; S.init(M, g.N, F.G, (int)blockIdx.x); S.ssq = ssq_in; S.need = (E.mode != 2 && E.mode != 3); S.wave_id = F.wave; S.slots = (LAS float*)(F.lds + 131072); S.cnt = 0;
#pragma unroll 1
            for (int rep = 0; rep < ((op == 0 || op == 2) ? REP_G : 1); ++rep)
            pg8::gemm_phase<pg8::EpiAny, pg8::RstdOrder, true, true>(F.lds, g, S, E, F.wave);
        }
    }
    gbar(F, xb);
    final_norm(F);
}

extern "C" void kernel_launch(void* const* d_in, const int* in_sizes, int n_in, void* d_out, int out_size, void* d_ws, size_t ws_size, hipStream_t stream) {
    static int grid = 0;
    if (grid == 0) {
        if (n_in != 21 || out_size != M * DM || ws_size < WS_END) { fprintf(stderr, "kernel_launch: unexpected shapes (n_in %d out %d ws %zu)\n", n_in, out_size, ws_size); grid = -1; return; }
        int dev = 0, cus = 0, per_cu = 0;
        hipGetDevice(&dev); hipDeviceGetAttribute(&cus, hipDeviceAttributeMultiprocessorCount, dev);
        hipFuncSetAttribute((const void*)hybrid_fwd, hipFuncAttributeMaxDynamicSharedMemorySize, LDS_BYTES + 64);
        hipOccupancyMaxActiveBlocksPerMultiprocessor(&per_cu, (const void*)hybrid_fwd, NTHR, LDS_BYTES + 64);
        (void)hipGetLastError();
        if (per_cu < 1) per_cu = 1;
        grid = cus;
        fprintf(stderr, "kernel_launch: cus %d per_cu %d grid %d ws %zu\n", cus, per_cu, grid, ws_size);
    }
    if (grid < 0) return;
    if (hipMemsetAsync((unsigned char*)d_ws + WS_MISC + 65536, 0, 16384, stream) != hipSuccess) { fprintf(stderr, "kernel_launch: memset failed\n"); return; }
    Args a{};
    for (int i = 0; i < 21; ++i) a.in[i] = d_in[i];
    a.out = (float*)d_out; a.ws = (unsigned char*)d_ws;
    void* kargs[] = {&a};
    hipError_t e = hipLaunchCooperativeKernel((const void*)hybrid_fwd, dim3(grid), dim3(NTHR), kargs, LDS_BYTES + 64, stream);
    if (e != hipSuccess) fprintf(stderr, "cooperative launch failed: %s (grid %d)\n", hipGetErrorString(e), grid);
}
```
